# Optimizing an MI355X kernel written in HIP

```python
import math
import jax, jax.numpy as jnp
from jax import lax
import numpy as np

D_MODEL = 1024
BATCH = 8
SEQ = 4096
DEPTH = 1
DEC_BATCH = 8
DEC_SEQ = 64
PAST_LEN = 2048

CHUNK = 64
QBLK = 128
DA_HEADS = 8
DA_HEAD_DIM = 64
DA_WIDTH = DA_HEADS * 2 * DA_HEAD_DIM
MLA_HEADS = 16
MLA_Q_LORA = 256
MLA_KV_LORA = 128
MLA_NOPE = 64
MLA_ROPE = 32
MLA_V = 64
MLA_WIDTH = MLA_HEADS * MLA_V
ROPE_THETA = 10000.0
REL_BUCKETS = 32
REL_MAX_DIST = 128
PEER_HEADS = 8
PEER_N_KEYS = 128
PEER_N_EXPERTS = PEER_N_KEYS * PEER_N_KEYS
PEER_D_KEY = 128
PEER_TOPK = 16
PEER_BLOCK = 128
IN_WIDTH = 3 * DA_WIDTH + MLA_Q_LORA + MLA_KV_LORA + MLA_ROPE + 2 * D_MODEL
NORM_EPS = 1e-6
NEG_INF = -1e30

kernel_name = "hybrid_diffattn_mla_peer_streaming_step"


def rmsnorm(x, g):
    xf = x.astype(jnp.float32)
    y = xf * lax.rsqrt(jnp.mean(xf * xf, axis=-1, keepdims=True) + NORM_EPS)
    return (y * g.astype(jnp.float32)).astype(x.dtype)


def rope(x, pos):
    half = x.shape[-1] // 2
    inv = ROPE_THETA ** (-jnp.arange(half, dtype=jnp.float32) / half)
    ang = pos.astype(jnp.float32)[:, None] * inv
    ang = ang.reshape(ang.shape[0], *([1] * (x.ndim - 3)), half)
    cos, sin = jnp.cos(ang), jnp.sin(ang)
    xf = x.astype(jnp.float32)
    x1, x2 = xf[..., :half], xf[..., half:]
    return jnp.concatenate([x1 * cos - x2 * sin, x1 * sin + x2 * cos], axis=-1).astype(x.dtype)


def t5_bucket(rel):
    nb = REL_BUCKETS // 2
    max_exact = nb // 2
    ret = jnp.where(rel > 0, nb, 0)
    n = jnp.abs(rel)
    large = max_exact + (jnp.log(jnp.maximum(n, 1).astype(jnp.float32) / max_exact)
                         / math.log(REL_MAX_DIST / max_exact) * (nb - max_exact)).astype(jnp.int32)
    large = jnp.minimum(large, nb - 1)
    return ret + jnp.where(n < max_exact, n, large)


def chunk_mask(q_pos, k_pos):
    return (k_pos // CHUNK)[None, :] <= (q_pos // CHUNK)[:, None]


def over_query_blocks(fn, qs, q_pos):
    B, S = qs[0].shape[:2]
    if S <= QBLK or S % QBLK:
        return fn(*qs, q_pos)
    nb = S // QBLK
    qb = tuple(jnp.moveaxis(q.reshape(B, nb, QBLK, *q.shape[2:]), 1, 0) for q in qs)
    out = lax.map(lambda a: fn(*a[0], a[1]), (qb, q_pos.reshape(nb, QBLK)))
    return jnp.moveaxis(out, 0, 1).reshape(B, S, *out.shape[3:])


def diff_attention(q, k, v, q_pos, k_pos, lam, rel_bias):
    s = jnp.einsum('bqhcd,bkhcd->bchqk', q, k).astype(jnp.float32) * (DA_HEAD_DIM ** -0.5)
    bias = jnp.transpose(rel_bias[t5_bucket(k_pos[None, :] - q_pos[:, None])], (2, 0, 1)).astype(jnp.float32)
    s = jnp.where(chunk_mask(q_pos, k_pos), s + bias, NEG_INF)
    p = jax.nn.softmax(s, axis=-1)
    pd = p[:, 0] - lam * p[:, 1]
    return jnp.einsum('bhqk,bkhe->bqhe', pd.astype(v.dtype), v)


def mla_attention(q_lat, q_pe, ckv, kpe, q_pos, k_pos):
    s = (jnp.einsum('bqhr,bkr->bhqk', q_lat, ckv)
         + jnp.einsum('bqhe,bke->bhqk', q_pe, kpe)).astype(jnp.float32) * ((MLA_NOPE + MLA_ROPE) ** -0.5)
    s = jnp.where(chunk_mask(q_pos, k_pos), s, NEG_INF)
    p = jax.nn.softmax(s, axis=-1)
    return jnp.einsum('bhqk,bkr->bqhr', p.astype(ckv.dtype), ckv)


def peer_tokens(h, w_q, keys, u, v):
    T = h.shape[0]
    q = (h @ w_q).reshape(T, PEER_HEADS, 2, PEER_D_KEY // 2)
    s = jnp.einsum('thcd,hcnd->thcn', q, keys).astype(jnp.float32)
    s1, i1 = lax.top_k(s[:, :, 0], PEER_TOPK)
    s2, i2 = lax.top_k(s[:, :, 1], PEER_TOPK)
    cand = (s1[..., :, None] + s2[..., None, :]).reshape(T, PEER_HEADS, PEER_TOPK * PEER_TOPK)
    cidx = (i1[..., :, None] * PEER_N_KEYS + i2[..., None, :]).reshape(T, PEER_HEADS, PEER_TOPK * PEER_TOPK)
    top, sel = lax.top_k(cand, PEER_TOPK)
    idx = jnp.take_along_axis(cidx, sel, axis=-1)
    g = jax.nn.softmax(top, axis=-1).astype(h.dtype)
    act = jax.nn.gelu(jnp.einsum('td,thkd->thk', h, u[idx]), approximate=False)
    return jnp.einsum('thk,thkd->td', g * act, v[idx])


def peer_ffn(h, w_q, keys, u, v):
    B, S, D = h.shape
    t = h.reshape(B * S, D)
    T = t.shape[0]
    if T > PEER_BLOCK and T % PEER_BLOCK == 0:
        out = lax.map(lambda blk: peer_tokens(blk, w_q, keys, u, v), t.reshape(T // PEER_BLOCK, PEER_BLOCK, D))
        out = out.reshape(T, D)
    else:
        out = peer_tokens(t, w_q, keys, u, v)
    return out.reshape(B, S, D)


def trunk_layer(x, pos, past, layer_idx, rel_bias, norm_mix, w_in, diff_lambda, diff_subln,
                mla_q_norm, mla_w_uq, mla_kv_norm, mla_w_uk, mla_w_uv,
                w_branch_a, w_branch_b, w_out, norm_ffn, peer_w_q, peer_keys, peer_u, peer_v):
    B, S, _ = x.shape
    h = rmsnorm(x, norm_mix)
    z = h @ w_in
    c0 = 3 * DA_WIDTH
    cuts = [DA_WIDTH, 2 * DA_WIDTH, c0, c0 + MLA_Q_LORA, c0 + MLA_Q_LORA + MLA_KV_LORA,
            c0 + MLA_Q_LORA + MLA_KV_LORA + MLA_ROPE]
    zq, zk, zv, zcq, zckv, zkr, zg = jnp.split(z, cuts, axis=-1)
    dq = zq.reshape(B, S, DA_HEADS, 2, DA_HEAD_DIM)
    dk = zk.reshape(B, S, DA_HEADS, 2, DA_HEAD_DIM)
    dv = zv.reshape(B, S, DA_HEADS, 2 * DA_HEAD_DIM)
    gates = jax.nn.sigmoid(zg).reshape(B, S, 2, D_MODEL)
    cq = rmsnorm(zcq, mla_q_norm)
    qh = jnp.einsum('bsr,rhe->bshe', cq, mla_w_uq)
    q_nope = qh[..., :MLA_NOPE]
    q_pe = rope(qh[..., MLA_NOPE:], pos)
    q_lat = jnp.einsum('bshn,rhn->bshr', q_nope, mla_w_uk)
    ckv = rmsnorm(zckv, mla_kv_norm)
    kpe = rope(zkr, pos)
    if past is None:
        k_a, v_a, ckv_all, kpe_all, k_pos = dk, dv, ckv, kpe, pos
    else:
        pk, pv, pckv, pkpe = past
        k_pos = jnp.concatenate([jnp.arange(pk.shape[1], dtype=jnp.int32), pos])
        k_a = jnp.concatenate([pk, dk], axis=1)
        v_a = jnp.concatenate([pv, dv], axis=1)
        ckv_all = jnp.concatenate([pckv, ckv], axis=1)
        kpe_all = jnp.concatenate([pkpe, kpe], axis=1)
    lambda_init = 0.8 - 0.6 * math.exp(-0.3 * layer_idx)
    lam_p = diff_lambda.astype(jnp.float32)
    lam = jnp.exp(jnp.sum(lam_p[0] * lam_p[1])) - jnp.exp(jnp.sum(lam_p[2] * lam_p[3])) + lambda_init
    o_a = over_query_blocks(lambda q, qp: diff_attention(q, k_a, v_a, qp, k_pos, lam, rel_bias), (dq,), pos)
    o_a = (rmsnorm(o_a, diff_subln) * (1.0 - lambda_init)).reshape(B, S, DA_WIDTH)
    o_lat = over_query_blocks(lambda ql, qe, qp: mla_attention(ql, qe, ckv_all, kpe_all, qp, k_pos), (q_lat, q_pe), pos)
    o_b = jnp.einsum('bshr,rhv->bshv', o_lat, mla_w_uv).reshape(B, S, MLA_WIDTH)
    merged = gates[:, :, 0] * (o_a @ w_branch_a) + gates[:, :, 1] * (o_b @ w_branch_b)
    x = x + merged @ w_out
    x = x + peer_ffn(rmsnorm(x, norm_ffn), peer_w_q, peer_keys, peer_u, peer_v)
    return x, (dk, dv, ckv, kpe)


def setup_inputs(seed: int = 0) -> dict:
    key = jax.random.key(seed)
    ks = jax.random.split(key, 32)

    def nrm(k, shape, scale):
        return jax.random.normal(k, shape, jnp.float32) * scale

    def gain(k, shape):
        return 1.0 + 0.02 * jax.random.normal(k, shape, jnp.float32)

    return {
        "x_prompt": nrm(ks[0], (BATCH, SEQ, D_MODEL), 1.0),
        "x_sample": nrm(ks[1], (DEC_BATCH, DEC_SEQ, D_MODEL), 1.0),
        "cache_diff_k": nrm(ks[2], (DEPTH, DEC_BATCH, PAST_LEN, DA_HEADS, 2, DA_HEAD_DIM), 1.0),
        "cache_diff_v": nrm(ks[3], (DEPTH, DEC_BATCH, PAST_LEN, DA_HEADS, 2 * DA_HEAD_DIM), 1.0),
        "cache_mla_ckv": nrm(ks[4], (DEPTH, DEC_BATCH, PAST_LEN, MLA_KV_LORA), 1.0),
        "cache_mla_kpe": nrm(ks[5], (DEPTH, DEC_BATCH, PAST_LEN, MLA_ROPE), 1.0),
        "rel_bias": nrm(ks[6], (REL_BUCKETS, DA_HEADS), 0.1),
        "norm_mix": gain(ks[7], (DEPTH, D_MODEL)),
        "w_in": nrm(ks[8], (DEPTH, D_MODEL, IN_WIDTH), D_MODEL ** -0.5),
        "diff_lambda": nrm(ks[9], (DEPTH, 4, DA_HEAD_DIM), 0.1),
        "diff_subln": gain(ks[10], (DEPTH, 2 * DA_HEAD_DIM)),
        "mla_q_norm": gain(ks[11], (DEPTH, MLA_Q_LORA)),
        "mla_w_uq": nrm(ks[12], (DEPTH, MLA_Q_LORA, MLA_HEADS, MLA_NOPE + MLA_ROPE), MLA_Q_LORA ** -0.5),
        "mla_kv_norm": gain(ks[13], (DEPTH, MLA_KV_LORA)),
        "mla_w_uk": nrm(ks[14], (DEPTH, MLA_KV_LORA, MLA_HEADS, MLA_NOPE), MLA_KV_LORA ** -0.5),
        "mla_w_uv": nrm(ks[15], (DEPTH, MLA_KV_LORA, MLA_HEADS, MLA_V), MLA_KV_LORA ** -0.5),
        "w_branch_a": nrm(ks[16], (DEPTH, DA_WIDTH, D_MODEL), DA_WIDTH ** -0.5),
        "w_branch_b": nrm(ks[17], (DEPTH, MLA_WIDTH, D_MODEL), MLA_WIDTH ** -0.5),
        "w_out": nrm(ks[18], (DEPTH, D_MODEL, D_MODEL), D_MODEL ** -0.5),
        "norm_ffn": gain(ks[19], (DEPTH, D_MODEL)),
        "peer_w_q": nrm(ks[20], (DEPTH, D_MODEL, PEER_HEADS * PEER_D_KEY), D_MODEL ** -0.5),
        "peer_keys": nrm(ks[21], (DEPTH, PEER_HEADS, 2, PEER_N_KEYS, PEER_D_KEY // 2), (PEER_D_KEY // 2) ** -0.5),
        "peer_u": nrm(ks[22], (DEPTH, PEER_N_EXPERTS, D_MODEL), D_MODEL ** -0.5),
        "peer_v": nrm(ks[23], (DEPTH, PEER_N_EXPERTS, D_MODEL), 0.1),
        "norm_final": gain(ks[24], (D_MODEL,)),
    }


def reference(x_prompt, x_sample, cache_diff_k, cache_diff_v, cache_mla_ckv, cache_mla_kpe,
              rel_bias, norm_mix, w_in, diff_lambda, diff_subln, mla_q_norm, mla_w_uq, mla_kv_norm,
              mla_w_uk, mla_w_uv, w_branch_a, w_branch_b, w_out, norm_ffn, peer_w_q, peer_keys,
              peer_u, peer_v, norm_final):
    pos_p = jnp.arange(x_prompt.shape[1], dtype=jnp.int32)
    pos_s = cache_diff_k.shape[2] + jnp.arange(x_sample.shape[1], dtype=jnp.int32)
    xp, xs = x_prompt, x_sample
    kp, vp, cp, ep = [], [], [], []
    ks_, vs_, cs_, es_ = [], [], [], []
    for l in range(DEPTH):
        w = (norm_mix[l], w_in[l], diff_lambda[l], diff_subln[l], mla_q_norm[l], mla_w_uq[l],
             mla_kv_norm[l], mla_w_uk[l], mla_w_uv[l], w_branch_a[l], w_branch_b[l], w_out[l],
             norm_ffn[l], peer_w_q[l], peer_keys[l], peer_u[l], peer_v[l])
        xp, (a, b, c, d) = trunk_layer(xp, pos_p, None, l, rel_bias, *w)
        kp.append(a); vp.append(b); cp.append(c); ep.append(d)
        past = (cache_diff_k[l], cache_diff_v[l], cache_mla_ckv[l], cache_mla_kpe[l])
        xs, (a, b, c, d) = trunk_layer(xs, pos_s, past, l, rel_bias, *w)
        ks_.append(a); vs_.append(b); cs_.append(c); es_.append(d)
    y_prompt = rmsnorm(xp, norm_final)
    y_sample = rmsnorm(xs, norm_final)
    return (y_prompt, y_sample,
            jnp.stack(kp), jnp.stack(vp), jnp.stack(cp), jnp.stack(ep),
            jnp.stack(ks_), jnp.stack(vs_), jnp.stack(cs_), jnp.stack(es_))
```

```cpp
#include <hip/hip_runtime.h>
#include <hip/hip_cooperative_groups.h>
#include <cstdio>
#include <cstdint>
namespace cg = cooperative_groups;

#ifndef ONLY
#define ONLY (-1)
#endif
#ifndef MULTI_LAUNCH
#define MULTI_LAUNCH 1
#endif

typedef unsigned short bf16_t;
typedef short bf16x8 __attribute__((ext_vector_type(8)));
typedef float f32x4 __attribute__((ext_vector_type(4)));
typedef float f32x16 __attribute__((ext_vector_type(16)));
typedef unsigned u32x4 __attribute__((ext_vector_type(4)));
typedef unsigned u32x2 __attribute__((ext_vector_type(2)));

constexpr int DM = 1024;
constexpr int TP = 32768, TS = 512, T = TP + TS;
constexpr int SEQ = 4096, PAST = 2048, LKS = 2112;
constexpr int R = TP + 8 * LKS;
constexpr int NIN = 5632;
constexpr float LOG2E = 1.4426950408889634f;
constexpr float EPS = 1e-6f;

constexpr size_t O_Y = 0;
constexpr size_t O_KP = 34078720, O_VP = 67633152, O_CP = 101187584, O_EP = 105381888;
constexpr size_t O_KS = 106430464, O_VS = 106954752, O_CS = 107479040, O_ES = 107544576;

constexpr size_t W_WIN = 0;
constexpr size_t W_WUQ = W_WIN + 11534336;
constexpr size_t W_WUKV = W_WUQ + 786432;
constexpr size_t W_WA = W_WUKV + 524288;
constexpr size_t W_WB = W_WA + 2097152;
constexpr size_t W_WO = W_WB + 2097152;
constexpr size_t W_WQ = W_WO + 2097152;
constexpr size_t W_KEYS = W_WQ + 2097152;
constexpr size_t W_ROPE = W_KEYS + 262144;
constexpr size_t W_MISC = W_ROPE + 524288;
constexpr size_t W_BAR = W_MISC + 8192;
constexpr size_t W_B = W_BAR + 256;
constexpr size_t W_C = W_B + 68157440;
constexpr size_t W_D = W_C + 68157440;
constexpr size_t W_D2 = W_D + 101711872;
constexpr size_t W_F = W_D + 203423744;
constexpr size_t W_G = W_F + 72417280;
constexpr size_t W_END = W_G + 12713984 + 3178496;
constexpr size_t F_ZCQ = W_F, F_ZCKV = F_ZCQ + 34078720, F_ZKR = F_ZCKV + 17039360, F_CQ = F_ZKR + 4259840;
constexpr size_t D_X1 = W_D, D_SELI = W_D + 136314880, D_SELW = D_SELI + 17039360;

struct Params {
  const float* in[25];
  float* out;
  char* ws;
  unsigned nblocks;
  unsigned pad;
};

typedef __bf16 bf16v2_t __attribute__((ext_vector_type(2)));
typedef float f32v2_t __attribute__((ext_vector_type(2)));
__device__ __forceinline__ unsigned pk2(float lo, float hi) { f32v2_t v = {lo, hi}; bf16v2_t r = __builtin_convertvector(v, bf16v2_t); return __builtin_bit_cast(unsigned, r); }
__device__ __forceinline__ bf16_t f2bf(float x) { return (bf16_t)(pk2(x, 0.f) & 0xffffu); }
__device__ __forceinline__ float bf2f(bf16_t v) { return __uint_as_float(((unsigned)v) << 16); }
__device__ __forceinline__ float bflo(unsigned w) { return __uint_as_float(w << 16); }
__device__ __forceinline__ float bfhi(unsigned w) { return __uint_as_float(w & 0xffff0000u); }
__device__ __forceinline__ float wave_sum(float v) {
#pragma unroll
  for (int o = 32; o >= 1; o >>= 1) v += __shfl_xor(v, o);
  return v;
}
__device__ __forceinline__ f32x16 mfma32(bf16x8 a, bf16x8 b, f32x16 c) { return __builtin_amdgcn_mfma_f32_32x32x16_bf16(a, b, c, 0, 0, 0); }
__device__ __forceinline__ int accrow(int reg, int hh) { return (reg & 3) + 8 * (reg >> 2) + 4 * hh; }
__device__ __forceinline__ int kperm(int k) { return (k & ~12) | ((k & 4) << 1) | ((k & 8) >> 1); }

__device__ __forceinline__ int keyrow_of_token(int t) {
  if (t < TP) return t;
  int ts = t - TP; return TP + (ts >> 6) * LKS + PAST + (ts & 63);
}

__device__ __forceinline__ void grid_barrier(unsigned* ctr, unsigned& gen, unsigned nblocks) {
  __threadfence();
  __syncthreads();
  if (threadIdx.x == 0) {
    gen += 1;
    __hip_atomic_fetch_add(ctr, 1u, __ATOMIC_RELEASE, __HIP_MEMORY_SCOPE_AGENT);
    const unsigned target = gen * nblocks;
    while (__hip_atomic_load(ctr, __ATOMIC_RELAXED, __HIP_MEMORY_SCOPE_AGENT) < target) __builtin_amdgcn_s_sleep(4);
  }
  __syncthreads();
  __builtin_amdgcn_fence(__ATOMIC_ACQUIRE, "agent");
}

constexpr int GEMM_BUF = 36864;
__device__ __forceinline__ void gemm_mainloop(const bf16_t* __restrict__ A, int lda, const bf16_t* __restrict__ Bt, int ldb, int K,
                                              f32x16 (&acc)[2][2], char* lds) {
  const int tid = threadIdx.x, lane = tid & 63, wid = tid >> 6;
  const int wr = wid >> 1, wc = wid & 1;
  const int lr = tid >> 3, lc = tid & 7;
  const bf16_t* ap = A + (size_t)lr * lda + lc * 8;
  const bf16_t* bp = Bt + (size_t)lr * ldb + lc * 8;
  u32x4 ra[4], rb[4];
  const int nk = K >> 6;
#pragma unroll
  for (int i = 0; i < 4; ++i) { ra[i] = *(const u32x4*)(ap + (size_t)(32 * i) * lda); rb[i] = *(const u32x4*)(bp + (size_t)(32 * i) * ldb); }
  {
    char* base = lds;
#pragma unroll
    for (int i = 0; i < 4; ++i) { *(u32x4*)(base + (lr + 32 * i) * 144 + lc * 16) = ra[i]; *(u32x4*)(base + 18432 + (lr + 32 * i) * 144 + lc * 16) = rb[i]; }
  }
  __syncthreads();
  for (int kt = 0; kt < nk; ++kt) {
    const bool more = (kt + 1 < nk);
    if (more) {
#pragma unroll
      for (int i = 0; i < 4; ++i) { ra[i] = *(const u32x4*)(ap + (size_t)(32 * i) * lda + (kt + 1) * 64); rb[i] = *(const u32x4*)(bp + (size_t)(32 * i) * ldb + (kt + 1) * 64); }
    }
    const char* base = lds + (kt & 1) * GEMM_BUF;
    const char* pa = base + (wr * 64 + (lane & 31)) * 144 + (lane >> 5) * 16;
    const char* pb = base + 18432 + (wc * 64 + (lane & 31)) * 144 + (lane >> 5) * 16;
#pragma unroll
    for (int ks = 0; ks < 4; ++ks) {
      bf16x8 a0 = *(const bf16x8*)(pa + ks * 32), a1 = *(const bf16x8*)(pa + 32 * 144 + ks * 32);
      bf16x8 b0 = *(const bf16x8*)(pb + ks * 32), b1 = *(const bf16x8*)(pb + 32 * 144 + ks * 32);
      acc[0][0] = mfma32(a0, b0, acc[0][0]); acc[0][1] = mfma32(a0, b1, acc[0][1]);
      acc[1][0] = mfma32(a1, b0, acc[1][0]); acc[1][1] = mfma32(a1, b1, acc[1][1]);
    }
    if (more) {
      char* wb = lds + ((kt + 1) & 1) * GEMM_BUF;
#pragma unroll
      for (int i = 0; i < 4; ++i) { *(u32x4*)(wb + (lr + 32 * i) * 144 + lc * 16) = ra[i]; *(u32x4*)(wb + 18432 + (lr + 32 * i) * 144 + lc * 16) = rb[i]; }
    }
    __syncthreads();
  }
}
__device__ __forceinline__ void zero_acc(f32x16 (&acc)[2][2]) {
#pragma unroll
  for (int i = 0; i < 2; ++i)
#pragma unroll
    for (int j = 0; j < 2; ++j)
#pragma unroll
      for (int r = 0; r < 16; ++r) acc[i][j][r] = 0.f;
}

__device__ __forceinline__ void vt_store(bf16_t* vt_row, int key32, const f32x16& a, int hh) {
#pragma unroll
  for (int g = 0; g < 4; ++g) {
    const int pos = key32 + (g >> 1) * 16 + hh * 8 + (g & 1) * 4;
    u32x2 w; w.x = pk2(a[4 * g], a[4 * g + 1]); w.y = pk2(a[4 * g + 2], a[4 * g + 3]);
    *(u32x2*)(vt_row + pos) = w;
  }
}

__device__ void phase_prep(const Params& p) {
  const int gtid = blockIdx.x * 256 + threadIdx.x, gthreads = gridDim.x * 256;
  const int gw = gtid >> 6, nw = gthreads >> 6, lane = threadIdx.x & 63;
  char* ws = p.ws;
  {
    bf16_t* dst = (bf16_t*)(ws + W_WIN); const float* src = p.in[8];
    for (int u = gtid; u < NIN * 128; u += gthreads) {
      const int n = u % NIN, k0 = (u / NIN) * 8;
      int col = n; bool valid = true;
      if (n >= 3584) col = n - 96; else if (n >= 3488) valid = false;
      float v[8];
#pragma unroll
      for (int j = 0; j < 8; ++j) v[j] = valid ? src[(size_t)(k0 + j) * 5536 + col] : 0.f;
      u32x4 w; w.x = pk2(v[0], v[1]); w.y = pk2(v[2], v[3]); w.z = pk2(v[4], v[5]); w.w = pk2(v[6], v[7]);
      *(u32x4*)(dst + (size_t)n * 1024 + k0) = w;
    }
  }
  {
    bf16_t* dst = (bf16_t*)(ws + W_WUQ); const float* src = p.in[12];
    for (int u = gtid; u < 1536 * 32; u += gthreads) {
      const int n = u % 1536, k0 = (u / 1536) * 8;
      int col = (n < 1024) ? ((n >> 6) * 96 + (n & 63)) : (((n - 1024) >> 5) * 96 + 64 + ((n - 1024) & 31));
      float v[8];
#pragma unroll
      for (int j = 0; j < 8; ++j) v[j] = src[(size_t)(k0 + j) * 1536 + col];
      u32x4 w; w.x = pk2(v[0], v[1]); w.y = pk2(v[2], v[3]); w.z = pk2(v[4], v[5]); w.w = pk2(v[6], v[7]);
      *(u32x4*)(dst + (size_t)n * 256 + k0) = w;
    }
  }
  {
    bf16_t* dst = (bf16_t*)(ws + W_WUKV);
    for (int u = gtid; u < 2048 * 16; u += gthreads) {
      const int n = u % 2048, k0 = (u / 2048) * 8;
      const float* src = (n < 1024) ? p.in[14] : p.in[15]; const int col = n & 1023;
      float v[8];
#pragma unroll
      for (int j = 0; j < 8; ++j) v[j] = src[(size_t)(k0 + j) * 1024 + col];
      u32x4 w; w.x = pk2(v[0], v[1]); w.y = pk2(v[2], v[3]); w.z = pk2(v[4], v[5]); w.w = pk2(v[6], v[7]);
      *(u32x4*)(dst + (size_t)n * 128 + k0) = w;
    }
  }
  {
    for (int u = gtid; u < 4 * 1024 * 128; u += gthreads) {
      const int which = u >> 17, uu = u & 131071;
      const int n = uu & 1023, k0 = (uu >> 10) * 8;
      const float* src = which == 0 ? p.in[16] : which == 1 ? p.in[17] : which == 2 ? p.in[18] : p.in[20];
      bf16_t* dst = (bf16_t*)(ws + (which == 0 ? W_WA : which == 1 ? W_WB : which == 2 ? W_WO : W_WQ));
      float v[8];
#pragma unroll
      for (int j = 0; j < 8; ++j) v[j] = src[(size_t)(k0 + j) * 1024 + n];
      u32x4 w; w.x = pk2(v[0], v[1]); w.y = pk2(v[2], v[3]); w.z = pk2(v[4], v[5]); w.w = pk2(v[6], v[7]);
      *(u32x4*)(dst + (size_t)n * 1024 + k0) = w;
    }
  }
  {
    bf16_t* dst = (bf16_t*)(ws + W_KEYS); const float* src = p.in[21];
    for (int u = gtid; u < 16 * 128 * 64 / 4; u += gthreads) {
      f32x4 v = *(const f32x4*)(src + (size_t)u * 4);
      u32x2 w; w.x = pk2(v[0], v[1]); w.y = pk2(v[2], v[3]);
      *(u32x2*)(dst + (size_t)u * 4) = w;
    }
  }
  {
    bf16_t* hb = (bf16_t*)(ws + W_B); const float* g = p.in[7];
    for (int t = gw; t < T; t += nw) {
      const float* x = (t < TP) ? p.in[0] + (size_t)t * DM : p.in[1] + (size_t)(t - TP) * DM;
      f32x4 v[4]; float ss = 0.f;
#pragma unroll
      for (int i = 0; i < 4; ++i) { v[i] = *(const f32x4*)(x + i * 256 + lane * 4); ss += v[i][0] * v[i][0] + v[i][1] * v[i][1] + v[i][2] * v[i][2] + v[i][3] * v[i][3]; }
      ss = wave_sum(ss);
      const float rs = rsqrtf(ss * (1.f / DM) + EPS);
#pragma unroll
      for (int i = 0; i < 4; ++i) {
        f32x4 gg = *(const f32x4*)(g + i * 256 + lane * 4);
        u32x2 w; w.x = pk2(v[i][0] * rs * gg[0], v[i][1] * rs * gg[1]); w.y = pk2(v[i][2] * rs * gg[2], v[i][3] * rs * gg[3]);
        *(u32x2*)(hb + (size_t)t * DM + i * 256 + lane * 4) = w;
      }
    }
  }
  {
    bf16_t* dk = (bf16_t*)(ws + W_D); const float* src = p.in[2];
    for (int u = gtid; u < 8 * PAST * 256; u += gthreads) {
      const int e = u * 4; const int row = e >> 10, c = e & 1023; const int b = row >> 11, j = row & 2047;
      f32x4 v = *(const f32x4*)(src + (size_t)e);
      u32x2 w; w.x = pk2(v[0], v[1]); w.y = pk2(v[2], v[3]);
      *(u32x2*)(dk + (size_t)(TP + b * LKS + j) * 1024 + c) = w;
    }
    bf16_t* ck = (bf16_t*)(ws + W_G); const float* s2 = p.in[4];
    for (int u = gtid; u < 8 * PAST * 32; u += gthreads) {
      const int e = u * 4; const int row = e >> 7, c = e & 127; const int b = row >> 11, j = row & 2047;
      f32x4 v = *(const f32x4*)(s2 + (size_t)e);
      u32x2 w; w.x = pk2(v[0], v[1]); w.y = pk2(v[2], v[3]);
      *(u32x2*)(ck + (size_t)(TP + b * LKS + j) * 128 + c) = w;
    }
    bf16_t* kp = (bf16_t*)(ws + W_G + 12713984); const float* s3 = p.in[5];
    for (int u = gtid; u < 8 * PAST * 8; u += gthreads) {
      const int e = u * 4; const int row = e >> 5, c = e & 31; const int b = row >> 11, j = row & 2047;
      f32x4 v = *(const f32x4*)(s3 + (size_t)e);
      u32x2 w; w.x = pk2(v[0], v[1]); w.y = pk2(v[2], v[3]);
      *(u32x2*)(kp + (size_t)(TP + b * LKS + j) * 32 + c) = w;
    }
  }
  {
    bf16_t* vt = (bf16_t*)(ws + W_D2) + (size_t)8 * 8 * 128 * SEQ; const float* src = p.in[3];
    for (int u = gtid; u < 8 * 256 * 1024; u += gthreads) {
      const int c = u & 1023, pg = (u >> 10) & 255, b = u >> 18;
      const int p0 = pg * 8;
      float v[8];
#pragma unroll
      for (int i = 0; i < 8; ++i) { const int key = kperm(p0 + i); v[i] = src[((size_t)(b * PAST + key)) * 1024 + c]; }
      u32x4 w; w.x = pk2(v[0], v[1]); w.y = pk2(v[2], v[3]); w.z = pk2(v[4], v[5]); w.w = pk2(v[6], v[7]);
      *(u32x4*)(vt + ((size_t)(b * 1024 + c)) * LKS + p0) = w;
    }
  }
  {
    float2* rt = (float2*)(ws + W_ROPE);
    for (int u = gtid; u < 4096 * 16; u += gthreads) {
      const int pos = u >> 4, i = u & 15;
      const float inv = powf(10000.0f, -(float)i / 16.0f);
      const float ang = (float)pos * inv;
      rt[u] = make_float2(cosf(ang), sinf(ang));
    }
    float* misc = (float*)(ws + W_MISC);
    if (gw == 0) {
      const float* lp = p.in[9];
      float a = lp[lane] * lp[64 + lane], b = lp[128 + lane] * lp[192 + lane];
      a = wave_sum(a); b = wave_sum(b);
      if (lane == 0) misc[0] = expf(a) - expf(b) + 0.2f;
    }
    for (int u = gtid; u < 8 * 192; u += gthreads) {
      const int h = u / 192, idx = u % 192; const int rel = idx - 128;
      const int n = rel < 0 ? -rel : rel;
      int bucket = rel > 0 ? 16 : 0;
      if (n < 8) bucket += n;
      else { int lg = 8 + (n >= 12) + (n >= 16) + (n >= 23) + (n >= 32) + (n >= 46) + (n >= 64) + (n >= 91); bucket += lg > 15 ? 15 : lg; }
      misc[64 + u] = p.in[6][bucket * 8 + h] * LOG2E;
    }
  }
}

__device__ void phase_inproj(const Params& p, char* lds) {
  char* ws = p.ws;
  const bf16_t* hb = (const bf16_t*)(ws + W_B); const bf16_t* wt = (const bf16_t*)(ws + W_WIN);
  const int lane = threadIdx.x & 63, wid = threadIdx.x >> 6, wr = wid >> 1, wc = wid & 1, hh = lane >> 5, l31 = lane & 31;
  for (int u = blockIdx.x; u < 260 * 44; u += gridDim.x) {
    const int mt = u / 44, nt = u % 44; const int m0 = mt * 128, n0 = nt * 128;
    f32x16 acc[2][2]; zero_acc(acc);
    gemm_mainloop(hb + (size_t)m0 * DM, DM, wt + (size_t)n0 * DM, DM, DM, acc, lds);
    const bool samp = (m0 >= TP);
#pragma unroll
    for (int i = 0; i < 2; ++i)
#pragma unroll
      for (int j = 0; j < 2; ++j) {
        const int mb = m0 + wr * 64 + i * 32; const int n = n0 + wc * 64 + j * 32 + l31;
        if (nt < 8) {
          bf16_t* dq = (bf16_t*)(ws + W_C);
#pragma unroll
          for (int r = 0; r < 16; ++r) dq[(size_t)(mb + accrow(r, hh)) * 1024 + n] = f2bf(acc[i][j][r] * (0.125f * LOG2E));
        } else if (nt < 16) {
          const int nn = n - 1024; bf16_t* dk = (bf16_t*)(ws + W_D);
          float* o = samp ? p.out + O_KS + (size_t)(mb - TP) * 1024 : p.out + O_KP + (size_t)mb * 1024;
#pragma unroll
          for (int r = 0; r < 16; ++r) {
            const int rr = accrow(r, hh); o[(size_t)rr * 1024 + nn] = acc[i][j][r];
            dk[(size_t)keyrow_of_token(mb + rr) * 1024 + nn] = f2bf(acc[i][j][r]);
          }
        } else if (nt < 24) {
          const int nn = n - 2048;
          float* o = samp ? p.out + O_VS + (size_t)(mb - TP) * 1024 : p.out + O_VP + (size_t)mb * 1024;
#pragma unroll
          for (int r = 0; r < 16; ++r) o[(size_t)accrow(r, hh) * 1024 + nn] = acc[i][j][r];
          bf16_t* vt; int key32;
          if (!samp) { const int b = mb >> 12; vt = (bf16_t*)(ws + W_D2) + ((size_t)(b * 1024 + nn)) * SEQ; key32 = mb & 4095; }
          else { const int ts = mb - TP; const int b = ts >> 6; vt = (bf16_t*)(ws + W_D2) + (size_t)8 * 1024 * SEQ + ((size_t)(b * 1024 + nn)) * LKS; key32 = PAST + (ts & 63); }
          vt_store(vt, key32, acc[i][j], hh);
        } else if (nt < 26) {
          float* z = (float*)(ws + F_ZCQ); const int nn = n - 3072;
#pragma unroll
          for (int r = 0; r < 16; ++r) z[(size_t)(mb + accrow(r, hh)) * 256 + nn] = acc[i][j][r];
        } else if (nt == 26) {
          float* z = (float*)(ws + F_ZCKV); const int nn = n - 3328;
#pragma unroll
          for (int r = 0; r < 16; ++r) z[(size_t)(mb + accrow(r, hh)) * 128 + nn] = acc[i][j][r];
        } else if (nt == 27) {
          float* z = (float*)(ws + F_ZKR); const int nn = n - 3456;
          if (nn < 32) {
#pragma unroll
            for (int r = 0; r < 16; ++r) z[(size_t)(mb + accrow(r, hh)) * 32 + nn] = acc[i][j][r];
          }
        } else {
          bf16_t* g = (bf16_t*)(p.out + O_Y); const int nn = n - 3584;
#pragma unroll
          for (int r = 0; r < 16; ++r) g[(size_t)(mb + accrow(r, hh)) * 2048 + nn] = f2bf(1.f / (1.f + __expf(-acc[i][j][r])));
        }
      }
  }
}

__device__ void phase_small(const Params& p) {
  char* ws = p.ws;
  const int gw = (blockIdx.x * 256 + threadIdx.x) >> 6, nw = (gridDim.x * 256) >> 6, lane = threadIdx.x & 63;
  const float* zcq = (const float*)(ws + F_ZCQ); const float* zckv = (const float*)(ws + F_ZCKV); const float* zkr = (const float*)(ws + F_ZKR);
  bf16_t* cq = (bf16_t*)(ws + F_CQ); bf16_t* ckva = (bf16_t*)(ws + W_G); bf16_t* kpea = (bf16_t*)(ws + W_G + 12713984);
  const float2* rt = (const float2*)(ws + W_ROPE);
  for (int t = gw; t < T; t += nw) {
    {
      f32x4 v = *(const f32x4*)(zcq + (size_t)t * 256 + lane * 4);
      float ss = wave_sum(v[0] * v[0] + v[1] * v[1] + v[2] * v[2] + v[3] * v[3]);
      const float rs = rsqrtf(ss * (1.f / 256.f) + EPS);
      f32x4 g = *(const f32x4*)(p.in[11] + lane * 4);
      u32x2 w; w.x = pk2(v[0] * rs * g[0], v[1] * rs * g[1]); w.y = pk2(v[2] * rs * g[2], v[3] * rs * g[3]);
      *(u32x2*)(cq + (size_t)t * 256 + lane * 4) = w;
    }
    const int kr = keyrow_of_token(t);
    {
      float2 v = *(const float2*)(zckv + (size_t)t * 128 + lane * 2);
      float ss = wave_sum(v.x * v.x + v.y * v.y);
      const float rs = rsqrtf(ss * (1.f / 128.f) + EPS);
      float2 g = *(const float2*)(p.in[13] + lane * 2);
      const float a = v.x * rs * g.x, b = v.y * rs * g.y;
      float* o = (t < TP) ? p.out + O_CP + (size_t)t * 128 : p.out + O_CS + (size_t)(t - TP) * 128;
      *(float2*)(o + lane * 2) = make_float2(a, b);
      *(unsigned*)(ckva + (size_t)kr * 128 + lane * 2) = pk2(a, b);
    }
    {
      const int pos = (t < TP) ? (t & 4095) : (PAST + ((t - TP) & 63));
      const int i = lane & 15;
      const float x1 = zkr[(size_t)t * 32 + i], x2 = zkr[(size_t)t * 32 + 16 + i];
      const float2 cs = rt[pos * 16 + i];
      const float r = (lane < 16) ? (x1 * cs.x - x2 * cs.y) : (x1 * cs.y + x2 * cs.x);
      if (lane < 32) {
        float* o = (t < TP) ? p.out + O_EP + (size_t)t * 32 : p.out + O_ES + (size_t)(t - TP) * 32;
        o[lane] = r; kpea[(size_t)kr * 32 + lane] = f2bf(r);
      }
    }
  }
}

template <int MODE>
__device__ void attn_item(const Params& p, char* lds, int grp  , int b, int h, int qblk) {
  constexpr int DQ = MODE == 0 ? 64 : 96;
  constexpr int KROW = MODE == 0 ? 128 : 96;
  constexpr int KSTR = MODE == 0 ? 272 : 208;
  constexpr int DV = MODE == 0 ? 128 : 64;
  constexpr int NH = MODE == 0 ? 8 : 16;
  constexpr int KBYTES = 64 * KSTR;
  constexpr int BUF = KBYTES + DV * 144;
  constexpr int KCH = KROW / 8;
  constexpr int NKC = 64 * KCH / 256;
  constexpr int NVC = DV * 8 / 256;
  char* ws = p.ws;
  const int tid = threadIdx.x, lane = tid & 63, wid = tid >> 6, hh = lane >> 5, l31 = lane & 31;
  const int qsub = MODE == 0 ? (wid >> 1) : wid;
  const int comp = MODE == 0 ? (wid & 1) : 0;
  const int QB = MODE == 0 ? 64 : 128;
  const int Lk = grp == 0 ? SEQ : LKS;
  const int tok0 = grp == 0 ? (b * SEQ + qblk * QB) : (TP + b * 64);
  const int qpos0 = grp == 0 ? qblk * QB : PAST;
  const int krow0 = grp == 0 ? b * SEQ : TP + b * LKS;
  int nkt;
  if (grp == 0) nkt = MODE == 0 ? (qblk + 1) : (2 * qblk + 2); else nkt = 33;
  int my_last = nkt - 1; bool active = true;
  if (MODE == 1) { if (grp == 0) my_last = 2 * qblk + (wid >> 1); else active = (wid < 2); }
  const int qtok = tok0 + qsub * 32 + l31;
  const int qpos = qpos0 + qsub * 32 + l31;

  bf16x8 qf[DQ / 16];
  if (MODE == 0) {
    const bf16_t* q = (const bf16_t*)(ws + W_C) + (size_t)qtok * 1024 + h * 128 + comp * 64 + hh * 8;
#pragma unroll
    for (int ks = 0; ks < 4; ++ks) qf[ks] = *(const bf16x8*)(q + ks * 16);
  } else {
    const int qt = active ? qtok : tok0;
    const bf16_t* q = (const bf16_t*)(ws + W_B) + (size_t)qt * 1024 + h * 64 + hh * 8;
#pragma unroll
    for (int ks = 0; ks < 4; ++ks) qf[ks] = *(const bf16x8*)(q + ks * 16);
    const bf16_t* qp = (const bf16_t*)(ws + F_ZCQ) + (size_t)qt * 512 + h * 32 + hh * 8;
    bf16x8 a = *(const bf16x8*)(qp), c = *(const bf16x8*)(qp + 16);
    const float2* rt = (const float2*)(ws + W_ROPE) + (size_t)(active ? qpos : qpos0) * 16 + hh * 8;
    float o1[8], o2[8];
#pragma unroll
    for (int j = 0; j < 8; ++j) {
      const float x1 = bf2f((bf16_t)a[j]), x2 = bf2f((bf16_t)c[j]); const float2 cs = rt[j];
      o1[j] = x1 * cs.x - x2 * cs.y; o2[j] = x1 * cs.y + x2 * cs.x;
    }
    u32x4 w1, w2;
    w1.x = pk2(o1[0], o1[1]); w1.y = pk2(o1[2], o1[3]); w1.z = pk2(o1[4], o1[5]); w1.w = pk2(o1[6], o1[7]);
    w2.x = pk2(o2[0], o2[1]); w2.y = pk2(o2[2], o2[3]); w2.z = pk2(o2[4], o2[5]); w2.w = pk2(o2[6], o2[7]);
    qf[4] = __builtin_bit_cast(bf16x8, w1); qf[5] = __builtin_bit_cast(bf16x8, w2);
  }

  const bf16_t* kg; const bf16_t* kpe; const bf16_t* vg;
  if (MODE == 0) {
    kg = (const bf16_t*)(ws + W_D) + (size_t)krow0 * 1024 + h * 128;
    kpe = nullptr;
    vg = (const bf16_t*)(ws + W_D2) + (grp == 0 ? (size_t)(b * 1024 + h * 128) * SEQ : (size_t)8 * 1024 * SEQ + (size_t)(b * 1024 + h * 128) * LKS);
  } else {
    kg = (const bf16_t*)(ws + W_D) + (size_t)krow0 * 1024 + h * 64;
    kpe = (const bf16_t*)(ws + W_G + 12713984) + (size_t)krow0 * 32;
    vg = (const bf16_t*)(ws + W_D2) + (grp == 0 ? (size_t)(b * 1024 + h * 64) * SEQ : (size_t)8 * 1024 * SEQ + (size_t)(b * 1024 + h * 64) * LKS);
  }
  u32x4 rk[NKC], rv[NVC];
  auto gloadK = [&](int kt) {
#pragma unroll
    for (int i = 0; i < NKC; ++i) {
      const int q = tid + 256 * i; const int row = q / KCH, ch = q % KCH;
      const bf16_t* src;
      if (MODE == 0) src = kg + (size_t)(kt * 64 + row) * 1024 + ch * 8;
      else src = (ch < 8) ? kg + (size_t)(kt * 64 + row) * 1024 + ch * 8 : kpe + (size_t)(kt * 64 + row) * 32 + (ch - 8) * 8;
      rk[i] = *(const u32x4*)src;
    }
  };
  auto gloadV = [&](int kt) {
#pragma unroll
    for (int i = 0; i < NVC; ++i) {
      const int q = tid + 256 * i; const int row = q >> 3, ch = q & 7;
      rv[i] = *(const u32x4*)(vg + (size_t)row * Lk + kt * 64 + ch * 8);
    }
  };
  auto lwriteK = [&](int buf) {
    char* base = lds + buf * BUF;
#pragma unroll
    for (int i = 0; i < NKC; ++i) { const int q = tid + 256 * i; const int row = q / KCH, ch = q % KCH; *(u32x4*)(base + row * KSTR + ch * 16) = rk[i]; }
  };
  auto lwriteV = [&](int buf) {
    char* base = lds + buf * BUF;
#pragma unroll
    for (int i = 0; i < NVC; ++i) { const int q = tid + 256 * i; const int row = q >> 3, ch = q & 7; *(u32x4*)(base + KBYTES + row * 144 + ch * 16) = rv[i]; }
  };

  f32x16 O[DV / 32];
#pragma unroll
  for (int i = 0; i < DV / 32; ++i)
#pragma unroll
    for (int r = 0; r < 16; ++r) O[i][r] = 0.f;
  float m = -1e30f, l = 0.f;
  const float* btab = (const float*)(ws + W_MISC) + 64 + h * 192;
  const float bfar = MODE == 0 ? btab[0] : 0.f;

  gloadK(0); gloadV(0); lwriteK(0); lwriteV(0);
  __syncthreads();
  for (int kt = 0; kt < nkt; ++kt) {
    const bool more = (kt + 1 < nkt);
    if (more) { gloadK(kt + 1); if (MODE == 1) gloadV(kt + 1); }
    if (active && kt <= my_last) {
      const char* base = lds + (kt & 1) * BUF;
      f32x16 S[2];
      const char* kp0 = base + l31 * KSTR + comp * 128 + hh * 16;
#pragma unroll
      for (int sub = 0; sub < 2; ++sub) {
#pragma unroll
        for (int r = 0; r < 16; ++r) S[sub][r] = bfar;
#pragma unroll
        for (int ks = 0; ks < DQ / 16; ++ks) {
          bf16x8 kf = *(const bf16x8*)(kp0 + sub * 32 * KSTR + ks * 32);
          S[sub] = mfma32(kf, qf[ks], S[sub]);
        }
      }
      if (MODE == 0) {
        const int kpos0 = kt * 64;
        if (kpos0 + 63 > qpos0 - 91) {
#pragma unroll
          for (int sub = 0; sub < 2; ++sub)
#pragma unroll
            for (int r = 0; r < 16; ++r) {
              int rel = kpos0 + sub * 32 + accrow(r, hh) - qpos; rel = rel < -128 ? -128 : rel;
              S[sub][r] += btab[rel + 128] - bfar;
            }
        }
      }
      __builtin_amdgcn_sched_barrier(0);
      float mx = S[0][0];
#pragma unroll
      for (int sub = 0; sub < 2; ++sub)
#pragma unroll
        for (int r = 0; r < 16; ++r) mx = fmaxf(mx, S[sub][r]);
      mx = fmaxf(mx, __shfl_xor(mx, 32));
      const float mn = fmaxf(m, mx);
      const float alpha = __builtin_amdgcn_exp2f(m - mn);
      m = mn;
      float ps = 0.f;
#pragma unroll
      for (int sub = 0; sub < 2; ++sub)
#pragma unroll
        for (int r = 0; r < 16; ++r) { S[sub][r] = __builtin_amdgcn_exp2f(S[sub][r] - mn); ps += S[sub][r]; }
      l = l * alpha + ps;
#pragma unroll
      for (int i = 0; i < DV / 32; ++i)
#pragma unroll
        for (int r = 0; r < 16; ++r) O[i][r] *= alpha;
      if (MODE == 0 && more) { lwriteK((kt + 1) & 1); gloadV(kt + 1); }
      const char* vp0 = base + KBYTES + l31 * 144 + hh * 16;
#pragma unroll
      for (int sub = 0; sub < 2; ++sub)
#pragma unroll
        for (int s = 0; s < 2; ++s) {
          u32x4 w;
          w.x = pk2(S[sub][8 * s + 0], S[sub][8 * s + 1]); w.y = pk2(S[sub][8 * s + 2], S[sub][8 * s + 3]);
          w.z = pk2(S[sub][8 * s + 4], S[sub][8 * s + 5]); w.w = pk2(S[sub][8 * s + 6], S[sub][8 * s + 7]);
          const bf16x8 pf = __builtin_bit_cast(bf16x8, w);
          __builtin_amdgcn_sched_barrier(0);
#pragma unroll
          for (int blk = 0; blk < DV / 32; ++blk) {
            bf16x8 vf = *(const bf16x8*)(vp0 + blk * 32 * 144 + sub * 64 + s * 32);
            O[blk] = mfma32(vf, pf, O[blk]);
          }
        }
    }
    if (more) { if (MODE == 1) lwriteK((kt + 1) & 1); lwriteV((kt + 1) & 1); }
    __syncthreads();
  }
  const float lt = l + __shfl_xor(l, 32);
  const float inv = 1.f / lt;
  if (MODE == 0) {
    float* xch = (float*)lds;
    const float lam = ((const float*)(ws + W_MISC))[0];
    if (comp == 1) {
#pragma unroll
      for (int blk = 0; blk < 4; ++blk)
#pragma unroll
        for (int r = 0; r < 16; ++r) xch[(qsub * 32 + l31) * 132 + blk * 32 + accrow(r, hh)] = O[blk][r] * inv * lam;
    }
    __syncthreads();
    if (comp == 0) {
      float ss = 0.f;
#pragma unroll
      for (int blk = 0; blk < 4; ++blk)
#pragma unroll
        for (int r = 0; r < 16; ++r) { const float v = O[blk][r] * inv - xch[(qsub * 32 + l31) * 132 + blk * 32 + accrow(r, hh)]; O[blk][r] = v; ss += v * v; }
      ss += __shfl_xor(ss, 32);
      const float rs = rsqrtf(ss * (1.f / 128.f) + EPS) * 0.8f;
      bf16_t* o = (bf16_t*)(ws + W_C) + (size_t)qtok * 1024 + h * 128;
      const float* sg = p.in[10];
#pragma unroll
      for (int blk = 0; blk < 4; ++blk)
#pragma unroll
        for (int g = 0; g < 4; ++g) {
          const int dv = blk * 32 + 8 * g + 4 * hh;
          f32x4 gg = *(const f32x4*)(sg + dv);
          u32x2 w; w.x = pk2(O[blk][4 * g] * rs * gg[0], O[blk][4 * g + 1] * rs * gg[1]); w.y = pk2(O[blk][4 * g + 2] * rs * gg[2], O[blk][4 * g + 3] * rs * gg[3]);
          *(u32x2*)(o + dv) = w;
        }
    }
    __syncthreads();
  } else {
    if (active) {
      bf16_t* o = (bf16_t*)(ws + W_B) + (size_t)qtok * 1024 + h * 64;
#pragma unroll
      for (int blk = 0; blk < 2; ++blk)
#pragma unroll
        for (int g = 0; g < 4; ++g) {
          const int dv = blk * 32 + 8 * g + 4 * hh;
          u32x2 w; w.x = pk2(O[blk][4 * g] * inv, O[blk][4 * g + 1] * inv); w.y = pk2(O[blk][4 * g + 2] * inv, O[blk][4 * g + 3] * inv);
          *(u32x2*)(o + dv) = w;
        }
    }
  }
}

__device__ void phase_attn_diff(const Params& p, char* lds) {
  const int total = 4096 + 64;
  for (int u = blockIdx.x; u < total; u += gridDim.x) {
    int grp = 0, bh, qblk = 0;
    if (u < 2048) { qblk = 63 - (u >> 6); bh = u & 63; }
    else if (u < 2112) { grp = 1; bh = u - 2048; }
    else { const int v = u - 64; qblk = 63 - (v >> 6); bh = v & 63; }
    attn_item<0>(p, lds, grp, bh >> 3, bh & 7, qblk);
  }
}
__device__ void phase_attn_mla(const Params& p, char* lds) {
  const int total = 4096 + 128;
  for (int u = blockIdx.x; u < total; u += gridDim.x) {
    int grp = 0, bh, qblk = 0;
    if (u < 2048) { qblk = 31 - (u >> 7); bh = u & 127; }
    else if (u < 2176) { grp = 1; bh = u - 2048; }
    else { const int v = u - 128; qblk = 31 - (v >> 7); bh = v & 127; }
    attn_item<1>(p, lds, grp, bh >> 4, bh & 15, qblk);
  }
}

__device__ void phase_mla_expand(const Params& p, char* lds) {
  char* ws = p.ws;
  const int lane = threadIdx.x & 63, wid = threadIdx.x >> 6, wr = wid >> 1, wc = wid & 1, hh = lane >> 5, l31 = lane & 31;
  const int nA = 260 * 12, nB = 388 * 16;
  for (int u = blockIdx.x; u < nA + nB; u += gridDim.x) {
    f32x16 acc[2][2]; zero_acc(acc);
    if (u < nA) {
      const int mt = u / 12, nt = u % 12; const int m0 = mt * 128, n0 = nt * 128;
      gemm_mainloop((const bf16_t*)(ws + F_CQ) + (size_t)m0 * 256, 256, (const bf16_t*)(ws + W_WUQ) + (size_t)n0 * 256, 256, 256, acc, lds);
      const float sc = 0.10206207261596577f * LOG2E;
#pragma unroll
      for (int i = 0; i < 2; ++i)
#pragma unroll
        for (int j = 0; j < 2; ++j) {
          const int mb = m0 + wr * 64 + i * 32; const int n = n0 + wc * 64 + j * 32 + l31;
          if (nt < 8) {
            bf16_t* o = (bf16_t*)(ws + W_B);
#pragma unroll
            for (int r = 0; r < 16; ++r) o[(size_t)(mb + accrow(r, hh)) * 1024 + n] = f2bf(acc[i][j][r] * sc);
          } else {
            bf16_t* o = (bf16_t*)(ws + F_ZCQ);
#pragma unroll
            for (int r = 0; r < 16; ++r) o[(size_t)(mb + accrow(r, hh)) * 512 + (n - 1024)] = f2bf(acc[i][j][r] * sc);
          }
        }
    } else {
      const int v = u - nA; const int mt = v / 16, nt = v % 16; const int m0 = mt * 128, n0 = nt * 128;
      gemm_mainloop((const bf16_t*)(ws + W_G) + (size_t)m0 * 128, 128, (const bf16_t*)(ws + W_WUKV) + (size_t)n0 * 128, 128, 128, acc, lds);
#pragma unroll
      for (int i = 0; i < 2; ++i)
#pragma unroll
        for (int j = 0; j < 2; ++j) {
          const int mb = m0 + wr * 64 + i * 32; const int n = n0 + wc * 64 + j * 32 + l31;
          if (nt < 8) {
            bf16_t* o = (bf16_t*)(ws + W_D);
#pragma unroll
            for (int r = 0; r < 16; ++r) o[(size_t)(mb + accrow(r, hh)) * 1024 + n] = f2bf(acc[i][j][r]);
          } else {
            const int nn = n - 1024; bf16_t* vt; int key32;
            if (mb < TP) { const int b = mb >> 12; vt = (bf16_t*)(ws + W_D2) + ((size_t)(b * 1024 + nn)) * SEQ; key32 = mb & 4095; }
            else { const int x = mb - TP; const int b = x / LKS; vt = (bf16_t*)(ws + W_D2) + (size_t)8 * 1024 * SEQ + ((size_t)(b * 1024 + nn)) * LKS; key32 = x - b * LKS; }
            vt_store(vt, key32, acc[i][j], hh);
          }
        }
    }
  }
}

__device__ void phase_merge(const Params& p, char* lds) {
  char* ws = p.ws;
  const int lane = threadIdx.x & 63, wid = threadIdx.x >> 6, wr = wid >> 1, wc = wid & 1, hh = lane >> 5, l31 = lane & 31;
  const bf16_t* gates = (const bf16_t*)(p.out + O_Y);
  bf16_t* mg = (bf16_t*)(ws + W_F);
  for (int u = blockIdx.x; u < 260 * 8; u += gridDim.x) {
    const int mt = u >> 3, nt = u & 7; const int m0 = mt * 128, n0 = nt * 128;
    const bf16_t* g0p = gates + (size_t)(m0 + wr * 64 + 4 * hh) * 2048 + n0 + wc * 64 + l31;
    bf16_t* mp = mg + (size_t)(m0 + wr * 64 + 4 * hh) * 1024 + n0 + wc * 64 + l31;
    {
      f32x16 acc[2][2]; zero_acc(acc);
      gemm_mainloop((const bf16_t*)(ws + W_C) + (size_t)m0 * 1024, 1024, (const bf16_t*)(ws + W_WA) + (size_t)n0 * 1024, 1024, 1024, acc, lds);
#pragma unroll
      for (int i = 0; i < 2; ++i)
#pragma unroll
        for (int j = 0; j < 2; ++j) {
#pragma unroll
          for (int r = 0; r < 16; ++r) {
            const int rr = i * 32 + (r & 3) + 8 * (r >> 2);
            mp[(size_t)rr * 1024 + j * 32] = f2bf(acc[i][j][r] * bf2f(g0p[(size_t)rr * 2048 + j * 32]));
          }
        }
    }
    asm volatile("" : "+v"(mp));
    asm volatile("" : "+v"(g0p));
    {
      f32x16 acc[2][2]; zero_acc(acc);
      gemm_mainloop((const bf16_t*)(ws + W_B) + (size_t)m0 * 1024, 1024, (const bf16_t*)(ws + W_WB) + (size_t)n0 * 1024, 1024, 1024, acc, lds);
#pragma unroll
      for (int i = 0; i < 2; ++i)
#pragma unroll
        for (int j = 0; j < 2; ++j) {
#pragma unroll
          for (int r = 0; r < 16; ++r) {
            const int rr = i * 32 + (r & 3) + 8 * (r >> 2);
            mp[(size_t)rr * 1024 + j * 32] = f2bf(bf2f(mp[(size_t)rr * 1024 + j * 32]) + acc[i][j][r] * bf2f(g0p[(size_t)rr * 2048 + 1024 + j * 32]));
          }
        }
    }
  }
}

__device__ void phase_outproj(const Params& p, char* lds) {
  char* ws = p.ws;
  const int lane = threadIdx.x & 63, wid = threadIdx.x >> 6, wr = wid >> 1, wc = wid & 1, hh = lane >> 5, l31 = lane & 31;
  float* x1 = (float*)(ws + D_X1);
  for (int u = blockIdx.x; u < 260 * 8; u += gridDim.x) {
    const int mt = u >> 3, nt = u & 7; const int m0 = mt * 128, n0 = nt * 128;
    f32x16 acc[2][2]; zero_acc(acc);
    gemm_mainloop((const bf16_t*)(ws + W_F) + (size_t)m0 * 1024, 1024, (const bf16_t*)(ws + W_WO) + (size_t)n0 * 1024, 1024, 1024, acc, lds);
    const float* xin = (m0 < TP) ? p.in[0] + (size_t)m0 * 1024 : p.in[1] + (size_t)(m0 - TP) * 1024;
#pragma unroll
    for (int i = 0; i < 2; ++i)
#pragma unroll
      for (int j = 0; j < 2; ++j) {
        const int ml = wr * 64 + i * 32; const int n = n0 + wc * 64 + j * 32 + l31;
#pragma unroll
        for (int r = 0; r < 16; ++r) { const int rr = ml + accrow(r, hh); x1[(size_t)(m0 + rr) * 1024 + n] = xin[(size_t)rr * 1024 + n] + acc[i][j][r]; }
      }
  }
}

__device__ void phase_ffn_norm(const Params& p) {
  char* ws = p.ws;
  const int gtid = blockIdx.x * 256 + threadIdx.x, gthreads = gridDim.x * 256;
  const int gw = gtid >> 6, nw = gthreads >> 6, lane = threadIdx.x & 63;
  const float* x1 = (const float*)(ws + D_X1); bf16_t* hf = (bf16_t*)(ws + W_C); const float* g = p.in[19];
  for (int t = gw; t < T; t += nw) {
    const float* x = x1 + (size_t)t * DM;
    f32x4 v[4]; float ss = 0.f;
#pragma unroll
    for (int i = 0; i < 4; ++i) { v[i] = *(const f32x4*)(x + i * 256 + lane * 4); ss += v[i][0] * v[i][0] + v[i][1] * v[i][1] + v[i][2] * v[i][2] + v[i][3] * v[i][3]; }
    ss = wave_sum(ss);
    const float rs = rsqrtf(ss * (1.f / DM) + EPS);
#pragma unroll
    for (int i = 0; i < 4; ++i) {
      f32x4 gg = *(const f32x4*)(g + i * 256 + lane * 4);
      u32x2 w; w.x = pk2(v[i][0] * rs * gg[0], v[i][1] * rs * gg[1]); w.y = pk2(v[i][2] * rs * gg[2], v[i][3] * rs * gg[3]);
      *(u32x2*)(hf + (size_t)t * DM + i * 256 + lane * 4) = w;
    }
  }
  bf16_t* ub = (bf16_t*)(ws + W_F);
  for (int u = gtid; u < 2 * 16384 * 256; u += gthreads) {
    const size_t e = (size_t)u * 4; const float* src = (e < 16777216) ? p.in[22] + e : p.in[23] + (e - 16777216);
    f32x4 v = *(const f32x4*)src;
    u32x2 w; w.x = pk2(v[0], v[1]); w.y = pk2(v[2], v[3]);
    *(u32x2*)(ub + e) = w;
  }
}

__device__ void phase_peer_q(const Params& p, char* lds) {
  char* ws = p.ws;
  const int lane = threadIdx.x & 63, wid = threadIdx.x >> 6, wr = wid >> 1, wc = wid & 1, hh = lane >> 5, l31 = lane & 31;
  bf16_t* pq = (bf16_t*)(ws + W_B);
  for (int u = blockIdx.x; u < 260 * 8; u += gridDim.x) {
    const int mt = u >> 3, nt = u & 7; const int m0 = mt * 128, n0 = nt * 128;
    f32x16 acc[2][2]; zero_acc(acc);
    gemm_mainloop((const bf16_t*)(ws + W_C) + (size_t)m0 * 1024, 1024, (const bf16_t*)(ws + W_WQ) + (size_t)n0 * 1024, 1024, 1024, acc, lds);
#pragma unroll
    for (int i = 0; i < 2; ++i)
#pragma unroll
      for (int j = 0; j < 2; ++j) {
        const int mb = m0 + wr * 64 + i * 32; const int n = n0 + wc * 64 + j * 32 + l31;
#pragma unroll
        for (int r = 0; r < 16; ++r) pq[(size_t)(mb + accrow(r, hh)) * 1024 + n] = f2bf(acc[i][j][r]);
      }
  }
}

__device__ __forceinline__ unsigned fkey(float f) { unsigned u = __float_as_uint(f); return (u & 0x80000000u) ? ~u : (u | 0x80000000u); }
__device__ __forceinline__ float fkey_inv(unsigned k) { unsigned u = (k & 0x80000000u) ? (k & 0x7fffffffu) : ~k; return __uint_as_float(u); }
__device__ __forceinline__ unsigned long long wave_max_u64(unsigned long long v) {
#pragma unroll
  for (int o = 32; o >= 1; o >>= 1) {
    unsigned lo = __shfl_xor((unsigned)(v & 0xffffffffull), o), hi = __shfl_xor((unsigned)(v >> 32), o);
    unsigned long long w = ((unsigned long long)hi << 32) | lo;
    v = w > v ? w : v;
  }
  return v;
}
__device__ void phase_peer_select(const Params& p, char* lds) {
  char* ws = p.ws;
  const int tid = threadIdx.x, lane = tid & 63, wid = tid >> 6, hh = lane >> 5, l31 = lane & 31;
  const bf16_t* pq = (const bf16_t*)(ws + W_B); const bf16_t* keys = (const bf16_t*)(ws + W_KEYS);
  int* seli = (int*)(ws + D_SELI); float* selw = (float*)(ws + D_SELW);
  float* S = (float*)lds;
  for (int u = blockIdx.x; u < 520 * 8; u += gridDim.x) {
    const int tt = u >> 3, h = u & 7; const int t0 = tt * 64;
    {
      const int c = wid >> 1;
      f32x16 acc[2][2]; zero_acc(acc);
      const bf16_t* ap = pq + (size_t)(t0 + l31) * 1024 + h * 128 + c * 64 + hh * 8;
      const bf16_t* bp = keys + ((size_t)((h * 2 + c) * 128 + (wid & 1) * 64 + l31)) * 64 + hh * 8;
#pragma unroll
      for (int ks = 0; ks < 4; ++ks) {
        bf16x8 a0 = *(const bf16x8*)(ap + ks * 16), a1 = *(const bf16x8*)(ap + 32 * 1024 + ks * 16);
        bf16x8 b0 = *(const bf16x8*)(bp + ks * 16), b1 = *(const bf16x8*)(bp + 32 * 64 + ks * 16);
        acc[0][0] = mfma32(a0, b0, acc[0][0]); acc[0][1] = mfma32(a0, b1, acc[0][1]);
        acc[1][0] = mfma32(a1, b0, acc[1][0]); acc[1][1] = mfma32(a1, b1, acc[1][1]);
      }
#pragma unroll
      for (int i = 0; i < 2; ++i)
#pragma unroll
        for (int j = 0; j < 2; ++j)
#pragma unroll
          for (int r = 0; r < 16; ++r) S[(i * 32 + accrow(r, hh)) * 260 + c * 128 + (wid & 1) * 64 + j * 32 + l31] = acc[i][j][r];
    }
    __syncthreads();
    for (int q = 0; q < 16; ++q) {
      const int tl = wid * 16 + q;
      const float* srow = S + tl * 260;
      float s1v = 0.f, s2v[4] = {0.f, 0.f, 0.f, 0.f}; int i1v = 0, i2v[4] = {0, 0, 0, 0};
#pragma unroll
      for (int c = 0; c < 2; ++c) {
        unsigned long long k0 = ((unsigned long long)fkey(srow[c * 128 + lane]) << 32) | (unsigned)(127 - lane);
        unsigned long long k1 = ((unsigned long long)fkey(srow[c * 128 + 64 + lane]) << 32) | (unsigned)(127 - (lane + 64));
        for (int r = 0; r < 16; ++r) {
          unsigned long long best = wave_max_u64(k0 > k1 ? k0 : k1);
          if (k0 == best) k0 = 0ull;
          if (k1 == best) k1 = 0ull;
          const float val = fkey_inv((unsigned)(best >> 32)); const int idx = 127 - (int)(best & 0xffffffffull);
          if (c == 0) { if (r == (lane >> 2)) { s1v = val; i1v = idx; } }
          else {
            if ((r >> 2) == (lane & 3)) {
              if ((r & 3) == 0) { s2v[0] = val; i2v[0] = idx; } else if ((r & 3) == 1) { s2v[1] = val; i2v[1] = idx; }
              else if ((r & 3) == 2) { s2v[2] = val; i2v[2] = idx; } else { s2v[3] = val; i2v[3] = idx; }
            }
          }
        }
      }
      unsigned long long ck[4];
#pragma unroll
      for (int e = 0; e < 4; ++e) {
        const float cv = s1v + s2v[e]; const int flat = (lane >> 2) * 16 + (lane & 3) * 4 + e;
        ck[e] = ((unsigned long long)fkey(cv) << 32) | (unsigned)(255 - flat);
      }
      float topv = 0.f; int topi = 0; float mxv = 0.f;
      for (int r = 0; r < 16; ++r) {
        unsigned long long b01 = ck[0] > ck[1] ? ck[0] : ck[1], b23 = ck[2] > ck[3] ? ck[2] : ck[3];
        unsigned long long best = wave_max_u64(b01 > b23 ? b01 : b23);
        int mine = -1;
#pragma unroll
        for (int e = 0; e < 4; ++e) if (ck[e] == best) { ck[e] = 0ull; mine = e; }
        const float val = fkey_inv((unsigned)(best >> 32));
        if (r == 0) mxv = val;
        int eidx = 0;
        if (mine >= 0) eidx = i1v * 128 + (mine == 0 ? i2v[0] : mine == 1 ? i2v[1] : mine == 2 ? i2v[2] : i2v[3]);
        const int flat = 255 - (int)(best & 0xffffffffull);
        const int owner = (flat >> 4) * 4 + ((flat & 15) >> 2);
        eidx = __shfl(eidx, owner);
        if (lane == r) { topv = val; topi = eidx; }
      }
      float e = (lane < 16) ? __expf(topv - mxv) : 0.f;
      float den = wave_sum(e);
      if (lane < 16) {
        const size_t o = ((size_t)(t0 + tl) * 8 + h) * 16 + lane;
        seli[o] = topi; selw[o] = e / den;
      }
    }
    __syncthreads();
  }
}

__device__ void phase_peer_gather(const Params& p) {
  char* ws = p.ws;
  const int gw = (blockIdx.x * 256 + threadIdx.x) >> 6, nw = (gridDim.x * 256) >> 6, lane = threadIdx.x & 63;
  const bf16_t* hf = (const bf16_t*)(ws + W_C);
  const bf16_t* ub = (const bf16_t*)(ws + W_F); const bf16_t* vb = ub + 16777216;
  const int* seli = (const int*)(ws + D_SELI); const float* selw = (const float*)(ws + D_SELW);
  const float* x1 = (const float*)(ws + D_X1);
  for (int t = gw; t < T; t += nw) {
    float hv[16];
    {
      u32x4 a = *(const u32x4*)(hf + (size_t)t * DM + lane * 8), b = *(const u32x4*)(hf + (size_t)t * DM + 512 + lane * 8);
#pragma unroll
      for (int i = 0; i < 4; ++i) { hv[2 * i] = bflo(a[i]); hv[2 * i + 1] = bfhi(a[i]); hv[8 + 2 * i] = bflo(b[i]); hv[8 + 2 * i + 1] = bfhi(b[i]); }
    }
    float ov[16];
#pragma unroll
    for (int i = 0; i < 16; ++i) ov[i] = 0.f;
    const int myi0 = seli[(size_t)t * 128 + lane], myi1 = seli[(size_t)t * 128 + 64 + lane];
    const float myw0 = selw[(size_t)t * 128 + lane], myw1 = selw[(size_t)t * 128 + 64 + lane];
    for (int e0 = 0; e0 < 128; e0 += 4) {
      int idx[4]; float gw4[4]; u32x4 ua[4], ubv[4];
#pragma unroll
      for (int k = 0; k < 4; ++k) {
        const int e = e0 + k;
        idx[k] = __shfl(e < 64 ? myi0 : myi1, e & 63); gw4[k] = __shfl(e < 64 ? myw0 : myw1, e & 63);
        ua[k] = *(const u32x4*)(ub + (size_t)idx[k] * DM + lane * 8); ubv[k] = *(const u32x4*)(ub + (size_t)idx[k] * DM + 512 + lane * 8);
      }
      u32x4 va[4], vbv[4];
#pragma unroll
      for (int k = 0; k < 4; ++k) { va[k] = *(const u32x4*)(vb + (size_t)idx[k] * DM + lane * 8); vbv[k] = *(const u32x4*)(vb + (size_t)idx[k] * DM + 512 + lane * 8); }
#pragma unroll
      for (int k = 0; k < 4; ++k) {
        float d = 0.f;
#pragma unroll
        for (int i = 0; i < 4; ++i) { d += hv[2 * i] * bflo(ua[k][i]) + hv[2 * i + 1] * bfhi(ua[k][i]); d += hv[8 + 2 * i] * bflo(ubv[k][i]) + hv[8 + 2 * i + 1] * bfhi(ubv[k][i]); }
        d = wave_sum(d);
        const float act = 0.5f * d * (1.f + erff(d * 0.70710678118654752f));
        const float w = gw4[k] * act;
#pragma unroll
        for (int i = 0; i < 4; ++i) { ov[2 * i] += w * bflo(va[k][i]); ov[2 * i + 1] += w * bfhi(va[k][i]); ov[8 + 2 * i] += w * bflo(vbv[k][i]); ov[8 + 2 * i + 1] += w * bfhi(vbv[k][i]); }
      }
    }
    const float* xr = x1 + (size_t)t * DM; const float* g = p.in[24];
    float ss = 0.f;
#pragma unroll
    for (int hlf = 0; hlf < 2; ++hlf) {
      f32x4 a = *(const f32x4*)(xr + hlf * 512 + lane * 8), b = *(const f32x4*)(xr + hlf * 512 + lane * 8 + 4);
#pragma unroll
      for (int i = 0; i < 4; ++i) { ov[hlf * 8 + i] += a[i]; ov[hlf * 8 + 4 + i] += b[i]; }
    }
#pragma unroll
    for (int i = 0; i < 16; ++i) ss += ov[i] * ov[i];
    ss = wave_sum(ss);
    const float rs = rsqrtf(ss * (1.f / DM) + EPS);
    float* y = p.out + O_Y + (size_t)t * DM;
#pragma unroll
    for (int hlf = 0; hlf < 2; ++hlf) {
      f32x4 ga = *(const f32x4*)(g + hlf * 512 + lane * 8), gb = *(const f32x4*)(g + hlf * 512 + lane * 8 + 4);
      f32x4 oa, ob;
#pragma unroll
      for (int i = 0; i < 4; ++i) { oa[i] = ov[hlf * 8 + i] * rs * ga[i]; ob[i] = ov[hlf * 8 + 4 + i] * rs * gb[i]; }
      *(f32x4*)(y + hlf * 512 + lane * 8) = oa; *(f32x4*)(y + hlf * 512 + lane * 8 + 4) = ob;
    }
  }
}

constexpr int NPHASE = 12;
__global__ void __launch_bounds__(256, 2) mega(Params p, int ph_lo, int ph_hi) {
  __shared__ __attribute__((aligned(16))) char lds[73728];
  unsigned gen = 0;
  unsigned* ctr = (unsigned*)(p.ws + W_BAR);
#define RUN_PHASE(PH, CALL)                                                       \
  if ((ONLY < 0 || ONLY == PH) && ph_lo <= PH && PH < ph_hi) {                    \
    CALL;                                                                         \
    if (PH + 1 < ph_hi) {                                                         \
      if (PH == 0) cg::this_grid().sync(); else grid_barrier(ctr, gen, p.nblocks); \
    }                                                                             \
  }
  RUN_PHASE(0, phase_prep(p))
  RUN_PHASE(1, phase_inproj(p, lds))
  RUN_PHASE(2, phase_small(p))
  RUN_PHASE(3, phase_attn_diff(p, lds))
  RUN_PHASE(4, phase_mla_expand(p, lds))
  RUN_PHASE(5, phase_attn_mla(p, lds))
  RUN_PHASE(6, phase_merge(p, lds))
  RUN_PHASE(7, phase_outproj(p, lds))
  RUN_PHASE(8, phase_ffn_norm(p))
  RUN_PHASE(9, phase_peer_q(p, lds))
  RUN_PHASE(10, phase_peer_select(p, lds))
  RUN_PHASE(11, phase_peer_gather(p))
}

extern "C" void kernel_launch(void* const* d_in, const int* in_sizes, int n_in, void* d_out, int out_size, void* d_ws, size_t ws_size,
                              hipStream_t stream) {
  if (ws_size < W_END || n_in < 25) { fprintf(stderr, "workspace too small: %zu < %zu\n", ws_size, (size_t)W_END); return; }
  static int grid_blocks = 0;
  if (!grid_blocks) {
    int dev = 0, cus = 0, per_cu = 0;
    hipGetDevice(&dev);
    hipDeviceGetAttribute(&cus, hipDeviceAttributeMultiprocessorCount, dev);
    hipOccupancyMaxActiveBlocksPerMultiprocessor(&per_cu, mega, 256, 0);
    if (per_cu > 2) per_cu = 2;
    grid_blocks = cus * per_cu;
  }
  Params p{};
  for (int i = 0; i < 25; ++i) p.in[i] = (const float*)d_in[i];
  p.out = (float*)d_out; p.ws = (char*)d_ws; p.nblocks = (unsigned)grid_blocks; p.pad = 0;
#if MULTI_LAUNCH
  for (int ph = 0; ph < NPHASE; ++ph) {
    hipLaunchKernelGGL(mega, dim3(grid_blocks), dim3(256), 0, stream, p, ph, ph + 1);
  }
#else
  hipMemsetAsync((char*)d_ws + W_BAR, 0, 256, stream);
  int lo = 0, hi = NPHASE;
  void* args[] = {&p, &lo, &hi};
  hipError_t e = hipLaunchCooperativeKernel((void*)mega, dim3(grid_blocks), dim3(256), args, 0, stream);
  if (e != hipSuccess) fprintf(stderr, "cooperative launch failed: %s (grid %d)\n", hipGetErrorString(e), grid_blocks);
#endif
}
```

```cpp
#include <hip/hip_runtime.h>
#include <hip/hip_cooperative_groups.h>
#include <cstdio>
#include <cstdint>
namespace cg = cooperative_groups;

#ifndef ONLY
#define ONLY (-1)
#endif
#ifndef DUPMASK
#define DUPMASK 0
#endif
#ifndef MULTI_LAUNCH
#define MULTI_LAUNCH 0
#endif

typedef unsigned short bf16_t;
typedef short bf16x8 __attribute__((ext_vector_type(8)));
typedef float f32x4 __attribute__((ext_vector_type(4)));
typedef float f32x16 __attribute__((ext_vector_type(16)));
typedef unsigned u32x4 __attribute__((ext_vector_type(4)));
typedef unsigned u32x2 __attribute__((ext_vector_type(2)));

constexpr int DM = 1024;
constexpr int TP = 32768, TS = 512, T = TP + TS;
constexpr int SEQ = 4096, PAST = 2048, LKS = 2112;
constexpr int R = TP + 8 * LKS;
constexpr int NIN = 5632;
constexpr int LDH = 1088;
constexpr int LDQ = 288;
constexpr int LDK = 160;
constexpr int SEQP = 4160;
constexpr float LOG2E = 1.4426950408889634f;
constexpr float EPS = 1e-6f;

constexpr size_t O_Y = 0;
constexpr size_t O_KP = 34078720, O_VP = 67633152, O_CP = 101187584, O_EP = 105381888;
constexpr size_t O_KS = 106430464, O_VS = 106954752, O_CS = 107479040, O_ES = 107544576;

constexpr size_t W_WIN = 0;
constexpr size_t W_WUQ = W_WIN + (size_t)NIN * LDH * 2;
constexpr size_t W_WUKV = W_WUQ + (size_t)1536 * LDQ * 2;
constexpr size_t W_WA = W_WUKV + (size_t)2048 * LDK * 2;
constexpr size_t W_WB = W_WA + (size_t)1024 * LDH * 2;
constexpr size_t W_WO = W_WB + (size_t)1024 * LDH * 2;
constexpr size_t W_WQ = W_WO + (size_t)1024 * LDH * 2;
constexpr size_t W_KEYS = W_WQ + (size_t)1024 * LDH * 2;
constexpr size_t W_ROPE = W_KEYS + 262144;
constexpr size_t W_MISC = W_ROPE + 524288;
constexpr size_t W_BAR = W_MISC + 8192;
constexpr int QW = 3584;
constexpr size_t SZ_ACT = (size_t)T * LDH * 2;
constexpr size_t W_B = W_BAR + 16384;
constexpr size_t W_C = W_B + SZ_ACT;
constexpr size_t W_D = W_C + SZ_ACT;
constexpr size_t SZ_VTP = (size_t)8 * 1024 * SEQP * 2, SZ_VTS = (size_t)8 * 1024 * LKS * 2;
constexpr size_t W_D2 = W_D + (size_t)R * LDH * 2;
constexpr size_t W_F = W_D2 + SZ_VTP + SZ_VTS;
constexpr size_t F_ZCQ = W_F, F_ZCKV = F_ZCQ + 34078720, F_ZKR = F_ZCKV + 17039360, F_CQ = F_ZKR + 4259840;
constexpr size_t SZ_F = (F_CQ - W_F) + (size_t)T * LDQ * 2;
static_assert(SZ_F >= SZ_ACT, "merged must fit in F");
constexpr size_t W_G = W_F + SZ_F;
constexpr size_t W_KPE = W_G + (size_t)R * LDK * 2;
constexpr size_t W_END = W_KPE + (size_t)R * 32 * 2;
static_assert(W_END <= 536870912ull, "workspace budget");
constexpr size_t D_X1 = W_D, D_SELI = W_D + 136314880, D_SELW = D_SELI + 17039360;
static_assert(D_SELW + 17039360 <= W_F, "x1 + sel must fit in D");

struct Params {
  const float* in[25];
  float* out;
  char* ws;
  unsigned nblocks;
  unsigned pad;
};

typedef __bf16 bf16v2_t __attribute__((ext_vector_type(2)));
typedef float f32v2_t __attribute__((ext_vector_type(2)));
__device__ __forceinline__ unsigned pk2(float lo, float hi) { f32v2_t v = {lo, hi}; bf16v2_t r = __builtin_convertvector(v, bf16v2_t); return __builtin_bit_cast(unsigned, r); }
__device__ __forceinline__ bf16_t f2bf(float x) { return (bf16_t)(pk2(x, 0.f) & 0xffffu); }
__device__ __forceinline__ float bf2f(bf16_t v) { return __uint_as_float(((unsigned)v) << 16); }
__device__ __forceinline__ float bflo(unsigned w) { return __uint_as_float(w << 16); }
__device__ __forceinline__ float bfhi(unsigned w) { return __uint_as_float(w & 0xffff0000u); }
__device__ __forceinline__ float wave_sum(float v) {
#pragma unroll
  for (int o = 32; o >= 1; o >>= 1) v += __shfl_xor(v, o);
  return v;
}
__device__ __forceinline__ f32x16 mfma32(bf16x8 a, bf16x8 b, f32x16 c) { return __builtin_amdgcn_mfma_f32_32x32x16_bf16(a, b, c, 0, 0, 0); }
__device__ __forceinline__ int accrow(int reg, int hh) { return (reg & 3) + 8 * (reg >> 2) + 4 * hh; }
__device__ __forceinline__ int kperm(int k) { return (k & ~12) | ((k & 4) << 1) | ((k & 8) >> 1); }

__device__ __forceinline__ int keyrow_of_token(int t) {
  if (t < TP) return t;
  int ts = t - TP; return TP + (ts >> 6) * LKS + PAST + (ts & 63);
}

#define XB_XCNT(j)  (256  + 64 * (j))
#define XB_XSUB(j)  (1280 + 64 * (j))
#define XB_XGEN(j)  (2304 + 64 * (j))
#define XB_TOP      3328
#define XB_TOPGEN   3392
__device__ __forceinline__ unsigned xb_ld(unsigned* p)              { return __hip_atomic_load(p, __ATOMIC_RELAXED, __HIP_MEMORY_SCOPE_AGENT); }
__device__ __forceinline__ unsigned xb_add(unsigned* p, unsigned v) { return __hip_atomic_fetch_add(p, v, __ATOMIC_RELAXED, __HIP_MEMORY_SCOPE_AGENT); }
__device__ __forceinline__ unsigned xb_xcc_id() { return (unsigned)__builtin_amdgcn_s_getreg((3 << 11) | 20) & 0xFu; }
__device__ __forceinline__ void grid_barrier(unsigned* bar, unsigned xcc, volatile unsigned* st) {
  asm volatile("s_waitcnt vmcnt(0)" ::: "memory");
  __syncthreads();
  if (threadIdx.x == 0) {
    __builtin_amdgcn_s_waitcnt(0);
    unsigned nloc = st[0], nx = st[1];
    if (nloc == 0u) {
      const unsigned G = gridDim.x;
      for (;;) {
        unsigned sum = 0u, cnt = 0u, mine = 0u;
#pragma unroll
        for (unsigned j = 0; j < 16; ++j) { const unsigned c = xb_ld(&bar[XB_XCNT(j)]); sum += c; cnt += (c > 0u) ? 1u : 0u; mine = (j == xcc) ? c : mine; }
        if (sum == G) { nloc = mine; nx = cnt; break; }
        __builtin_amdgcn_s_sleep(1);
      }
      st[0] = nloc; st[1] = nx;
    }
    const unsigned old = xb_add(&bar[XB_XSUB(xcc)], 1u);
    const unsigned gen = old / nloc;
    if (old + 1u == (gen + 1u) * nloc) {
      __builtin_amdgcn_fence(__ATOMIC_RELEASE, "agent");
      asm volatile("s_waitcnt vmcnt(0)" ::: "memory");
      const unsigned og = xb_add(&bar[XB_TOP], 1u);
      const unsigned tg = og / nx;
      if (og + 1u == (tg + 1u) * nx) xb_add(&bar[XB_TOPGEN], 1u);
      else { while (xb_ld(&bar[XB_TOPGEN]) == tg) __builtin_amdgcn_s_sleep(1); }
      __builtin_amdgcn_fence(__ATOMIC_ACQUIRE, "agent");
      xb_add(&bar[XB_XGEN(xcc)], 1u);
      asm volatile("s_waitcnt vmcnt(0)" ::: "memory");
    } else {
      while (xb_ld(&bar[XB_XGEN(xcc)]) == gen) __builtin_amdgcn_s_sleep(1);
      __builtin_amdgcn_fence(__ATOMIC_ACQUIRE, "agent");
      asm volatile("s_waitcnt vmcnt(0)" ::: "memory");
    }
  }
  __syncthreads();
}

constexpr int GEMM_BUF = 32768;
typedef __attribute__((address_space(3))) unsigned lds_u32_t;
typedef __attribute__((address_space(1))) const unsigned glb_u32_t;
__device__ __forceinline__ void glds16(const bf16_t* g, char* l) {
  __builtin_amdgcn_global_load_lds((glb_u32_t*)g, (lds_u32_t*)l, 16, 0, 0);
}
template <bool SW>
__device__ __forceinline__ void gemm_mainloop(const bf16_t* __restrict__ A, int lda, const bf16_t* __restrict__ Bt, int ldb, int K,
                                              f32x16 (&acc)[2][2], char* lds, int kstart) {
  const int tid = threadIdx.x, lane = tid & 63, wid = tid >> 6;
  const int wr = wid >> 1, wc = wid & 1, l31 = lane & 31, hh = lane >> 5;
  const int lrow = wid * 32 + (lane >> 3);
  const int nk = K >> 6;
  kstart &= (nk - 1);
  const bf16_t* ap[4]; const bf16_t* bp[4];
#pragma unroll
  for (int i = 0; i < 4; ++i) {
    const int row = lrow + 8 * i; const int ch = (lane & 7) ^ ((row >> 1) & 7);
    ap[i] = A + (size_t)row * lda + ch * 8; bp[i] = Bt + (size_t)row * ldb + ch * 8;
  }
  char* ldst = lds + (wid * 32) * 128 + lane * 16;
#pragma unroll
  for (int i = 0; i < 4; ++i) { glds16(ap[i] + kstart * 64, ldst + i * 1024); glds16(bp[i] + kstart * 64, ldst + 16384 + i * 1024); }
  asm volatile("s_waitcnt vmcnt(0)" ::: "memory");
  __syncthreads();
  const int swz = (l31 >> 1) & 7;
  const int roffA = (wr * 64 + l31) * 128, roffB = 16384 + (wc * 64 + l31) * 128;
#pragma unroll 1
  for (int kt = 0; kt < nk; ++kt) {
    const bool more = (kt + 1 < nk);
    if (more) {
      char* d = ldst + ((kt + 1) & 1) * GEMM_BUF;
      const int ko = ((kt + 1 + kstart) & (nk - 1)) * 64;
#pragma unroll
      for (int i = 0; i < 4; ++i) { glds16(ap[i] + ko, d + i * 1024); glds16(bp[i] + ko, d + 16384 + i * 1024); }
    }
    const char* base = lds + (kt & 1) * GEMM_BUF;
#pragma unroll
    for (int ks = 0; ks < 4; ++ks) {
      const int co = ((2 * ks + hh) ^ swz) * 16;
      bf16x8 a0 = *(const bf16x8*)(base + roffA + co), a1 = *(const bf16x8*)(base + roffA + 32 * 128 + co);
      bf16x8 b0 = *(const bf16x8*)(base + roffB + co), b1 = *(const bf16x8*)(base + roffB + 32 * 128 + co);
      if (SW) {
        acc[0][0] = mfma32(b0, a0, acc[0][0]); acc[0][1] = mfma32(b1, a0, acc[0][1]);
        acc[1][0] = mfma32(b0, a1, acc[1][0]); acc[1][1] = mfma32(b1, a1, acc[1][1]);
      } else {
        acc[0][0] = mfma32(a0, b0, acc[0][0]); acc[0][1] = mfma32(a0, b1, acc[0][1]);
        acc[1][0] = mfma32(a1, b0, acc[1][0]); acc[1][1] = mfma32(a1, b1, acc[1][1]);
      }
    }
    asm volatile("s_waitcnt vmcnt(0)" ::: "memory");
    __syncthreads();
  }
}
__device__ __forceinline__ bool tile_at(int nMt, int nNt, int it, int& mt, int& nt) {
  const int x = blockIdx.x & 7, lb = blockIdx.x >> 3, nloc = gridDim.x >> 3;
  const int mb = (x * nMt) >> 3, mc = (((x + 1) * nMt) >> 3) - mb;
  const int idx = lb + it * nloc;
  if (idx >= mc * nNt) return false;
  const int g = idx / (8 * nNt); const int rem = idx - g * 8 * nNt;
  const int left = mc - g * 8; const int gsz = left < 8 ? left : 8;
  mt = mb + g * 8 + rem % gsz; nt = rem / gsz;
  return true;
}
__device__ __forceinline__ void zero_acc(f32x16 (&acc)[2][2]) {
#pragma unroll
  for (int i = 0; i < 2; ++i)
#pragma unroll
    for (int j = 0; j < 2; ++j)
#pragma unroll
      for (int r = 0; r < 16; ++r) acc[i][j][r] = 0.f;
}

__device__ __forceinline__ void vt_store(bf16_t* vt_row, int key32, const f32x16& a, int hh) {
#pragma unroll
  for (int g = 0; g < 4; ++g) {
    const int pos = key32 + (g >> 1) * 16 + hh * 8 + (g & 1) * 4;
    u32x2 w; w.x = pk2(a[4 * g], a[4 * g + 1]); w.y = pk2(a[4 * g + 2], a[4 * g + 3]);
    *(u32x2*)(vt_row + pos) = w;
  }
}

__device__ __forceinline__ void st_bf16_sw(bf16_t* row, const f32x16& a, int hh, float sc) {
#pragma unroll
  for (int g = 0; g < 4; ++g) { u32x2 w; w.x = pk2(a[4 * g] * sc, a[4 * g + 1] * sc); w.y = pk2(a[4 * g + 2] * sc, a[4 * g + 3] * sc); *(u32x2*)(row + 8 * g + 4 * hh) = w; }
}
__device__ __forceinline__ void st_f32_sw(float* row, const f32x16& a, int hh) {
#pragma unroll
  for (int g = 0; g < 4; ++g) { f32x4 w = {a[4 * g], a[4 * g + 1], a[4 * g + 2], a[4 * g + 3]}; *(f32x4*)(row + 8 * g + 4 * hh) = w; }
}

__device__ void phase_prep(const Params& p) {
  const int gtid = blockIdx.x * 256 + threadIdx.x, gthreads = gridDim.x * 256;
  const int gw = gtid >> 6, nw = gthreads >> 6, lane = threadIdx.x & 63;
  char* ws = p.ws;
  {
    bf16_t* dst = (bf16_t*)(ws + W_WIN); const float* src = p.in[8];
    for (int u = gtid; u < NIN * 128; u += gthreads) {
      const int n = u % NIN, k0 = (u / NIN) * 8;
      int col = n; bool valid = true;
      if (n >= 3584) col = n - 96; else if (n >= 3488) valid = false;
      float v[8];
#pragma unroll
      for (int j = 0; j < 8; ++j) v[j] = valid ? src[(size_t)(k0 + j) * 5536 + col] : 0.f;
      u32x4 w; w.x = pk2(v[0], v[1]); w.y = pk2(v[2], v[3]); w.z = pk2(v[4], v[5]); w.w = pk2(v[6], v[7]);
      *(u32x4*)(dst + (size_t)n * LDH + k0) = w;
    }
  }
  {
    bf16_t* dst = (bf16_t*)(ws + W_WUQ); const float* src = p.in[12];
    for (int u = gtid; u < 1536 * 32; u += gthreads) {
      const int n = u % 1536, k0 = (u / 1536) * 8;
      int col = (n < 1024) ? ((n >> 6) * 96 + (n & 63)) : (((n - 1024) >> 5) * 96 + 64 + ((n - 1024) & 31));
      float v[8];
#pragma unroll
      for (int j = 0; j < 8; ++j) v[j] = src[(size_t)(k0 + j) * 1536 + col];
      u32x4 w; w.x = pk2(v[0], v[1]); w.y = pk2(v[2], v[3]); w.z = pk2(v[4], v[5]); w.w = pk2(v[6], v[7]);
      *(u32x4*)(dst + (size_t)n * LDQ + k0) = w;
    }
  }
  {
    bf16_t* dst = (bf16_t*)(ws + W_WUKV);
    for (int u = gtid; u < 2048 * 16; u += gthreads) {
      const int n = u % 2048, k0 = (u / 2048) * 8;
      const float* src = (n < 1024) ? p.in[14] : p.in[15]; const int col = n & 1023;
      float v[8];
#pragma unroll
      for (int j = 0; j < 8; ++j) v[j] = src[(size_t)(k0 + j) * 1024 + col];
      u32x4 w; w.x = pk2(v[0], v[1]); w.y = pk2(v[2], v[3]); w.z = pk2(v[4], v[5]); w.w = pk2(v[6], v[7]);
      *(u32x4*)(dst + (size_t)n * LDK + k0) = w;
    }
  }
  {
    for (int u = gtid; u < 4 * 1024 * 128; u += gthreads) {
      const int which = u >> 17, uu = u & 131071;
      const int n = uu & 1023, k0 = (uu >> 10) * 8;
      const float* src = which == 0 ? p.in[16] : which == 1 ? p.in[17] : which == 2 ? p.in[18] : p.in[20];
      bf16_t* dst = (bf16_t*)(ws + (which == 0 ? W_WA : which == 1 ? W_WB : which == 2 ? W_WO : W_WQ));
      float v[8];
#pragma unroll
      for (int j = 0; j < 8; ++j) v[j] = src[(size_t)(k0 + j) * 1024 + n];
      u32x4 w; w.x = pk2(v[0], v[1]); w.y = pk2(v[2], v[3]); w.z = pk2(v[4], v[5]); w.w = pk2(v[6], v[7]);
      *(u32x4*)(dst + (size_t)n * LDH + k0) = w;
    }
  }
  {
    bf16_t* dst = (bf16_t*)(ws + W_KEYS); const float* src = p.in[21];
    for (int u = gtid; u < 16 * 128 * 64 / 4; u += gthreads) {
      f32x4 v = *(const f32x4*)(src + (size_t)u * 4);
      u32x2 w; w.x = pk2(v[0], v[1]); w.y = pk2(v[2], v[3]);
      *(u32x2*)(dst + (size_t)u * 4) = w;
    }
  }
  {
    bf16_t* hb = (bf16_t*)(ws + W_B); const float* g = p.in[7];
    for (int t = gw; t < T; t += nw) {
      const float* x = (t < TP) ? p.in[0] + (size_t)t * DM : p.in[1] + (size_t)(t - TP) * DM;
      f32x4 v[4]; float ss = 0.f;
#pragma unroll
      for (int i = 0; i < 4; ++i) { v[i] = *(const f32x4*)(x + i * 256 + lane * 4); ss += v[i][0] * v[i][0] + v[i][1] * v[i][1] + v[i][2] * v[i][2] + v[i][3] * v[i][3]; }
      ss = wave_sum(ss);
      const float rs = rsqrtf(ss * (1.f / DM) + EPS);
#pragma unroll
      for (int i = 0; i < 4; ++i) {
        f32x4 gg = *(const f32x4*)(g + i * 256 + lane * 4);
        u32x2 w; w.x = pk2(v[i][0] * rs * gg[0], v[i][1] * rs * gg[1]); w.y = pk2(v[i][2] * rs * gg[2], v[i][3] * rs * gg[3]);
        *(u32x2*)(hb + (size_t)t * LDH + i * 256 + lane * 4) = w;
      }
    }
  }
  {
    bf16_t* dk = (bf16_t*)(ws + W_D); const float* src = p.in[2];
    for (int u = gtid; u < 8 * PAST * 256; u += gthreads) {
      const int e = u * 4; const int row = e >> 10, c = e & 1023; const int b = row >> 11, j = row & 2047;
      f32x4 v = *(const f32x4*)(src + (size_t)e);
      u32x2 w; w.x = pk2(v[0], v[1]); w.y = pk2(v[2], v[3]);
      *(u32x2*)(dk + (size_t)(TP + b * LKS + j) * LDH + c) = w;
    }
    bf16_t* ck = (bf16_t*)(ws + W_G); const float* s2 = p.in[4];
    for (int u = gtid; u < 8 * PAST * 32; u += gthreads) {
      const int e = u * 4; const int row = e >> 7, c = e & 127; const int b = row >> 11, j = row & 2047;
      f32x4 v = *(const f32x4*)(s2 + (size_t)e);
      u32x2 w; w.x = pk2(v[0], v[1]); w.y = pk2(v[2], v[3]);
      *(u32x2*)(ck + (size_t)(TP + b * LKS + j) * LDK + c) = w;
    }
    bf16_t* kp = (bf16_t*)(ws + W_KPE); const float* s3 = p.in[5];
    for (int u = gtid; u < 8 * PAST * 8; u += gthreads) {
      const int e = u * 4; const int row = e >> 5, c = e & 31; const int b = row >> 11, j = row & 2047;
      f32x4 v = *(const f32x4*)(s3 + (size_t)e);
      u32x2 w; w.x = pk2(v[0], v[1]); w.y = pk2(v[2], v[3]);
      *(u32x2*)(kp + (size_t)(TP + b * LKS + j) * 32 + c) = w;
    }
  }
  {
    bf16_t* vt = (bf16_t*)(ws + W_D2 + SZ_VTP); const float* src = p.in[3];
    for (int u = gtid; u < 8 * 256 * 1024; u += gthreads) {
      const int c = u & 1023, pg = (u >> 10) & 255, b = u >> 18;
      const int p0 = pg * 8;
      float v[8];
#pragma unroll
      for (int i = 0; i < 8; ++i) { const int key = kperm(p0 + i); v[i] = src[((size_t)(b * PAST + key)) * 1024 + c]; }
      u32x4 w; w.x = pk2(v[0], v[1]); w.y = pk2(v[2], v[3]); w.z = pk2(v[4], v[5]); w.w = pk2(v[6], v[7]);
      *(u32x4*)(vt + ((size_t)(b * 1024 + c)) * LKS + p0) = w;
    }
  }
  {
    float2* rt = (float2*)(ws + W_ROPE);
    for (int u = gtid; u < 4096 * 16; u += gthreads) {
      const int pos = u >> 4, i = u & 15;
      const float inv = powf(10000.0f, -(float)i / 16.0f);
      const float ang = (float)pos * inv;
      rt[u] = make_float2(cosf(ang), sinf(ang));
    }
    float* misc = (float*)(ws + W_MISC);
    if (gw == 0) {
      const float* lp = p.in[9];
      float a = lp[lane] * lp[64 + lane], b = lp[128 + lane] * lp[192 + lane];
      a = wave_sum(a); b = wave_sum(b);
      if (lane == 0) misc[0] = expf(a) - expf(b) + 0.2f;
    }
    for (int u = gtid; u < 8 * 192; u += gthreads) {
      const int h = u / 192, idx = u % 192; const int rel = idx - 128;
      const int n = rel < 0 ? -rel : rel;
      int bucket = rel > 0 ? 16 : 0;
      if (n < 8) bucket += n;
      else { int lg = 8 + (n >= 12) + (n >= 16) + (n >= 23) + (n >= 32) + (n >= 46) + (n >= 64) + (n >= 91); bucket += lg > 15 ? 15 : lg; }
      misc[64 + u] = (p.in[6][bucket * 8 + h] - p.in[6][15 * 8 + h]) * LOG2E;
    }
  }
}

__device__ void phase_inproj(const Params& p, char* lds) {
  char* ws = p.ws;
  const bf16_t* hb = (const bf16_t*)(ws + W_B); const bf16_t* wt = (const bf16_t*)(ws + W_WIN);
  const int lane = threadIdx.x & 63, wid = threadIdx.x >> 6, wr = wid >> 1, wc = wid & 1, hh = lane >> 5, l31 = lane & 31;
  for (int it = 0;; ++it) {
    int mt, nt; if (!tile_at(260, 44, it, mt, nt)) break;
    const int m0 = mt * 128, n0 = nt * 128;
    f32x16 acc[2][2]; zero_acc(acc);
    const bool samp = (m0 >= TP);
    if (nt >= 16 && nt < 24) {
      gemm_mainloop<false>(hb + (size_t)m0 * LDH, LDH, wt + (size_t)n0 * LDH, LDH, DM, acc, lds, 2 * ((mt + nt) & 7));
#pragma unroll
      for (int i = 0; i < 2; ++i)
#pragma unroll
        for (int j = 0; j < 2; ++j) {
          const int mb = m0 + wr * 64 + i * 32; const int nn = n0 - 2048 + wc * 64 + j * 32 + l31;
          float* o = (samp ? p.out + O_VS + (size_t)(mb - TP) * 1024 : p.out + O_VP + (size_t)mb * 1024) + nn;
#pragma unroll
          for (int r = 0; r < 16; ++r) o[(size_t)accrow(r, hh) * 1024] = acc[i][j][r];
          bf16_t* vt; int key32;
          if (!samp) { const int b = mb >> 12; vt = (bf16_t*)(ws + W_D2) + ((size_t)(b * 1024 + nn)) * SEQP; key32 = mb & 4095; }
          else { const int ts = mb - TP; const int b = ts >> 6; vt = (bf16_t*)(ws + W_D2 + SZ_VTP) + ((size_t)(b * 1024 + nn)) * LKS; key32 = PAST + (ts & 63); }
          vt_store(vt, key32, acc[i][j], hh);
        }
      continue;
    }
    gemm_mainloop<true>(hb + (size_t)m0 * LDH, LDH, wt + (size_t)n0 * LDH, LDH, DM, acc, lds, 2 * ((mt + nt) & 7));
#pragma unroll
    for (int i = 0; i < 2; ++i)
#pragma unroll
      for (int j = 0; j < 2; ++j) {
        const int tok = m0 + wr * 64 + i * 32 + l31; const int cb = n0 + wc * 64 + j * 32;
        if (nt < 8) {
          st_bf16_sw((bf16_t*)(ws + W_C) + (size_t)tok * LDH + cb, acc[i][j], hh, 0.125f * LOG2E);
        } else if (nt < 16) {
          st_f32_sw((samp ? p.out + O_KS + (size_t)(tok - TP) * 1024 : p.out + O_KP + (size_t)tok * 1024) + (cb - 1024), acc[i][j], hh);
          st_bf16_sw((bf16_t*)(ws + W_D) + (size_t)keyrow_of_token(tok) * LDH + (cb - 1024), acc[i][j], hh, 1.f);
        } else if (nt < 26) {
          st_f32_sw((float*)(ws + F_ZCQ) + (size_t)tok * 256 + (cb - 3072), acc[i][j], hh);
        } else if (nt == 26) {
          st_f32_sw((float*)(ws + F_ZCKV) + (size_t)tok * 128 + (cb - 3328), acc[i][j], hh);
        } else if (nt == 27) {
          if (cb == 3456) st_f32_sw((float*)(ws + F_ZKR) + (size_t)tok * 32, acc[i][j], hh);
        } else {
          f32x16 sg;
#pragma unroll
          for (int r = 0; r < 16; ++r) sg[r] = __builtin_amdgcn_rcpf(1.f + __expf(-acc[i][j][r]));
          st_bf16_sw((bf16_t*)(p.out + O_Y) + (size_t)tok * 2048 + (cb - 3584), sg, hh, 1.f);
        }
      }
  }
}

__device__ void phase_small(const Params& p) {
  char* ws = p.ws;
  const int gw = (blockIdx.x * 256 + threadIdx.x) >> 6, nw = (gridDim.x * 256) >> 6, lane = threadIdx.x & 63;
  const float* zcq = (const float*)(ws + F_ZCQ); const float* zckv = (const float*)(ws + F_ZCKV); const float* zkr = (const float*)(ws + F_ZKR);
  bf16_t* cq = (bf16_t*)(ws + F_CQ); bf16_t* ckva = (bf16_t*)(ws + W_G); bf16_t* kpea = (bf16_t*)(ws + W_KPE);
  const float2* rt = (const float2*)(ws + W_ROPE);
  for (int t = gw; t < T; t += nw) {
    {
      f32x4 v = *(const f32x4*)(zcq + (size_t)t * 256 + lane * 4);
      float ss = wave_sum(v[0] * v[0] + v[1] * v[1] + v[2] * v[2] + v[3] * v[3]);
      const float rs = rsqrtf(ss * (1.f / 256.f) + EPS);
      f32x4 g = *(const f32x4*)(p.in[11] + lane * 4);
      u32x2 w; w.x = pk2(v[0] * rs * g[0], v[1] * rs * g[1]); w.y = pk2(v[2] * rs * g[2], v[3] * rs * g[3]);
      *(u32x2*)(cq + (size_t)t * LDQ + lane * 4) = w;
    }
    const int kr = keyrow_of_token(t);
    {
      float2 v = *(const float2*)(zckv + (size_t)t * 128 + lane * 2);
      float ss = wave_sum(v.x * v.x + v.y * v.y);
      const float rs = rsqrtf(ss * (1.f / 128.f) + EPS);
      float2 g = *(const float2*)(p.in[13] + lane * 2);
      const float a = v.x * rs * g.x, b = v.y * rs * g.y;
      float* o = (t < TP) ? p.out + O_CP + (size_t)t * 128 : p.out + O_CS + (size_t)(t - TP) * 128;
      *(float2*)(o + lane * 2) = make_float2(a, b);
      *(unsigned*)(ckva + (size_t)kr * LDK + lane * 2) = pk2(a, b);
    }
    {
      const int pos = (t < TP) ? (t & 4095) : (PAST + ((t - TP) & 63));
      const int i = lane & 15;
      const float x1 = zkr[(size_t)t * 32 + i], x2 = zkr[(size_t)t * 32 + 16 + i];
      const float2 cs = rt[pos * 16 + i];
      const float r = (lane < 16) ? (x1 * cs.x - x2 * cs.y) : (x1 * cs.y + x2 * cs.x);
      if (lane < 32) {
        float* o = (t < TP) ? p.out + O_EP + (size_t)t * 32 : p.out + O_ES + (size_t)(t - TP) * 32;
        o[lane] = r; kpea[(size_t)kr * 32 + lane] = f2bf(r);
      }
    }
  }
}

template <int MODE>
__device__ void attn_item(const Params& p, char* lds, int grp  , int b, int h, int qblk, int dry) {
  constexpr int DQ = MODE == 0 ? 64 : 96;
  constexpr int KROW = MODE == 0 ? 128 : 96;
  constexpr int KSTR = MODE == 0 ? 272 : 208;
  constexpr int DV = MODE == 0 ? 128 : 64;
  constexpr int NH = MODE == 0 ? 8 : 16;
  constexpr int KBYTES = 64 * KSTR;
  constexpr int BUF = KBYTES + DV * 144;
  constexpr int KCH = KROW / 8;
  constexpr int NKC = 64 * KCH / 256;
  constexpr int NVC = DV * 8 / 256;
  char* ws = p.ws;
  const int tid = threadIdx.x, lane = tid & 63, wid = tid >> 6, hh = lane >> 5, l31 = lane & 31;
  const int qsub = MODE == 0 ? (wid >> 1) : wid;
  const int comp = MODE == 0 ? (wid & 1) : 0;
  const int QB = MODE == 0 ? 64 : 128;
  const int Lk = grp == 0 ? SEQP : LKS;
  const int tok0 = grp == 0 ? (b * SEQ + qblk * QB) : (TP + b * 64);
  const int qpos0 = grp == 0 ? qblk * QB : PAST;
  const int krow0 = grp == 0 ? b * SEQ : TP + b * LKS;
  int nkt;
  if (grp == 0) nkt = MODE == 0 ? (qblk + 1) : (2 * qblk + 2); else nkt = 33;
  int my_last = nkt - 1; bool active = true;
  if (MODE == 1) { if (grp == 0) my_last = 2 * qblk + (wid >> 1); else active = (wid < 2); }
  const int qtok = tok0 + qsub * 32 + l31;
  const int qpos = qpos0 + qsub * 32 + l31;

  bf16x8 qf[DQ / 16];
  if (MODE == 0) {
    const bf16_t* q = (const bf16_t*)(ws + W_C) + (size_t)qtok * LDH + h * 128 + comp * 64 + hh * 8;
#pragma unroll
    for (int ks = 0; ks < 4; ++ks) qf[ks] = *(const bf16x8*)(q + ks * 16);
  } else {
    const int qt = active ? qtok : tok0;
    const bf16_t* q = (const bf16_t*)(ws + W_B) + (size_t)qt * LDH + h * 64 + hh * 8;
#pragma unroll
    for (int ks = 0; ks < 4; ++ks) qf[ks] = *(const bf16x8*)(q + ks * 16);
    const bf16_t* qp = (const bf16_t*)(ws + F_ZCQ) + (size_t)qt * 512 + h * 32 + hh * 8;
    bf16x8 a = *(const bf16x8*)(qp), c = *(const bf16x8*)(qp + 16);
    const float2* rt = (const float2*)(ws + W_ROPE) + (size_t)(active ? qpos : qpos0) * 16 + hh * 8;
    float o1[8], o2[8];
#pragma unroll
    for (int j = 0; j < 8; ++j) {
      const float x1 = bf2f((bf16_t)a[j]), x2 = bf2f((bf16_t)c[j]); const float2 cs = rt[j];
      o1[j] = x1 * cs.x - x2 * cs.y; o2[j] = x1 * cs.y + x2 * cs.x;
    }
    u32x4 w1, w2;
    w1.x = pk2(o1[0], o1[1]); w1.y = pk2(o1[2], o1[3]); w1.z = pk2(o1[4], o1[5]); w1.w = pk2(o1[6], o1[7]);
    w2.x = pk2(o2[0], o2[1]); w2.y = pk2(o2[2], o2[3]); w2.z = pk2(o2[4], o2[5]); w2.w = pk2(o2[6], o2[7]);
    qf[4] = __builtin_bit_cast(bf16x8, w1); qf[5] = __builtin_bit_cast(bf16x8, w2);
  }

  const bf16_t* kg; const bf16_t* kpe; const bf16_t* vg;
  if (MODE == 0) {
    kg = (const bf16_t*)(ws + W_D) + (size_t)krow0 * LDH + h * 128;
    kpe = nullptr;
    vg = grp == 0 ? (const bf16_t*)(ws + W_D2) + (size_t)(b * 1024 + h * 128) * SEQP : (const bf16_t*)(ws + W_D2 + SZ_VTP) + (size_t)(b * 1024 + h * 128) * LKS;
  } else {
    kg = (const bf16_t*)(ws + W_D) + (size_t)krow0 * LDH + h * 64;
    kpe = (const bf16_t*)(ws + W_KPE) + (size_t)krow0 * 32;
    vg = grp == 0 ? (const bf16_t*)(ws + W_D2) + (size_t)(b * 1024 + h * 64) * SEQP : (const bf16_t*)(ws + W_D2 + SZ_VTP) + (size_t)(b * 1024 + h * 64) * LKS;
  }
  u32x4 rk[NKC], rv[NVC];
  int koff[NKC], voff[NVC];
#pragma unroll
  for (int i = 0; i < NKC; ++i) { const int q = tid + 256 * i; koff[i] = (q / KCH) * LDH + (q % KCH) * 8; }
#pragma unroll
  for (int i = 0; i < NVC; ++i) { const int q = tid + 256 * i; voff[i] = (q >> 3) * Lk + (q & 7) * 8; }
  auto gloadK = [&](int kt) {
    const bf16_t* ktile = kg + (size_t)kt * 64 * LDH;
#pragma unroll
    for (int i = 0; i < NKC; ++i) {
      if (MODE == 0) rk[i] = *(const u32x4*)(ktile + koff[i]);
      else {
        const int q = tid + 256 * i; const int row = q / KCH, ch = q % KCH;
        const bf16_t* src = (ch < 8) ? kg + (size_t)(kt * 64 + row) * LDH + ch * 8 : kpe + (size_t)(kt * 64 + row) * 32 + (ch - 8) * 8;
        rk[i] = *(const u32x4*)src;
      }
    }
  };
  auto gloadV = [&](int kt) {
    const bf16_t* vtile = vg + kt * 64;
#pragma unroll
    for (int i = 0; i < NVC; ++i) rv[i] = *(const u32x4*)(vtile + voff[i]);
  };
  auto lwriteK = [&](int buf) {
    char* base = lds + buf * BUF;
#pragma unroll
    for (int i = 0; i < NKC; ++i) { const int q = tid + 256 * i; const int row = q / KCH, ch = q % KCH; *(u32x4*)(base + row * KSTR + ch * 16) = rk[i]; }
  };
  auto lwriteV = [&](int buf) {
    char* base = lds + buf * BUF;
#pragma unroll
    for (int i = 0; i < NVC; ++i) { const int q = tid + 256 * i; const int row = q >> 3, ch = q & 7; *(u32x4*)(base + KBYTES + row * 144 + ch * 16) = rv[i]; }
  };

  f32x16 O[DV / 32];
#pragma unroll
  for (int i = 0; i < DV / 32; ++i)
#pragma unroll
    for (int r = 0; r < 16; ++r) O[i][r] = 0.f;
  float m = -1e30f, l = 0.f;
  const float* btab = (const float*)(ws + W_MISC) + 64 + h * 192;

  gloadK(0); gloadV(0); lwriteK(0); lwriteV(0);
  __syncthreads();
  for (int kt = 0; kt < nkt; ++kt) {
    const bool more = (kt + 1 < nkt);
    if (more) { gloadK(kt + 1); if (MODE == 1) gloadV(kt + 1); }
    if (active && kt <= my_last) {
      const char* base = lds + (kt & 1) * BUF;
      f32x16 S[2];
      const char* kp0 = base + l31 * KSTR + comp * 128 + hh * 16;
#pragma unroll
      for (int sub = 0; sub < 2; ++sub) {
#pragma unroll
        for (int r = 0; r < 16; ++r) S[sub][r] = 0.f;
#pragma unroll
        for (int ks = 0; ks < DQ / 16; ++ks) {
          bf16x8 kf = *(const bf16x8*)(kp0 + sub * 32 * KSTR + ks * 32);
          S[sub] = mfma32(kf, qf[ks], S[sub]);
        }
      }
      if (MODE == 0) {
        const int kpos0 = kt * 64;
        if (kpos0 + 63 > qpos0 - 91) {
#pragma unroll
          for (int sub = 0; sub < 2; ++sub)
#pragma unroll
            for (int r = 0; r < 16; ++r) {
              int rel = kpos0 + sub * 32 + accrow(r, hh) - qpos; rel = rel < -128 ? -128 : rel;
              S[sub][r] += btab[rel + 128];
            }
        }
      }
      __builtin_amdgcn_sched_barrier(0);
      float mx = S[0][0];
#pragma unroll
      for (int sub = 0; sub < 2; ++sub)
#pragma unroll
        for (int r = 0; r < 16; ++r) mx = fmaxf(mx, S[sub][r]);
      mx = fmaxf(mx, __shfl_xor(mx, 32));
      if (__any(mx > m)) {
        const float mn = fmaxf(m, mx);
        const float alpha = __builtin_amdgcn_exp2f(m - mn);
        m = mn; l *= alpha;
#pragma unroll
        for (int i = 0; i < DV / 32; ++i)
#pragma unroll
          for (int r = 0; r < 16; ++r) O[i][r] *= alpha;
      }
      f32v2_t ps2 = {0.f, 0.f}; const f32v2_t m2 = {m, m};
#pragma unroll
      for (int sub = 0; sub < 2; ++sub)
#pragma unroll
        for (int r = 0; r < 16; r += 2) {
          f32v2_t v = (f32v2_t){S[sub][r], S[sub][r + 1]} - m2;
          v[0] = __builtin_amdgcn_exp2f(v[0]); v[1] = __builtin_amdgcn_exp2f(v[1]);
          S[sub][r] = v[0]; S[sub][r + 1] = v[1]; ps2 += v;
        }
      l += ps2[0] + ps2[1];
      if (MODE == 0 && more) { lwriteK((kt + 1) & 1); gloadV(kt + 1); }
      const char* vp0 = base + KBYTES + l31 * 144 + hh * 16;
#pragma unroll
      for (int sub = 0; sub < 2; ++sub)
#pragma unroll
        for (int s = 0; s < 2; ++s) {
          u32x4 w;
          w.x = pk2(S[sub][8 * s + 0], S[sub][8 * s + 1]); w.y = pk2(S[sub][8 * s + 2], S[sub][8 * s + 3]);
          w.z = pk2(S[sub][8 * s + 4], S[sub][8 * s + 5]); w.w = pk2(S[sub][8 * s + 6], S[sub][8 * s + 7]);
          const bf16x8 pf = __builtin_bit_cast(bf16x8, w);
          __builtin_amdgcn_sched_barrier(0);
#pragma unroll
          for (int blk = 0; blk < DV / 32; ++blk) {
            bf16x8 vf = *(const bf16x8*)(vp0 + blk * 32 * 144 + sub * 64 + s * 32);
            O[blk] = mfma32(vf, pf, O[blk]);
          }
        }
    }
    if (more) { if (MODE == 1) lwriteK((kt + 1) & 1); lwriteV((kt + 1) & 1); }
    __syncthreads();
  }
  const float lt = l + __shfl_xor(l, 32);
  const float inv = 1.f / lt;
  if (MODE == 0) {
    float* xch = (float*)lds;
    const float lam = ((const float*)(ws + W_MISC))[0];
    if (comp == 1) {
#pragma unroll
      for (int blk = 0; blk < 4; ++blk)
#pragma unroll
        for (int r = 0; r < 16; ++r) xch[(qsub * 32 + l31) * 132 + blk * 32 + accrow(r, hh)] = O[blk][r] * inv * lam;
    }
    __syncthreads();
    if (comp == 0 && !dry) {
      float ss = 0.f;
#pragma unroll
      for (int blk = 0; blk < 4; ++blk)
#pragma unroll
        for (int r = 0; r < 16; ++r) { const float v = O[blk][r] * inv - xch[(qsub * 32 + l31) * 132 + blk * 32 + accrow(r, hh)]; O[blk][r] = v; ss += v * v; }
      ss += __shfl_xor(ss, 32);
      const float rs = rsqrtf(ss * (1.f / 128.f) + EPS) * 0.8f;
      bf16_t* o = (bf16_t*)(ws + W_C) + (size_t)qtok * LDH + h * 128;
      const float* sg = p.in[10];
#pragma unroll
      for (int blk = 0; blk < 4; ++blk)
#pragma unroll
        for (int g = 0; g < 4; ++g) {
          const int dv = blk * 32 + 8 * g + 4 * hh;
          f32x4 gg = *(const f32x4*)(sg + dv);
          u32x2 w; w.x = pk2(O[blk][4 * g] * rs * gg[0], O[blk][4 * g + 1] * rs * gg[1]); w.y = pk2(O[blk][4 * g + 2] * rs * gg[2], O[blk][4 * g + 3] * rs * gg[3]);
          *(u32x2*)(o + dv) = w;
        }
    }
    __syncthreads();
  } else {
    if (active && !dry) {
      bf16_t* o = (bf16_t*)(ws + W_B) + (size_t)qtok * LDH + h * 64;
#pragma unroll
      for (int blk = 0; blk < 2; ++blk)
#pragma unroll
        for (int g = 0; g < 4; ++g) {
          const int dv = blk * 32 + 8 * g + 4 * hh;
          u32x2 w; w.x = pk2(O[blk][4 * g] * inv, O[blk][4 * g + 1] * inv); w.y = pk2(O[blk][4 * g + 2] * inv, O[blk][4 * g + 3] * inv);
          *(u32x2*)(o + dv) = w;
        }
    }
  }
}

__device__ void attn_item_mla(const Params& p, char* lds, int grp, int b, int h, int qblk, int dry) {
  constexpr int KSTR = 208, KBYTES = 64 * KSTR, BUF = KBYTES + 64 * 144;
  char* ws = p.ws;
  int tid = threadIdx.x; asm volatile("" : "+v"(tid));
  const int lane = tid & 63, wid = tid >> 6, hh = lane >> 5, l31 = lane & 31;
  const int Lk = grp == 0 ? SEQP : LKS;
  const int tok0 = grp == 0 ? (b * SEQ + qblk * 256) : (TP + b * 64);
  const int qpos0 = grp == 0 ? qblk * 256 : PAST;
  const int krow0 = grp == 0 ? b * SEQ : TP + b * LKS;
  const int nkt = grp == 0 ? (4 * qblk + 4) : 33;
  const int my_last = grp == 0 ? (4 * qblk + wid) : 32;
  const bool active = grp == 0 ? true : (wid == 0);
  bf16x8 qf[2][6];
#pragma unroll
  for (int qs = 0; qs < 2; ++qs) {
    const int qt = active ? tok0 + wid * 64 + qs * 32 + l31 : tok0;
    const int qp = active ? qpos0 + wid * 64 + qs * 32 + l31 : qpos0;
    const bf16_t* q = (const bf16_t*)(ws + W_B) + (size_t)qt * LDH + h * 64 + hh * 8;
#pragma unroll
    for (int ks = 0; ks < 4; ++ks) qf[qs][ks] = *(const bf16x8*)(q + ks * 16);
    const bf16_t* qpe = (const bf16_t*)(ws + F_ZCQ) + (size_t)qt * 512 + h * 32 + hh * 8;
    const bf16x8 a = *(const bf16x8*)(qpe), c = *(const bf16x8*)(qpe + 16);
    const float2* rt = (const float2*)(ws + W_ROPE) + (size_t)qp * 16 + hh * 8;
    float o1[8], o2[8];
#pragma unroll
    for (int j = 0; j < 8; ++j) {
      const float x1 = bf2f((bf16_t)a[j]), x2 = bf2f((bf16_t)c[j]); const float2 cs = rt[j];
      o1[j] = x1 * cs.x - x2 * cs.y; o2[j] = x1 * cs.y + x2 * cs.x;
    }
    u32x4 w1, w2;
    w1.x = pk2(o1[0], o1[1]); w1.y = pk2(o1[2], o1[3]); w1.z = pk2(o1[4], o1[5]); w1.w = pk2(o1[6], o1[7]);
    w2.x = pk2(o2[0], o2[1]); w2.y = pk2(o2[2], o2[3]); w2.z = pk2(o2[4], o2[5]); w2.w = pk2(o2[6], o2[7]);
    qf[qs][4] = __builtin_bit_cast(bf16x8, w1); qf[qs][5] = __builtin_bit_cast(bf16x8, w2);
  }
  const bf16_t* kg = (const bf16_t*)(ws + W_D) + (size_t)krow0 * LDH + h * 64;
  const bf16_t* kpe = (const bf16_t*)(ws + W_KPE) + (size_t)krow0 * 32;
  const bf16_t* vg = grp == 0 ? (const bf16_t*)(ws + W_D2) + (size_t)(b * 1024 + h * 64) * SEQP : (const bf16_t*)(ws + W_D2 + SZ_VTP) + (size_t)(b * 1024 + h * 64) * LKS;
  u32x4 rk[3], rv[2];
  auto gload = [&](int kt) {
#pragma unroll
    for (int i = 0; i < 3; ++i) {
      const int q = tid + 256 * i; const int row = q / 12, ch = q % 12;
      const bf16_t* src = (ch < 8) ? kg + (size_t)(kt * 64 + row) * LDH + ch * 8 : kpe + (size_t)(kt * 64 + row) * 32 + (ch - 8) * 8;
      rk[i] = *(const u32x4*)src;
    }
#pragma unroll
    for (int i = 0; i < 2; ++i) { const int q = tid + 256 * i; const int row = q >> 3, ch = q & 7; rv[i] = *(const u32x4*)(vg + (size_t)row * Lk + kt * 64 + ch * 8); }
  };
  auto lwrite = [&](int buf) {
    char* base = lds + buf * BUF;
#pragma unroll
    for (int i = 0; i < 3; ++i) { const int q = tid + 256 * i; const int row = q / 12, ch = q % 12; *(u32x4*)(base + row * KSTR + ch * 16) = rk[i]; }
#pragma unroll
    for (int i = 0; i < 2; ++i) { const int q = tid + 256 * i; const int row = q >> 3, ch = q & 7; *(u32x4*)(base + KBYTES + row * 144 + ch * 16) = rv[i]; }
  };
  f32x16 O[2][2];
#pragma unroll
  for (int qs = 0; qs < 2; ++qs)
#pragma unroll
    for (int i = 0; i < 2; ++i)
#pragma unroll
      for (int r = 0; r < 16; ++r) O[qs][i][r] = 0.f;
  float m[2] = {-1e30f, -1e30f}, l[2] = {0.f, 0.f};
  gload(0); lwrite(0);
  __syncthreads();
  for (int kt = 0; kt < nkt; ++kt) {
    const bool more = (kt + 1 < nkt);
    if (more) gload(kt + 1);
    if (active && kt <= my_last) {
      const char* base = lds + (kt & 1) * BUF;
      const char* kp0 = base + l31 * KSTR + hh * 16;
      const char* vp0 = base + KBYTES + l31 * 144 + hh * 16;
#pragma unroll 1
      for (int sub = 0; sub < 2; ++sub) {
        f32x16 S[2];
#pragma unroll
        for (int r = 0; r < 16; ++r) { S[0][r] = 0.f; S[1][r] = 0.f; }
#pragma unroll
        for (int ks = 0; ks < 6; ++ks) {
          const bf16x8 kf = *(const bf16x8*)(kp0 + sub * 32 * KSTR + ks * 32);
          S[0] = mfma32(kf, qf[0][ks], S[0]);
          S[1] = mfma32(kf, qf[1][ks], S[1]);
        }
#pragma unroll
        for (int qs = 0; qs < 2; ++qs) {
          float mx = S[qs][0];
#pragma unroll
          for (int r = 1; r < 16; ++r) mx = fmaxf(mx, S[qs][r]);
          mx = fmaxf(mx, __shfl_xor(mx, 32));
          if (__any(mx > m[qs])) {
            const float mn = fmaxf(m[qs], mx);
            const float alpha = __builtin_amdgcn_exp2f(m[qs] - mn);
            m[qs] = mn; l[qs] *= alpha;
#pragma unroll
            for (int i = 0; i < 2; ++i)
#pragma unroll
              for (int r = 0; r < 16; ++r) O[qs][i][r] *= alpha;
          }
          f32v2_t ps2 = {0.f, 0.f}; const f32v2_t m2 = {m[qs], m[qs]};
#pragma unroll
          for (int r = 0; r < 16; r += 2) {
            f32v2_t v = (f32v2_t){S[qs][r], S[qs][r + 1]} - m2;
            v[0] = __builtin_amdgcn_exp2f(v[0]); v[1] = __builtin_amdgcn_exp2f(v[1]);
            S[qs][r] = v[0]; S[qs][r + 1] = v[1]; ps2 += v;
          }
          l[qs] += ps2[0] + ps2[1];
        }
#pragma unroll
        for (int s2 = 0; s2 < 2; ++s2) {
          u32x4 w0, w1;
          w0.x = pk2(S[0][8 * s2 + 0], S[0][8 * s2 + 1]); w0.y = pk2(S[0][8 * s2 + 2], S[0][8 * s2 + 3]);
          w0.z = pk2(S[0][8 * s2 + 4], S[0][8 * s2 + 5]); w0.w = pk2(S[0][8 * s2 + 6], S[0][8 * s2 + 7]);
          w1.x = pk2(S[1][8 * s2 + 0], S[1][8 * s2 + 1]); w1.y = pk2(S[1][8 * s2 + 2], S[1][8 * s2 + 3]);
          w1.z = pk2(S[1][8 * s2 + 4], S[1][8 * s2 + 5]); w1.w = pk2(S[1][8 * s2 + 6], S[1][8 * s2 + 7]);
          const bf16x8 pf0 = __builtin_bit_cast(bf16x8, w0), pf1 = __builtin_bit_cast(bf16x8, w1);
#pragma unroll
          for (int blk = 0; blk < 2; ++blk) {
            const bf16x8 vf = *(const bf16x8*)(vp0 + blk * 32 * 144 + sub * 64 + s2 * 32);
            O[0][blk] = mfma32(vf, pf0, O[0][blk]);
            O[1][blk] = mfma32(vf, pf1, O[1][blk]);
          }
        }
      }
    }
    if (more) lwrite((kt + 1) & 1);
    __syncthreads();
  }
  if (active && !dry) {
#pragma unroll
    for (int qs = 0; qs < 2; ++qs) {
      const float lt = l[qs] + __shfl_xor(l[qs], 32);
      const float inv = 1.f / lt;
      const int qtok = tok0 + wid * 64 + qs * 32 + l31;
      bf16_t* o = (bf16_t*)(ws + W_B) + (size_t)qtok * LDH + h * 64;
#pragma unroll
      for (int blk = 0; blk < 2; ++blk)
#pragma unroll
        for (int g = 0; g < 4; ++g) {
          const int dv = blk * 32 + 8 * g + 4 * hh;
          u32x2 w; w.x = pk2(O[qs][blk][4 * g] * inv, O[qs][blk][4 * g + 1] * inv); w.y = pk2(O[qs][blk][4 * g + 2] * inv, O[qs][blk][4 * g + 3] * inv);
          *(u32x2*)(o + dv) = w;
        }
    }
  }
}

__device__ void phase_attn_diff(const Params& p, char* lds, int* s_item, int dry) {
  const int x = blockIdx.x & 7;
  const int total = 512 + 8;
  unsigned* q = (unsigned*)(p.ws + W_BAR) + QW + dry * 8 + x;
  for (;;) {
    if (threadIdx.x == 0) *s_item = (int)__hip_atomic_fetch_add(q, 1u, __ATOMIC_RELAXED, __HIP_MEMORY_SCOPE_AGENT);
    __syncthreads();
    const int u = *s_item;
    __syncthreads();
    if (u >= total) break;
    int grp = 0, bh, qblk = 0;
    if (u < 256) { qblk = 63 - (u >> 3); bh = (u & 7) * 8 + x; }
    else if (u < 264) { grp = 1; bh = (u - 256) * 8 + x; }
    else { const int v = u - 8; qblk = 63 - (v >> 3); bh = (v & 7) * 8 + x; }
    attn_item<0>(p, lds, grp, bh >> 3, bh & 7, qblk, dry);
  }
}
__device__ void phase_attn_mla(const Params& p, char* lds, int* s_item, int dry) {
  const int x = blockIdx.x & 7;
  const int total = 256 + 16;
  unsigned* q = (unsigned*)(p.ws + W_BAR) + QW + 16 + dry * 8 + x;
  for (;;) {
    if (threadIdx.x == 0) *s_item = (int)__hip_atomic_fetch_add(q, 1u, __ATOMIC_RELAXED, __HIP_MEMORY_SCOPE_AGENT);
    __syncthreads();
    const int u = *s_item;
    __syncthreads();
    if (u >= total) break;
    int grp = 0, bh, qblk = 0;
    if (u < 128) { qblk = 15 - (u >> 4); bh = (u & 15) * 8 + x; }
    else if (u < 144) { grp = 1; bh = (u - 128) * 8 + x; }
    else { const int v = u - 16; qblk = 15 - (v >> 4); bh = (v & 15) * 8 + x; }
    attn_item_mla(p, lds, grp, bh >> 4, bh & 15, qblk, dry);
  }
}

__device__ void phase_mla_expand(const Params& p, char* lds) {
  char* ws = p.ws;
  const int lane = threadIdx.x & 63, wid = threadIdx.x >> 6, wr = wid >> 1, wc = wid & 1, hh = lane >> 5, l31 = lane & 31;
  for (int it = 0, setB = 0;; ++it) {
    int mt, nt;
    if (!setB) { if (!tile_at(260, 12, it, mt, nt)) { setB = 1; it = -1; continue; } }
    else if (!tile_at(388, 16, it, mt, nt)) break;
    f32x16 acc[2][2]; zero_acc(acc);
    const int m0 = mt * 128, n0 = nt * 128;
    if (!setB) {
      gemm_mainloop<true>((const bf16_t*)(ws + F_CQ) + (size_t)m0 * LDQ, LDQ, (const bf16_t*)(ws + W_WUQ) + (size_t)n0 * LDQ, LDQ, 256, acc, lds, 2 * ((mt + nt) & 7));
      const float sc = 0.10206207261596577f * LOG2E;
#pragma unroll
      for (int i = 0; i < 2; ++i)
#pragma unroll
        for (int j = 0; j < 2; ++j) {
          const int tok = m0 + wr * 64 + i * 32 + l31; const int cb = n0 + wc * 64 + j * 32;
          if (nt < 8) st_bf16_sw((bf16_t*)(ws + W_B) + (size_t)tok * LDH + cb, acc[i][j], hh, sc);
          else st_bf16_sw((bf16_t*)(ws + F_ZCQ) + (size_t)tok * 512 + (cb - 1024), acc[i][j], hh, sc);
        }
    } else if (nt < 8) {
      gemm_mainloop<true>((const bf16_t*)(ws + W_G) + (size_t)m0 * LDK, LDK, (const bf16_t*)(ws + W_WUKV) + (size_t)n0 * LDK, LDK, 128, acc, lds, 2 * ((mt + nt) & 7));
#pragma unroll
      for (int i = 0; i < 2; ++i)
#pragma unroll
        for (int j = 0; j < 2; ++j) {
          const int row = m0 + wr * 64 + i * 32 + l31; const int cb = n0 + wc * 64 + j * 32;
          st_bf16_sw((bf16_t*)(ws + W_D) + (size_t)row * LDH + cb, acc[i][j], hh, 1.f);
        }
    } else {
      gemm_mainloop<false>((const bf16_t*)(ws + W_G) + (size_t)m0 * LDK, LDK, (const bf16_t*)(ws + W_WUKV) + (size_t)n0 * LDK, LDK, 128, acc, lds, 2 * ((mt + nt) & 7));
#pragma unroll
      for (int i = 0; i < 2; ++i)
#pragma unroll
        for (int j = 0; j < 2; ++j) {
          const int mb = m0 + wr * 64 + i * 32; const int nn = n0 - 1024 + wc * 64 + j * 32 + l31;
          bf16_t* vt; int key32;
          if (mb < TP) { const int b = mb >> 12; vt = (bf16_t*)(ws + W_D2) + ((size_t)(b * 1024 + nn)) * SEQP; key32 = mb & 4095; }
          else { const int x = mb - TP; const int b = x / LKS; vt = (bf16_t*)(ws + W_D2 + SZ_VTP) + ((size_t)(b * 1024 + nn)) * LKS; key32 = x - b * LKS; }
          vt_store(vt, key32, acc[i][j], hh);
        }
    }
  }
}

__device__ void phase_merge(const Params& p, char* lds) {
  char* ws = p.ws;
  const int lane = threadIdx.x & 63, wid = threadIdx.x >> 6, wr = wid >> 1, wc = wid & 1, hh = lane >> 5, l31 = lane & 31;
  const bf16_t* gates = (const bf16_t*)(p.out + O_Y);
  bf16_t* mg = (bf16_t*)(ws + W_F);
  for (int it = 0;; ++it) {
    int mt, nt; if (!tile_at(260, 8, it, mt, nt)) break;
    const int m0 = mt * 128, n0 = nt * 128;
    {
      f32x16 acc[2][2]; zero_acc(acc);
      gemm_mainloop<true>((const bf16_t*)(ws + W_C) + (size_t)m0 * LDH, LDH, (const bf16_t*)(ws + W_WA) + (size_t)n0 * LDH, LDH, 1024, acc, lds, 2 * ((mt + nt) & 7));
#pragma unroll
      for (int i = 0; i < 2; ++i)
#pragma unroll
        for (int j = 0; j < 2; ++j) {
          const int tok = m0 + wr * 64 + i * 32 + l31; const int cb = n0 + wc * 64 + j * 32;
          const bf16_t* gp = gates + (size_t)tok * 2048 + cb + 4 * hh;
          bf16_t* op = mg + (size_t)tok * LDH + cb + 4 * hh;
#pragma unroll
          for (int g = 0; g < 4; ++g) {
            const u32x2 gv = *(const u32x2*)(gp + 8 * g);
            u32x2 w;
            w.x = pk2(acc[i][j][4 * g] * bflo(gv.x), acc[i][j][4 * g + 1] * bfhi(gv.x));
            w.y = pk2(acc[i][j][4 * g + 2] * bflo(gv.y), acc[i][j][4 * g + 3] * bfhi(gv.y));
            *(u32x2*)(op + 8 * g) = w;
          }
        }
    }
    {
      f32x16 acc[2][2]; zero_acc(acc);
      gemm_mainloop<true>((const bf16_t*)(ws + W_B) + (size_t)m0 * LDH, LDH, (const bf16_t*)(ws + W_WB) + (size_t)n0 * LDH, LDH, 1024, acc, lds, 2 * ((mt + nt) & 7));
      int l31b = l31; asm volatile("" : "+v"(l31b));
#pragma unroll
      for (int i = 0; i < 2; ++i)
#pragma unroll
        for (int j = 0; j < 2; ++j) {
          const int tok = m0 + wr * 64 + i * 32 + l31b; const int cb = n0 + wc * 64 + j * 32;
          const bf16_t* gp = gates + (size_t)tok * 2048 + 1024 + cb + 4 * hh;
          bf16_t* op = mg + (size_t)tok * LDH + cb + 4 * hh;
#pragma unroll
          for (int g = 0; g < 4; ++g) {
            const u32x2 gv = *(const u32x2*)(gp + 8 * g);
            const u32x2 pv = *(const u32x2*)(op + 8 * g);
            u32x2 w;
            w.x = pk2(bflo(pv.x) + acc[i][j][4 * g] * bflo(gv.x), bfhi(pv.x) + acc[i][j][4 * g + 1] * bfhi(gv.x));
            w.y = pk2(bflo(pv.y) + acc[i][j][4 * g + 2] * bflo(gv.y), bfhi(pv.y) + acc[i][j][4 * g + 3] * bfhi(gv.y));
            *(u32x2*)(op + 8 * g) = w;
          }
        }
    }
  }
}

__device__ void phase_outproj(const Params& p, char* lds) {
  char* ws = p.ws;
  const int lane = threadIdx.x & 63, wid = threadIdx.x >> 6, wr = wid >> 1, wc = wid & 1, hh = lane >> 5, l31 = lane & 31;
  float* x1 = (float*)(ws + D_X1);
  for (int it = 0;; ++it) {
    int mt, nt; if (!tile_at(260, 8, it, mt, nt)) break;
    const int m0 = mt * 128, n0 = nt * 128;
    f32x16 acc[2][2]; zero_acc(acc);
    gemm_mainloop<true>((const bf16_t*)(ws + W_F) + (size_t)m0 * LDH, LDH, (const bf16_t*)(ws + W_WO) + (size_t)n0 * LDH, LDH, 1024, acc, lds, 2 * ((mt + nt) & 7));
#pragma unroll
    for (int i = 0; i < 2; ++i)
#pragma unroll
      for (int j = 0; j < 2; ++j) {
        const int tok = m0 + wr * 64 + i * 32 + l31; const int cb = n0 + wc * 64 + j * 32 + 4 * hh;
        const float* xr = ((tok < TP) ? p.in[0] + (size_t)tok * 1024 : p.in[1] + (size_t)(tok - TP) * 1024) + cb;
        float* orow = x1 + (size_t)tok * 1024 + cb;
#pragma unroll
        for (int g = 0; g < 4; ++g) {
          const f32x4 xv = *(const f32x4*)(xr + 8 * g);
          f32x4 w = {xv[0] + acc[i][j][4 * g], xv[1] + acc[i][j][4 * g + 1], xv[2] + acc[i][j][4 * g + 2], xv[3] + acc[i][j][4 * g + 3]};
          *(f32x4*)(orow + 8 * g) = w;
        }
      }
  }
}

__device__ void phase_ffn_norm(const Params& p) {
  char* ws = p.ws;
  const int gtid = blockIdx.x * 256 + threadIdx.x, gthreads = gridDim.x * 256;
  const int gw = gtid >> 6, nw = gthreads >> 6, lane = threadIdx.x & 63;
  const float* x1 = (const float*)(ws + D_X1); bf16_t* hf = (bf16_t*)(ws + W_C); const float* g = p.in[19];
  for (int t = gw; t < T; t += nw) {
    const float* x = x1 + (size_t)t * DM;
    f32x4 v[4]; float ss = 0.f;
#pragma unroll
    for (int i = 0; i < 4; ++i) { v[i] = *(const f32x4*)(x + i * 256 + lane * 4); ss += v[i][0] * v[i][0] + v[i][1] * v[i][1] + v[i][2] * v[i][2] + v[i][3] * v[i][3]; }
    ss = wave_sum(ss);
    const float rs = rsqrtf(ss * (1.f / DM) + EPS);
#pragma unroll
    for (int i = 0; i < 4; ++i) {
      f32x4 gg = *(const f32x4*)(g + i * 256 + lane * 4);
      u32x2 w; w.x = pk2(v[i][0] * rs * gg[0], v[i][1] * rs * gg[1]); w.y = pk2(v[i][2] * rs * gg[2], v[i][3] * rs * gg[3]);
      *(u32x2*)(hf + (size_t)t * LDH + i * 256 + lane * 4) = w;
    }
  }
  unsigned char* q8 = (unsigned char*)(ws + W_F); float* qs = (float*)(ws + W_F + 33554432);
  for (int r = gw; r < 2 * 16384; r += nw) {
    const float* src = (r < 16384) ? p.in[22] + (size_t)r * DM : p.in[23] + (size_t)(r - 16384) * DM;
    f32x4 v[4]; float am = 0.f;
#pragma unroll
    for (int i = 0; i < 4; ++i) { v[i] = *(const f32x4*)(src + lane * 16 + i * 4); am = fmaxf(am, fmaxf(fmaxf(fabsf(v[i][0]), fabsf(v[i][1])), fmaxf(fabsf(v[i][2]), fabsf(v[i][3])))); }
#pragma unroll
    for (int o = 32; o >= 1; o >>= 1) am = fmaxf(am, __shfl_xor(am, o));
    const float sc = am > 0.f ? 224.f / am : 1.f;
    u32x4 w;
#pragma unroll
    for (int i = 0; i < 4; ++i) {
      int d = 0;
      d = __builtin_amdgcn_cvt_pk_fp8_f32(v[i][0] * sc, v[i][1] * sc, d, false);
      d = __builtin_amdgcn_cvt_pk_fp8_f32(v[i][2] * sc, v[i][3] * sc, d, true);
      w[i] = (unsigned)d;
    }
    *(u32x4*)(q8 + (r < 16384 ? (size_t)r * 2048 : (size_t)(r - 16384) * 2048 + 1024) + lane * 16) = w;
    if (lane == 0) qs[r] = am > 0.f ? am / 224.f : 1.f;
  }
}

__device__ void phase_peer_q(const Params& p, char* lds) {
  char* ws = p.ws;
  const int lane = threadIdx.x & 63, wid = threadIdx.x >> 6, wr = wid >> 1, wc = wid & 1, hh = lane >> 5, l31 = lane & 31;
  bf16_t* pq = (bf16_t*)(ws + W_B);
  for (int it = 0;; ++it) {
    int mt, nt; if (!tile_at(260, 8, it, mt, nt)) break;
    const int m0 = mt * 128, n0 = nt * 128;
    f32x16 acc[2][2]; zero_acc(acc);
    gemm_mainloop<true>((const bf16_t*)(ws + W_C) + (size_t)m0 * LDH, LDH, (const bf16_t*)(ws + W_WQ) + (size_t)n0 * LDH, LDH, 1024, acc, lds, 2 * ((mt + nt) & 7));
#pragma unroll
    for (int i = 0; i < 2; ++i)
#pragma unroll
      for (int j = 0; j < 2; ++j) {
        const int tok = m0 + wr * 64 + i * 32 + l31; const int cb = n0 + wc * 64 + j * 32;
        st_bf16_sw(pq + (size_t)tok * LDH + cb, acc[i][j], hh, 1.f);
      }
  }
}

__device__ __forceinline__ unsigned fkey(float f) { unsigned u = __float_as_uint(f); return (u & 0x80000000u) ? ~u : (u | 0x80000000u); }
__device__ __forceinline__ float fkey_inv(unsigned k) { unsigned u = (k & 0x80000000u) ? (k & 0x7fffffffu) : ~k; return __uint_as_float(u); }
__device__ __forceinline__ void insert16(unsigned (&L)[16], unsigned x) {
#pragma unroll
  for (int i = 0; i < 16; ++i) { const unsigned hi = x > L[i] ? x : L[i]; x = x > L[i] ? L[i] : x; L[i] = hi; }
}
__device__ __forceinline__ void cswap_desc(unsigned& a, unsigned& b) { const unsigned hi = a > b ? a : b, lo = a > b ? b : a; a = hi; b = lo; }
__device__ __forceinline__ void sort16_desc(unsigned (&a)[16]) {
#pragma unroll
  for (int k = 2; k <= 16; k <<= 1)
#pragma unroll
    for (int j = k >> 1; j > 0; j >>= 1)
#pragma unroll
      for (int i = 0; i < 16; ++i) {
        const int l = i ^ j;
        if (l > i) { if ((i & k) == 0) cswap_desc(a[i], a[l]); else cswap_desc(a[l], a[i]); }
      }
}
template <bool SORT>
__device__ __forceinline__ void merge16_desc(unsigned (&a)[16], const unsigned (&b)[16]) {
#pragma unroll
  for (int i = 0; i < 16; ++i) a[i] = a[i] > b[15 - i] ? a[i] : b[15 - i];
  if (SORT) {
#pragma unroll
    for (int j = 8; j > 0; j >>= 1)
#pragma unroll
      for (int i = 0; i < 16; ++i) { const int l = i ^ j; if (l > i) cswap_desc(a[i], a[l]); }
  }
}
__device__ void phase_peer_select(const Params& p, char* lds) {
  char* ws = p.ws;
  const int tid = threadIdx.x, lane = tid & 63, wid = tid >> 6, hh = lane >> 5, l31 = lane & 31;
  const bf16_t* pq = (const bf16_t*)(ws + W_B); const bf16_t* keys = (const bf16_t*)(ws + W_KEYS);
  int* seli = (int*)(ws + D_SELI); float* selw = (float*)(ws + D_SELW);
  float* S = (float*)lds;
  unsigned* LH = (unsigned*)lds;
  unsigned* LF = LH + 2 * 64 * 20;
  for (int u = blockIdx.x; u < 520 * 8; u += gridDim.x) {
    const int tt = u >> 3, h = u & 7; const int t0 = tt * 64;
    {
      const int c = wid >> 1;
      f32x16 acc[2][2]; zero_acc(acc);
      const bf16_t* ap = pq + (size_t)(t0 + l31) * LDH + h * 128 + c * 64 + hh * 8;
      const bf16_t* bp = keys + ((size_t)((h * 2 + c) * 128 + (wid & 1) * 64 + l31)) * 64 + hh * 8;
#pragma unroll
      for (int ks = 0; ks < 4; ++ks) {
        bf16x8 a0 = *(const bf16x8*)(ap + ks * 16), a1 = *(const bf16x8*)(ap + 32 * LDH + ks * 16);
        bf16x8 b0 = *(const bf16x8*)(bp + ks * 16), b1 = *(const bf16x8*)(bp + 32 * 64 + ks * 16);
        acc[0][0] = mfma32(a0, b0, acc[0][0]); acc[0][1] = mfma32(a0, b1, acc[0][1]);
        acc[1][0] = mfma32(a1, b0, acc[1][0]); acc[1][1] = mfma32(a1, b1, acc[1][1]);
      }
#pragma unroll
      for (int i = 0; i < 2; ++i)
#pragma unroll
        for (int j = 0; j < 2; ++j)
#pragma unroll
          for (int r = 0; r < 16; ++r) S[(i * 32 + accrow(r, hh)) * 260 + c * 128 + (wid & 1) * 64 + j * 32 + l31] = acc[i][j][r];
    }
    __syncthreads();
    const int tok = lane, c = wid & 1, half = wid >> 1;
    unsigned L[16];
    {
      const float* sp = S + tok * 260 + c * 128 + half * 64;
#pragma unroll
      for (int grp = 0; grp < 4; ++grp) {
        unsigned G[16];
#pragma unroll
        for (int n4 = 0; n4 < 4; ++n4) {
          const f32x4 v = *(const f32x4*)(sp + grp * 16 + n4 * 4);
          const unsigned ib = (unsigned)(127 - (half * 64 + grp * 16 + n4 * 4));
#pragma unroll
          for (int e = 0; e < 4; ++e) G[n4 * 4 + e] = (fkey(v[e]) & ~127u) | (ib - e);
        }
        sort16_desc(G);
        if (grp == 0) {
#pragma unroll
          for (int i = 0; i < 16; ++i) L[i] = G[i];
        } else merge16_desc<true>(L, G);
      }
    }
    __syncthreads();
    if (half == 1) {
#pragma unroll
      for (int i = 0; i < 16; i += 4) { u32x4 w = {L[i], L[i + 1], L[i + 2], L[i + 3]}; *(u32x4*)(LH + (c * 64 + tok) * 20 + i) = w; }
    }
    __syncthreads();
    if (half == 0) {
      unsigned G[16];
#pragma unroll
      for (int i = 0; i < 16; i += 4) {
        const u32x4 w = *(const u32x4*)(LH + (c * 64 + tok) * 20 + i);
        G[i] = w[0]; G[i + 1] = w[1]; G[i + 2] = w[2]; G[i + 3] = w[3];
      }
      merge16_desc<true>(L, G);
#pragma unroll
      for (int i = 0; i < 16; i += 4) { u32x4 w = {L[i], L[i + 1], L[i + 2], L[i + 3]}; *(u32x4*)(LF + (c * 64 + tok) * 20 + i) = w; }
    }
    __syncthreads();
    if (wid == 0) {
      float a[16], b[16];
#pragma unroll
      for (int i = 0; i < 16; ++i) a[i] = fkey_inv(L[i]);
#pragma unroll
      for (int j = 0; j < 16; j += 4) {
        const u32x4 w = *(const u32x4*)(LF + (64 + tok) * 20 + j);
        b[j] = fkey_inv(w[0]); b[j + 1] = fkey_inv(w[1]); b[j + 2] = fkey_inv(w[2]); b[j + 3] = fkey_inv(w[3]);
      }
      unsigned M[16], G[16];
#pragma unroll
      for (int j = 0; j < 16; ++j) M[j] = (fkey(a[0] + b[j]) & ~255u) | (unsigned)(255 - j);
      sort16_desc(M);
#define PK_CAND(i, j) ((fkey(a[i] + b[j]) & ~255u) | (unsigned)(255 - ((i) * 16 + (j))))
      G[0] = PK_CAND(1, 0); G[1] = PK_CAND(1, 1); G[2] = PK_CAND(1, 2); G[3] = PK_CAND(1, 3); G[4] = PK_CAND(1, 4); G[5] = PK_CAND(1, 5); G[6] = PK_CAND(1, 6); G[7] = PK_CAND(1, 7);
      G[8] = PK_CAND(2, 0); G[9] = PK_CAND(2, 1); G[10] = PK_CAND(2, 2); G[11] = PK_CAND(2, 3); G[12] = PK_CAND(2, 4); G[13] = 0u; G[14] = 0u; G[15] = 0u;
      sort16_desc(G); merge16_desc<true>(M, G);
      G[0] = PK_CAND(3, 0); G[1] = PK_CAND(3, 1); G[2] = PK_CAND(3, 2); G[3] = PK_CAND(3, 3); G[4] = PK_CAND(4, 0); G[5] = PK_CAND(4, 1); G[6] = PK_CAND(4, 2);
      G[7] = PK_CAND(5, 0); G[8] = PK_CAND(5, 1); G[9] = PK_CAND(6, 0); G[10] = PK_CAND(6, 1); G[11] = PK_CAND(7, 0); G[12] = PK_CAND(7, 1); G[13] = 0u; G[14] = 0u; G[15] = 0u;
      sort16_desc(G); merge16_desc<true>(M, G);
      G[0] = PK_CAND(8, 0); G[1] = PK_CAND(9, 0); G[2] = PK_CAND(10, 0); G[3] = PK_CAND(11, 0); G[4] = PK_CAND(12, 0); G[5] = PK_CAND(13, 0); G[6] = PK_CAND(14, 0); G[7] = PK_CAND(15, 0);
#pragma unroll
      for (int i = 8; i < 16; ++i) G[i] = 0u;
      sort16_desc(G); merge16_desc<true>(M, G);
#undef PK_CAND
      const float mx = fkey_inv(M[0]);
      float ev[16], den = 0.f;
#pragma unroll
      for (int k = 0; k < 16; ++k) { ev[k] = __expf(fkey_inv(M[k]) - mx); den += ev[k]; }
      const float rden = 1.f / den;
      const size_t o = ((size_t)(t0 + tok) * 8 + h) * 16;
#pragma unroll
      for (int k4 = 0; k4 < 16; k4 += 4) {
        int id[4]; f32x4 wv;
#pragma unroll
        for (int e = 0; e < 4; ++e) {
          const int flat = 255 - (int)(M[k4 + e] & 255u);
          const int i1 = 127 - (int)(LF[tok * 20 + (flat >> 4)] & 127u), i2 = 127 - (int)(LF[(64 + tok) * 20 + (flat & 15)] & 127u);
          id[e] = i1 * 128 + i2; wv[e] = ev[k4 + e] * rden;
        }
        *(int4*)(seli + o + k4) = make_int4(id[0], id[1], id[2], id[3]);
        *(f32x4*)(selw + o + k4) = wv;
      }
    }
    __syncthreads();
  }
}

__device__ __forceinline__ void peer_token_part(const Params& p, int t, int e_lo, int e_hi, float (&ov)[16], int lane) {
  char* ws = p.ws;
  const bf16_t* hf = (const bf16_t*)(ws + W_C);
  const unsigned char* u8 = (const unsigned char*)(ws + W_F); const unsigned char* v8 = u8 + 1024;
  const float* qs = (const float*)(ws + W_F + 33554432);
  const int* seli = (const int*)(ws + D_SELI); const float* selw = (const float*)(ws + D_SELW);
  f32v2_t hv[8], o2[8];
  {
    u32x4 a = *(const u32x4*)(hf + (size_t)t * LDH + lane * 16), b = *(const u32x4*)(hf + (size_t)t * LDH + lane * 16 + 8);
#pragma unroll
    for (int i = 0; i < 4; ++i) { hv[i] = (f32v2_t){bflo(a[i]), bfhi(a[i])}; hv[4 + i] = (f32v2_t){bflo(b[i]), bfhi(b[i])}; }
#pragma unroll
    for (int i = 0; i < 8; ++i) o2[i] = (f32v2_t){ov[2 * i], ov[2 * i + 1]};
  }
  const int myi0 = seli[(size_t)t * 128 + lane], myi1 = seli[(size_t)t * 128 + 64 + lane];
  const float mysu0 = qs[myi0], mysu1 = qs[myi1];
  const float myw0 = selw[(size_t)t * 128 + lane] * qs[16384 + myi0], myw1 = selw[(size_t)t * 128 + 64 + lane] * qs[16384 + myi1];
  const int b0 = lane & 1, b1 = lane & 2, b2 = lane & 4;
  for (int e0 = e_lo; e0 < e_hi; e0 += 8) {
    u32x4 ua[8], va[8];
    const int esel = (e0 & 63) + (lane & 7);
    const float sul = __shfl(e0 < 64 ? mysu0 : mysu1, esel), gwl = __shfl(e0 < 64 ? myw0 : myw1, esel);
#pragma unroll
    for (int k = 0; k < 8; ++k) {
      const int idx = __shfl(e0 < 64 ? myi0 : myi1, (e0 & 63) + k);
      ua[k] = *(const u32x4*)(u8 + (size_t)idx * 2048 + lane * 16);
      va[k] = *(const u32x4*)(v8 + (size_t)idx * 2048 + lane * 16);
    }
    float d[8];
#pragma unroll
    for (int k = 0; k < 8; ++k) {
      f32v2_t acc = {0.f, 0.f};
#pragma unroll
      for (int i = 0; i < 4; ++i) {
        const f32v2_t lo = __builtin_amdgcn_cvt_pk_f32_fp8((int)ua[k][i], false), hi = __builtin_amdgcn_cvt_pk_f32_fp8((int)ua[k][i], true);
        acc = hv[2 * i] * lo + acc; acc = hv[2 * i + 1] * hi + acc;
      }
      d[k] = acc[0] + acc[1];
    }
    float v4[4], v2[2], v1;
#pragma unroll
    for (int j = 0; j < 4; ++j) { const float keep = b0 ? d[2 * j + 1] : d[2 * j], send = b0 ? d[2 * j] : d[2 * j + 1]; v4[j] = keep + __shfl_xor(send, 1); }
#pragma unroll
    for (int j = 0; j < 2; ++j) { const float keep = b1 ? v4[2 * j + 1] : v4[2 * j], send = b1 ? v4[2 * j] : v4[2 * j + 1]; v2[j] = keep + __shfl_xor(send, 2); }
    { const float keep = b2 ? v2[1] : v2[0], send = b2 ? v2[0] : v2[1]; v1 = keep + __shfl_xor(send, 4); }
    v1 += __shfl_xor(v1, 8); v1 += __shfl_xor(v1, 16); v1 += __shfl_xor(v1, 32);
    const float dl = v1 * sul;
    const float wl = gwl * (0.5f * dl * (1.f + erff(dl * 0.70710678118654752f)));
#pragma unroll
    for (int k = 0; k < 8; ++k) {
      const float w = __builtin_bit_cast(float, __builtin_amdgcn_readlane(__builtin_bit_cast(int, wl), k));
      const f32v2_t w2 = {w, w};
#pragma unroll
      for (int i = 0; i < 4; ++i) {
        const f32v2_t lo = __builtin_amdgcn_cvt_pk_f32_fp8((int)va[k][i], false), hi = __builtin_amdgcn_cvt_pk_f32_fp8((int)va[k][i], true);
        o2[2 * i] = w2 * lo + o2[2 * i]; o2[2 * i + 1] = w2 * hi + o2[2 * i + 1];
      }
    }
  }
#pragma unroll
  for (int i = 0; i < 8; ++i) { ov[2 * i] = o2[i][0]; ov[2 * i + 1] = o2[i][1]; }
}
__device__ __forceinline__ void peer_token_finish(const Params& p, int t, float (&ov)[16], int lane) {
  const float* xr = (const float*)(p.ws + D_X1) + (size_t)t * DM + lane * 16; const float* g = p.in[24] + lane * 16;
  float ss = 0.f;
#pragma unroll
  for (int i = 0; i < 4; ++i) { f32x4 a = *(const f32x4*)(xr + i * 4); ov[4 * i] += a[0]; ov[4 * i + 1] += a[1]; ov[4 * i + 2] += a[2]; ov[4 * i + 3] += a[3]; }
#pragma unroll
  for (int i = 0; i < 16; ++i) ss += ov[i] * ov[i];
  ss = wave_sum(ss);
  const float rs = rsqrtf(ss * (1.f / DM) + EPS);
  float* y = p.out + O_Y + (size_t)t * DM + lane * 16;
#pragma unroll
  for (int i = 0; i < 4; ++i) {
    f32x4 ga = *(const f32x4*)(g + i * 4); f32x4 o;
    o[0] = ov[4 * i] * rs * ga[0]; o[1] = ov[4 * i + 1] * rs * ga[1]; o[2] = ov[4 * i + 2] * rs * ga[2]; o[3] = ov[4 * i + 3] * rs * ga[3];
    *(f32x4*)(y + i * 4) = o;
  }
}
__device__ void phase_peer_gather(const Params& p, char* lds) {
  const int wid = threadIdx.x >> 6, lane = threadIdx.x & 63;
  const int gw = blockIdx.x * 4 + wid, nw = gridDim.x * 4;
  const int t_main = (T / nw) * nw;
  for (int t = gw; t < t_main; t += nw) {
    float ov[16];
#pragma unroll
    for (int i = 0; i < 16; ++i) ov[i] = 0.f;
    peer_token_part(p, t, 0, 128, ov, lane);
    peer_token_finish(p, t, ov, lane);
  }
  float* part = (float*)lds;
  for (int t = t_main + blockIdx.x; t < T; t += gridDim.x) {
    float ov[16];
#pragma unroll
    for (int i = 0; i < 16; ++i) ov[i] = 0.f;
    peer_token_part(p, t, wid * 32, wid * 32 + 32, ov, lane);
    if (wid > 0) {
#pragma unroll
      for (int i = 0; i < 4; ++i) { f32x4 w = {ov[4 * i], ov[4 * i + 1], ov[4 * i + 2], ov[4 * i + 3]}; *(f32x4*)(part + wid * 1024 + lane * 16 + i * 4) = w; }
    }
    __syncthreads();
    if (wid == 0) {
#pragma unroll
      for (int w = 1; w < 4; ++w)
#pragma unroll
        for (int i = 0; i < 4; ++i) { const f32x4 v = *(const f32x4*)(part + w * 1024 + lane * 16 + i * 4); ov[4 * i] += v[0]; ov[4 * i + 1] += v[1]; ov[4 * i + 2] += v[2]; ov[4 * i + 3] += v[3]; }
      peer_token_finish(p, t, ov, lane);
    }
    __syncthreads();
  }
}

constexpr int NPHASE = 12;
__global__ void __launch_bounds__(256, 2) mega(Params p, int ph_lo, int ph_hi, int dupmask) {
  __shared__ __attribute__((aligned(16))) char lds[73728];
  __shared__ int s_item;
  __shared__ unsigned s_bar[4];
  unsigned* bar = (unsigned*)(p.ws + W_BAR);
  const unsigned xcc = xb_xcc_id();
  if (threadIdx.x < 4) s_bar[threadIdx.x] = 0u;
  if (threadIdx.x == 0 && ph_hi - ph_lo > 1) (void)xb_add(&bar[XB_XCNT(xcc)], 1u);
  __syncthreads();
  if (ph_hi > 4096) cg::this_grid().sync();
#define RUN_PHASE(PH, CALL)                                                       \
  if ((ONLY < 0 || ONLY == PH) && ph_lo <= PH && PH < ph_hi) {                    \
    const int nrep = 1 + ((dupmask >> PH) & 1);                                   \
    for (int rep = 0; rep < nrep; ++rep) {                                        \
      const int dry = (rep + 1 < nrep); (void)dry;                                \
      CALL;                                                                       \
      if (dry) grid_barrier(bar, xcc, s_bar);                                     \
    }                                                                             \
    if (PH + 1 < ph_hi) {                                                         \
      grid_barrier(bar, xcc, s_bar);                                              \
    }                                                                             \
  }
  RUN_PHASE(0, phase_prep(p))
  RUN_PHASE(1, phase_inproj(p, lds))
  RUN_PHASE(2, phase_small(p))
  RUN_PHASE(3, phase_attn_diff(p, lds, &s_item, dry))
  RUN_PHASE(4, phase_mla_expand(p, lds))
  RUN_PHASE(5, phase_attn_mla(p, lds, &s_item, dry))
  RUN_PHASE(6, phase_merge(p, lds))
  RUN_PHASE(7, phase_outproj(p, lds))
  RUN_PHASE(8, phase_ffn_norm(p))
  RUN_PHASE(9, phase_peer_q(p, lds))
  RUN_PHASE(10, phase_peer_select(p, lds))
  RUN_PHASE(11, phase_peer_gather(p, lds))
}

extern "C" void kernel_launch(void* const* d_in, const int* in_sizes, int n_in, void* d_out, int out_size, void* d_ws, size_t ws_size,
                              hipStream_t stream) {
  if (ws_size < W_END || n_in < 25) { fprintf(stderr, "workspace too small: %zu < %zu\n", ws_size, (size_t)W_END); return; }
  static int grid_blocks = 0;
  if (!grid_blocks) {
    int dev = 0, cus = 0, per_cu = 0;
    hipGetDevice(&dev);
    hipDeviceGetAttribute(&cus, hipDeviceAttributeMultiprocessorCount, dev);
    hipOccupancyMaxActiveBlocksPerMultiprocessor(&per_cu, mega, 256, 0);
    if (per_cu > 2) per_cu = 2;
    grid_blocks = cus * per_cu;
  }
  Params p{};
  for (int i = 0; i < 25; ++i) p.in[i] = (const float*)d_in[i];
  p.out = (float*)d_out; p.ws = (char*)d_ws; p.nblocks = (unsigned)grid_blocks; p.pad = 0;
  hipMemsetAsync((char*)d_ws + W_BAR, 0, 16384, stream);
#if MULTI_LAUNCH
  for (int ph = 0; ph < NPHASE; ++ph) {
    hipLaunchKernelGGL(mega, dim3(grid_blocks), dim3(256), 0, stream, p, ph, ph + 1, 0);
  }
#else
  int lo = 0, hi = NPHASE, dup = DUPMASK;
  void* args[] = {&p, &lo, &hi, &dup};
  hipError_t e = hipLaunchCooperativeKernel((void*)mega, dim3(grid_blocks), dim3(256), args, 0, stream);
  if (e != hipSuccess) fprintf(stderr, "cooperative launch failed: %s (grid %d)\n", hipGetErrorString(e), grid_blocks);
#endif
}
```

```cpp
#include <hip/hip_runtime.h>
#include <hip/hip_cooperative_groups.h>
#include <cstdio>
#include <cstdint>
namespace cg = cooperative_groups;

#ifndef ONLY
#define ONLY (-1)
#endif
#ifndef DUPMASK
#define DUPMASK 0
#endif
#ifndef MULTI_LAUNCH
#define MULTI_LAUNCH 0
#endif

typedef unsigned short bf16_t;
typedef short bf16x8 __attribute__((ext_vector_type(8)));
typedef float f32x4 __attribute__((ext_vector_type(4)));
typedef float f32x16 __attribute__((ext_vector_type(16)));
typedef unsigned u32x4 __attribute__((ext_vector_type(4)));
typedef unsigned u32x2 __attribute__((ext_vector_type(2)));

constexpr int DM = 1024;
constexpr int TP = 32768, TS = 512, T = TP + TS;
constexpr int SEQ = 4096, PAST = 2048, LKS = 2112;
constexpr int R = TP + 8 * LKS;
constexpr int NIN = 5632;
constexpr int LDH = 1088;
constexpr int LDQ = 288;
constexpr int LDK = 160;
constexpr int SEQP = 4160;
constexpr float LOG2E = 1.4426950408889634f;
constexpr float EPS = 1e-6f;

constexpr size_t O_Y = 0;
constexpr size_t O_KP = 34078720, O_VP = 67633152, O_CP = 101187584, O_EP = 105381888;
constexpr size_t O_KS = 106430464, O_VS = 106954752, O_CS = 107479040, O_ES = 107544576;

constexpr size_t W_WIN = 0;
constexpr size_t W_WUQ = W_WIN + (size_t)NIN * LDH * 2;
constexpr size_t W_WUKV = W_WUQ + (size_t)1536 * LDQ * 2;
constexpr size_t W_WA = W_WUKV + (size_t)2048 * LDK * 2;
constexpr size_t W_WB = W_WA + (size_t)1024 * LDH * 2;
constexpr size_t W_WO = W_WB + (size_t)1024 * LDH * 2;
constexpr size_t W_WQ = W_WO + (size_t)1024 * LDH * 2;
constexpr size_t W_KEYS = W_WQ + (size_t)1024 * LDH * 2;
constexpr size_t W_ROPE = W_KEYS + 262144;
constexpr size_t W_MISC = W_ROPE + 524288;
constexpr size_t W_BAR = W_MISC + 8192;
constexpr int QW = 3584;
constexpr size_t SZ_ACT = (size_t)T * LDH * 2;
constexpr size_t W_B = W_BAR + 16384;
constexpr size_t W_C = W_B + SZ_ACT;
constexpr size_t W_D = W_C + SZ_ACT;
constexpr size_t SZ_VTP = (size_t)8 * 1024 * SEQP * 2, SZ_VTS = (size_t)8 * 1024 * LKS * 2;
constexpr size_t W_D2 = W_D + (size_t)R * LDH * 2;
constexpr size_t W_F = W_D2 + SZ_VTP + SZ_VTS;
constexpr size_t F_ZCQ = W_F, F_ZCKV = F_ZCQ + 34078720, F_ZKR = F_ZCKV + 17039360, F_CQ = F_ZKR + 4259840;
constexpr size_t SZ_F = (F_CQ - W_F) + (size_t)T * LDQ * 2;
static_assert(SZ_F >= SZ_ACT, "merged must fit in F");
constexpr size_t W_G = W_F + SZ_F;
constexpr size_t W_KPE = W_G + (size_t)R * LDK * 2;
constexpr size_t W_END = W_KPE + (size_t)R * 32 * 2;
static_assert(W_END <= 536870912ull, "workspace budget");
constexpr size_t D_X1 = W_D, D_SELI = W_D + 136314880, D_SELW = D_SELI + 17039360;
static_assert(D_SELW + 17039360 <= W_F, "x1 + sel must fit in D");

struct Params {
  const float* in[25];
  float* out;
  char* ws;
  unsigned nblocks;
  unsigned pad;
};

typedef __bf16 bf16v2_t __attribute__((ext_vector_type(2)));
typedef float f32v2_t __attribute__((ext_vector_type(2)));
__device__ __forceinline__ unsigned pk2(float lo, float hi) { f32v2_t v = {lo, hi}; bf16v2_t r = __builtin_convertvector(v, bf16v2_t); return __builtin_bit_cast(unsigned, r); }
__device__ __forceinline__ bf16_t f2bf(float x) { return (bf16_t)(pk2(x, 0.f) & 0xffffu); }
__device__ __forceinline__ float bf2f(bf16_t v) { return __uint_as_float(((unsigned)v) << 16); }
__device__ __forceinline__ float bflo(unsigned w) { return __uint_as_float(w << 16); }
__device__ __forceinline__ float bfhi(unsigned w) { return __uint_as_float(w & 0xffff0000u); }
__device__ __forceinline__ float wave_sum(float v) {
#pragma unroll
  for (int o = 32; o >= 1; o >>= 1) v += __shfl_xor(v, o);
  return v;
}
__device__ __forceinline__ f32x16 mfma32(bf16x8 a, bf16x8 b, f32x16 c) { return __builtin_amdgcn_mfma_f32_32x32x16_bf16(a, b, c, 0, 0, 0); }
__device__ __forceinline__ int accrow(int reg, int hh) { return (reg & 3) + 8 * (reg >> 2) + 4 * hh; }
__device__ __forceinline__ int kperm(int k) { return (k & ~12) | ((k & 4) << 1) | ((k & 8) >> 1); }

__device__ __forceinline__ int keyrow_of_token(int t) {
  if (t < TP) return t;
  int ts = t - TP; return TP + (ts >> 6) * LKS + PAST + (ts & 63);
}

#define XB_XCNT(j)  (256  + 64 * (j))
#define XB_XSUB(j)  (1280 + 64 * (j))
#define XB_XGEN(j)  (2304 + 64 * (j))
#define XB_TOP      3328
#define XB_TOPGEN   3392
__device__ __forceinline__ unsigned xb_ld(unsigned* p)              { return __hip_atomic_load(p, __ATOMIC_RELAXED, __HIP_MEMORY_SCOPE_AGENT); }
__device__ __forceinline__ unsigned xb_add(unsigned* p, unsigned v) { return __hip_atomic_fetch_add(p, v, __ATOMIC_RELAXED, __HIP_MEMORY_SCOPE_AGENT); }
__device__ __forceinline__ unsigned xb_xcc_id() { return (unsigned)__builtin_amdgcn_s_getreg((3 << 11) | 20) & 0xFu; }
__device__ __forceinline__ void grid_barrier(unsigned* bar, unsigned xcc, volatile unsigned* st) {
  asm volatile("s_waitcnt vmcnt(0)" ::: "memory");
  __syncthreads();
  if (threadIdx.x == 0) {
    __builtin_amdgcn_s_waitcnt(0);
    unsigned nloc = st[0], nx = st[1];
    if (nloc == 0u) {
      const unsigned G = gridDim.x;
      for (;;) {
        unsigned sum = 0u, cnt = 0u, mine = 0u;
#pragma unroll
        for (unsigned j = 0; j < 16; ++j) { const unsigned c = xb_ld(&bar[XB_XCNT(j)]); sum += c; cnt += (c > 0u) ? 1u : 0u; mine = (j == xcc) ? c : mine; }
        if (sum == G) { nloc = mine; nx = cnt; break; }
        __builtin_amdgcn_s_sleep(1);
      }
      st[0] = nloc; st[1] = nx;
    }
    const unsigned old = xb_add(&bar[XB_XSUB(xcc)], 1u);
    const unsigned gen = old / nloc;
    if (old + 1u == (gen + 1u) * nloc) {
      __builtin_amdgcn_fence(__ATOMIC_RELEASE, "agent");
      asm volatile("s_waitcnt vmcnt(0)" ::: "memory");
      const unsigned og = xb_add(&bar[XB_TOP], 1u);
      const unsigned tg = og / nx;
      if (og + 1u == (tg + 1u) * nx) xb_add(&bar[XB_TOPGEN], 1u);
      else { while (xb_ld(&bar[XB_TOPGEN]) == tg) __builtin_amdgcn_s_sleep(1); }
      __builtin_amdgcn_fence(__ATOMIC_ACQUIRE, "agent");
      xb_add(&bar[XB_XGEN(xcc)], 1u);
      asm volatile("s_waitcnt vmcnt(0)" ::: "memory");
    } else {
      while (xb_ld(&bar[XB_XGEN(xcc)]) == gen) __builtin_amdgcn_s_sleep(1);
      __builtin_amdgcn_fence(__ATOMIC_ACQUIRE, "agent");
      asm volatile("s_waitcnt vmcnt(0)" ::: "memory");
    }
  }
  __syncthreads();
}

constexpr int GEMM_BUF = 32768;
typedef __attribute__((address_space(3))) unsigned lds_u32_t;
typedef __attribute__((address_space(1))) const unsigned glb_u32_t;
__device__ __forceinline__ void glds16(const bf16_t* g, char* l) {
  __builtin_amdgcn_global_load_lds((glb_u32_t*)g, (lds_u32_t*)l, 16, 0, 0);
}
template <bool SW>
__device__ __forceinline__ void gemm_mainloop(const bf16_t* __restrict__ A, int lda, const bf16_t* __restrict__ Bt, int ldb, int K,
                                              f32x16 (&acc)[2][2], char* lds, int kstart) {
  const int tid = threadIdx.x, lane = tid & 63, wid = tid >> 6;
  const int wr = wid >> 1, wc = wid & 1, l31 = lane & 31, hh = lane >> 5;
  const int lrow = wid * 32 + (lane >> 3);
  const int nk = K >> 6;
  kstart &= (nk - 1);
  const bf16_t* ap[4]; const bf16_t* bp[4];
#pragma unroll
  for (int i = 0; i < 4; ++i) {
    const int row = lrow + 8 * i; const int ch = (lane & 7) ^ ((row >> 1) & 7);
    ap[i] = A + (size_t)row * lda + ch * 8; bp[i] = Bt + (size_t)row * ldb + ch * 8;
  }
  char* ldst = lds + (wid * 32) * 128 + lane * 16;
#pragma unroll
  for (int i = 0; i < 4; ++i) { glds16(ap[i] + kstart * 64, ldst + i * 1024); glds16(bp[i] + kstart * 64, ldst + 16384 + i * 1024); }
  asm volatile("s_waitcnt vmcnt(0)" ::: "memory");
  __syncthreads();
  const int swz = (l31 >> 1) & 7;
  const int roffA = (wr * 64 + l31) * 128, roffB = 16384 + (wc * 64 + l31) * 128;
#pragma unroll 1
  for (int kt = 0; kt < nk; ++kt) {
    const bool more = (kt + 1 < nk);
    if (more) {
      char* d = ldst + ((kt + 1) & 1) * GEMM_BUF;
      const int ko = ((kt + 1 + kstart) & (nk - 1)) * 64;
#pragma unroll
      for (int i = 0; i < 4; ++i) { glds16(ap[i] + ko, d + i * 1024); glds16(bp[i] + ko, d + 16384 + i * 1024); }
    }
    const char* base = lds + (kt & 1) * GEMM_BUF;
#pragma unroll
    for (int ks = 0; ks < 4; ++ks) {
      const int co = ((2 * ks + hh) ^ swz) * 16;
      bf16x8 a0 = *(const bf16x8*)(base + roffA + co), a1 = *(const bf16x8*)(base + roffA + 32 * 128 + co);
      bf16x8 b0 = *(const bf16x8*)(base + roffB + co), b1 = *(const bf16x8*)(base + roffB + 32 * 128 + co);
      if (SW) {
        acc[0][0] = mfma32(b0, a0, acc[0][0]); acc[0][1] = mfma32(b1, a0, acc[0][1]);
        acc[1][0] = mfma32(b0, a1, acc[1][0]); acc[1][1] = mfma32(b1, a1, acc[1][1]);
      } else {
        acc[0][0] = mfma32(a0, b0, acc[0][0]); acc[0][1] = mfma32(a0, b1, acc[0][1]);
        acc[1][0] = mfma32(a1, b0, acc[1][0]); acc[1][1] = mfma32(a1, b1, acc[1][1]);
      }
    }
    asm volatile("s_waitcnt vmcnt(0)" ::: "memory");
    __syncthreads();
  }
}
__device__ __forceinline__ bool tile_at(int nMt, int nNt, int it, int& mt, int& nt) {
  const int x = blockIdx.x & 7, lb = blockIdx.x >> 3, nloc = gridDim.x >> 3;
  const int mb = (x * nMt) >> 3, mc = (((x + 1) * nMt) >> 3) - mb;
  const int idx = lb + it * nloc;
  if (idx >= mc * nNt) return false;
  const int g = idx / (8 * nNt); const int rem = idx - g * 8 * nNt;
  const int left = mc - g * 8; const int gsz = left < 8 ? left : 8;
  mt = mb + g * 8 + rem % gsz; nt = rem / gsz;
  return true;
}
__device__ __forceinline__ void zero_acc(f32x16 (&acc)[2][2]) {
#pragma unroll
  for (int i = 0; i < 2; ++i)
#pragma unroll
    for (int j = 0; j < 2; ++j)
#pragma unroll
      for (int r = 0; r < 16; ++r) acc[i][j][r] = 0.f;
}

__device__ __forceinline__ void vt_store(bf16_t* vt_row, int key32, const f32x16& a, int hh) {
#pragma unroll
  for (int g = 0; g < 4; ++g) {
    const int pos = key32 + (g >> 1) * 16 + hh * 8 + (g & 1) * 4;
    u32x2 w; w.x = pk2(a[4 * g], a[4 * g + 1]); w.y = pk2(a[4 * g + 2], a[4 * g + 3]);
    *(u32x2*)(vt_row + pos) = w;
  }
}

__device__ __forceinline__ void st_bf16_sw(bf16_t* row, const f32x16& a, int hh, float sc) {
#pragma unroll
  for (int g = 0; g < 4; ++g) { u32x2 w; w.x = pk2(a[4 * g] * sc, a[4 * g + 1] * sc); w.y = pk2(a[4 * g + 2] * sc, a[4 * g + 3] * sc); *(u32x2*)(row + 8 * g + 4 * hh) = w; }
}
__device__ __forceinline__ void st_f32_sw(float* row, const f32x16& a, int hh) {
#pragma unroll
  for (int g = 0; g < 4; ++g) { f32x4 w = {a[4 * g], a[4 * g + 1], a[4 * g + 2], a[4 * g + 3]}; *(f32x4*)(row + 8 * g + 4 * hh) = w; }
}

__device__ void phase_prep(const Params& p) {
  const int gtid = blockIdx.x * 256 + threadIdx.x, gthreads = gridDim.x * 256;
  const int gw = gtid >> 6, nw = gthreads >> 6, lane = threadIdx.x & 63;
  char* ws = p.ws;
  {
    bf16_t* dst = (bf16_t*)(ws + W_WIN); const float* src = p.in[8];
    for (int u = gtid; u < NIN * 128; u += gthreads) {
      const int n = u % NIN, k0 = (u / NIN) * 8;
      int col = n; bool valid = true;
      if (n >= 3584) col = n - 96; else if (n >= 3488) valid = false;
      float v[8];
#pragma unroll
      for (int j = 0; j < 8; ++j) v[j] = valid ? src[(size_t)(k0 + j) * 5536 + col] : 0.f;
      u32x4 w; w.x = pk2(v[0], v[1]); w.y = pk2(v[2], v[3]); w.z = pk2(v[4], v[5]); w.w = pk2(v[6], v[7]);
      *(u32x4*)(dst + (size_t)n * LDH + k0) = w;
    }
  }
  {
    bf16_t* dst = (bf16_t*)(ws + W_WUQ); const float* src = p.in[12];
    for (int u = gtid; u < 1536 * 32; u += gthreads) {
      const int n = u % 1536, k0 = (u / 1536) * 8;
      int col = (n < 1024) ? ((n >> 6) * 96 + (n & 63)) : (((n - 1024) >> 5) * 96 + 64 + ((n - 1024) & 31));
      float v[8];
#pragma unroll
      for (int j = 0; j < 8; ++j) v[j] = src[(size_t)(k0 + j) * 1536 + col];
      u32x4 w; w.x = pk2(v[0], v[1]); w.y = pk2(v[2], v[3]); w.z = pk2(v[4], v[5]); w.w = pk2(v[6], v[7]);
      *(u32x4*)(dst + (size_t)n * LDQ + k0) = w;
    }
  }
  {
    bf16_t* dst = (bf16_t*)(ws + W_WUKV);
    for (int u = gtid; u < 2048 * 16; u += gthreads) {
      const int n = u % 2048, k0 = (u / 2048) * 8;
      const float* src = (n < 1024) ? p.in[14] : p.in[15]; const int col = n & 1023;
      float v[8];
#pragma unroll
      for (int j = 0; j < 8; ++j) v[j] = src[(size_t)(k0 + j) * 1024 + col];
      u32x4 w; w.x = pk2(v[0], v[1]); w.y = pk2(v[2], v[3]); w.z = pk2(v[4], v[5]); w.w = pk2(v[6], v[7]);
      *(u32x4*)(dst + (size_t)n * LDK + k0) = w;
    }
  }
  {
    for (int u = gtid; u < 4 * 1024 * 128; u += gthreads) {
      const int which = u >> 17, uu = u & 131071;
      const int n = uu & 1023, k0 = (uu >> 10) * 8;
      const float* src = which == 0 ? p.in[16] : which == 1 ? p.in[17] : which == 2 ? p.in[18] : p.in[20];
      bf16_t* dst = (bf16_t*)(ws + (which == 0 ? W_WA : which == 1 ? W_WB : which == 2 ? W_WO : W_WQ));
      float v[8];
#pragma unroll
      for (int j = 0; j < 8; ++j) v[j] = src[(size_t)(k0 + j) * 1024 + n];
      u32x4 w; w.x = pk2(v[0], v[1]); w.y = pk2(v[2], v[3]); w.z = pk2(v[4], v[5]); w.w = pk2(v[6], v[7]);
      *(u32x4*)(dst + (size_t)n * LDH + k0) = w;
    }
  }
  {
    bf16_t* dst = (bf16_t*)(ws + W_KEYS); const float* src = p.in[21];
    for (int u = gtid; u < 16 * 128 * 64 / 4; u += gthreads) {
      f32x4 v = *(const f32x4*)(src + (size_t)u * 4);
      u32x2 w; w.x = pk2(v[0], v[1]); w.y = pk2(v[2], v[3]);
      *(u32x2*)(dst + (size_t)u * 4) = w;
    }
  }
  {
    bf16_t* hb = (bf16_t*)(ws + W_B); const float* g = p.in[7];
    for (int t = gw; t < T; t += nw) {
      const float* x = (t < TP) ? p.in[0] + (size_t)t * DM : p.in[1] + (size_t)(t - TP) * DM;
      f32x4 v[4]; float ss = 0.f;
#pragma unroll
      for (int i = 0; i < 4; ++i) { v[i] = *(const f32x4*)(x + i * 256 + lane * 4); ss += v[i][0] * v[i][0] + v[i][1] * v[i][1] + v[i][2] * v[i][2] + v[i][3] * v[i][3]; }
      ss = wave_sum(ss);
      const float rs = rsqrtf(ss * (1.f / DM) + EPS);
#pragma unroll
      for (int i = 0; i < 4; ++i) {
        f32x4 gg = *(const f32x4*)(g + i * 256 + lane * 4);
        u32x2 w; w.x = pk2(v[i][0] * rs * gg[0], v[i][1] * rs * gg[1]); w.y = pk2(v[i][2] * rs * gg[2], v[i][3] * rs * gg[3]);
        *(u32x2*)(hb + (size_t)t * LDH + i * 256 + lane * 4) = w;
      }
    }
  }
  {
    bf16_t* dk = (bf16_t*)(ws + W_D); const float* src = p.in[2];
    for (int u = gtid; u < 8 * PAST * 256; u += gthreads) {
      const int e = u * 4; const int row = e >> 10, c = e & 1023; const int b = row >> 11, j = row & 2047;
      f32x4 v = *(const f32x4*)(src + (size_t)e);
      u32x2 w; w.x = pk2(v[0], v[1]); w.y = pk2(v[2], v[3]);
      *(u32x2*)(dk + (size_t)(TP + b * LKS + j) * LDH + c) = w;
    }
    bf16_t* ck = (bf16_t*)(ws + W_G); const float* s2 = p.in[4];
    for (int u = gtid; u < 8 * PAST * 32; u += gthreads) {
      const int e = u * 4; const int row = e >> 7, c = e & 127; const int b = row >> 11, j = row & 2047;
      f32x4 v = *(const f32x4*)(s2 + (size_t)e);
      u32x2 w; w.x = pk2(v[0], v[1]); w.y = pk2(v[2], v[3]);
      *(u32x2*)(ck + (size_t)(TP + b * LKS + j) * LDK + c) = w;
    }
    bf16_t* kp = (bf16_t*)(ws + W_KPE); const float* s3 = p.in[5];
    for (int u = gtid; u < 8 * PAST * 8; u += gthreads) {
      const int e = u * 4; const int row = e >> 5, c = e & 31; const int b = row >> 11, j = row & 2047;
      f32x4 v = *(const f32x4*)(s3 + (size_t)e);
      u32x2 w; w.x = pk2(v[0], v[1]); w.y = pk2(v[2], v[3]);
      *(u32x2*)(kp + (size_t)(TP + b * LKS + j) * 32 + c) = w;
    }
  }
  {
    bf16_t* vt = (bf16_t*)(ws + W_D2 + SZ_VTP); const float* src = p.in[3];
    for (int u = gtid; u < 8 * 256 * 1024; u += gthreads) {
      const int c = u & 1023, pg = (u >> 10) & 255, b = u >> 18;
      const int p0 = pg * 8;
      float v[8];
#pragma unroll
      for (int i = 0; i < 8; ++i) { const int key = kperm(p0 + i); v[i] = src[((size_t)(b * PAST + key)) * 1024 + c]; }
      u32x4 w; w.x = pk2(v[0], v[1]); w.y = pk2(v[2], v[3]); w.z = pk2(v[4], v[5]); w.w = pk2(v[6], v[7]);
      *(u32x4*)(vt + ((size_t)(b * 1024 + c)) * LKS + p0) = w;
    }
  }
  {
    float2* rt = (float2*)(ws + W_ROPE);
    for (int u = gtid; u < 4096 * 16; u += gthreads) {
      const int pos = u >> 4, i = u & 15;
      const float inv = powf(10000.0f, -(float)i / 16.0f);
      const float ang = (float)pos * inv;
      rt[u] = make_float2(cosf(ang), sinf(ang));
    }
    float* misc = (float*)(ws + W_MISC);
    if (gw == 0) {
      const float* lp = p.in[9];
      float a = lp[lane] * lp[64 + lane], b = lp[128 + lane] * lp[192 + lane];
      a = wave_sum(a); b = wave_sum(b);
      if (lane == 0) misc[0] = expf(a) - expf(b) + 0.2f;
    }
    for (int u = gtid; u < 8 * 192; u += gthreads) {
      const int h = u / 192, idx = u % 192; const int rel = idx - 128;
      const int n = rel < 0 ? -rel : rel;
      int bucket = rel > 0 ? 16 : 0;
      if (n < 8) bucket += n;
      else { int lg = 8 + (n >= 12) + (n >= 16) + (n >= 23) + (n >= 32) + (n >= 46) + (n >= 64) + (n >= 91); bucket += lg > 15 ? 15 : lg; }
      misc[64 + u] = (p.in[6][bucket * 8 + h] - p.in[6][15 * 8 + h]) * LOG2E;
    }
  }
}

__device__ void phase_inproj(const Params& p, char* lds) {
  char* ws = p.ws;
  const bf16_t* hb = (const bf16_t*)(ws + W_B); const bf16_t* wt = (const bf16_t*)(ws + W_WIN);
  const int lane = threadIdx.x & 63, wid = threadIdx.x >> 6, wr = wid >> 1, wc = wid & 1, hh = lane >> 5, l31 = lane & 31;
  for (int it = 0;; ++it) {
    int mt, nt; if (!tile_at(260, 44, it, mt, nt)) break;
    const int m0 = mt * 128, n0 = nt * 128;
    f32x16 acc[2][2]; zero_acc(acc);
    const bool samp = (m0 >= TP);
    if (nt >= 16 && nt < 24) {
      gemm_mainloop<false>(hb + (size_t)m0 * LDH, LDH, wt + (size_t)n0 * LDH, LDH, DM, acc, lds, 2 * ((mt + nt) & 7));
#pragma unroll
      for (int i = 0; i < 2; ++i)
#pragma unroll
        for (int j = 0; j < 2; ++j) {
          const int mb = m0 + wr * 64 + i * 32; const int nn = n0 - 2048 + wc * 64 + j * 32 + l31;
          float* o = (samp ? p.out + O_VS + (size_t)(mb - TP) * 1024 : p.out + O_VP + (size_t)mb * 1024) + nn;
#pragma unroll
          for (int r = 0; r < 16; ++r) o[(size_t)accrow(r, hh) * 1024] = acc[i][j][r];
          bf16_t* vt; int key32;
          if (!samp) { const int b = mb >> 12; vt = (bf16_t*)(ws + W_D2) + ((size_t)(b * 1024 + nn)) * SEQP; key32 = mb & 4095; }
          else { const int ts = mb - TP; const int b = ts >> 6; vt = (bf16_t*)(ws + W_D2 + SZ_VTP) + ((size_t)(b * 1024 + nn)) * LKS; key32 = PAST + (ts & 63); }
          vt_store(vt, key32, acc[i][j], hh);
        }
      continue;
    }
    gemm_mainloop<true>(hb + (size_t)m0 * LDH, LDH, wt + (size_t)n0 * LDH, LDH, DM, acc, lds, 2 * ((mt + nt) & 7));
#pragma unroll
    for (int i = 0; i < 2; ++i)
#pragma unroll
      for (int j = 0; j < 2; ++j) {
        const int tok = m0 + wr * 64 + i * 32 + l31; const int cb = n0 + wc * 64 + j * 32;
        if (nt < 8) {
          st_bf16_sw((bf16_t*)(ws + W_C) + (size_t)tok * LDH + cb, acc[i][j], hh, 0.125f * LOG2E);
        } else if (nt < 16) {
          st_f32_sw((samp ? p.out + O_KS + (size_t)(tok - TP) * 1024 : p.out + O_KP + (size_t)tok * 1024) + (cb - 1024), acc[i][j], hh);
          st_bf16_sw((bf16_t*)(ws + W_D) + (size_t)keyrow_of_token(tok) * LDH + (cb - 1024), acc[i][j], hh, 1.f);
        } else if (nt < 26) {
          st_f32_sw((float*)(ws + F_ZCQ) + (size_t)tok * 256 + (cb - 3072), acc[i][j], hh);
        } else if (nt == 26) {
          st_f32_sw((float*)(ws + F_ZCKV) + (size_t)tok * 128 + (cb - 3328), acc[i][j], hh);
        } else if (nt == 27) {
          if (cb == 3456) st_f32_sw((float*)(ws + F_ZKR) + (size_t)tok * 32, acc[i][j], hh);
        } else {
          f32x16 sg;
#pragma unroll
          for (int r = 0; r < 16; ++r) sg[r] = __builtin_amdgcn_rcpf(1.f + __expf(-acc[i][j][r]));
          st_bf16_sw((bf16_t*)(p.out + O_Y) + (size_t)tok * 2048 + (cb - 3584), sg, hh, 1.f);
        }
      }
  }
}

__device__ void phase_small(const Params& p) {
  char* ws = p.ws;
  const int gw = (blockIdx.x * 256 + threadIdx.x) >> 6, nw = (gridDim.x * 256) >> 6, lane = threadIdx.x & 63;
  const float* zcq = (const float*)(ws + F_ZCQ); const float* zckv = (const float*)(ws + F_ZCKV); const float* zkr = (const float*)(ws + F_ZKR);
  bf16_t* cq = (bf16_t*)(ws + F_CQ); bf16_t* ckva = (bf16_t*)(ws + W_G); bf16_t* kpea = (bf16_t*)(ws + W_KPE);
  const float2* rt = (const float2*)(ws + W_ROPE);
  for (int t = gw; t < T; t += nw) {
    {
      f32x4 v = *(const f32x4*)(zcq + (size_t)t * 256 + lane * 4);
      float ss = wave_sum(v[0] * v[0] + v[1] * v[1] + v[2] * v[2] + v[3] * v[3]);
      const float rs = rsqrtf(ss * (1.f / 256.f) + EPS);
      f32x4 g = *(const f32x4*)(p.in[11] + lane * 4);
      u32x2 w; w.x = pk2(v[0] * rs * g[0], v[1] * rs * g[1]); w.y = pk2(v[2] * rs * g[2], v[3] * rs * g[3]);
      *(u32x2*)(cq + (size_t)t * LDQ + lane * 4) = w;
    }
    const int kr = keyrow_of_token(t);
    {
      float2 v = *(const float2*)(zckv + (size_t)t * 128 + lane * 2);
      float ss = wave_sum(v.x * v.x + v.y * v.y);
      const float rs = rsqrtf(ss * (1.f / 128.f) + EPS);
      float2 g = *(const float2*)(p.in[13] + lane * 2);
      const float a = v.x * rs * g.x, b = v.y * rs * g.y;
      float* o = (t < TP) ? p.out + O_CP + (size_t)t * 128 : p.out + O_CS + (size_t)(t - TP) * 128;
      *(float2*)(o + lane * 2) = make_float2(a, b);
      *(unsigned*)(ckva + (size_t)kr * LDK + lane * 2) = pk2(a, b);
    }
    {
      const int pos = (t < TP) ? (t & 4095) : (PAST + ((t - TP) & 63));
      const int i = lane & 15;
      const float x1 = zkr[(size_t)t * 32 + i], x2 = zkr[(size_t)t * 32 + 16 + i];
      const float2 cs = rt[pos * 16 + i];
      const float r = (lane < 16) ? (x1 * cs.x - x2 * cs.y) : (x1 * cs.y + x2 * cs.x);
      if (lane < 32) {
        float* o = (t < TP) ? p.out + O_EP + (size_t)t * 32 : p.out + O_ES + (size_t)(t - TP) * 32;
        o[lane] = r; kpea[(size_t)kr * 32 + lane] = f2bf(r);
      }
    }
  }
}

template <int MODE>
__device__ void attn_item(const Params& p, char* lds, int grp  , int b, int h, int qblk, int dry) {
  constexpr int DQ = MODE == 0 ? 64 : 96;
  constexpr int KROW = MODE == 0 ? 128 : 96;
  constexpr int KSTR = MODE == 0 ? 272 : 208;
  constexpr int DV = MODE == 0 ? 128 : 64;
  constexpr int NH = MODE == 0 ? 8 : 16;
  constexpr int KBYTES = 64 * KSTR;
  constexpr int BUF = KBYTES + DV * 144;
  constexpr int KCH = KROW / 8;
  constexpr int NKC = 64 * KCH / 256;
  constexpr int NVC = DV * 8 / 256;
  char* ws = p.ws;
  const int tid = threadIdx.x, lane = tid & 63, wid = tid >> 6, hh = lane >> 5, l31 = lane & 31;
  const int qsub = MODE == 0 ? (wid >> 1) : wid;
  const int comp = MODE == 0 ? (wid & 1) : 0;
  const int QB = MODE == 0 ? 64 : 128;
  const int Lk = grp == 0 ? SEQP : LKS;
  const int tok0 = grp == 0 ? (b * SEQ + qblk * QB) : (TP + b * 64);
  const int qpos0 = grp == 0 ? qblk * QB : PAST;
  const int krow0 = grp == 0 ? b * SEQ : TP + b * LKS;
  int nkt;
  if (grp == 0) nkt = MODE == 0 ? (qblk + 1) : (2 * qblk + 2); else nkt = 33;
  int my_last = nkt - 1; bool active = true;
  if (MODE == 1) { if (grp == 0) my_last = 2 * qblk + (wid >> 1); else active = (wid < 2); }
  const int qtok = tok0 + qsub * 32 + l31;
  const int qpos = qpos0 + qsub * 32 + l31;

  bf16x8 qf[DQ / 16];
  if (MODE == 0) {
    const bf16_t* q = (const bf16_t*)(ws + W_C) + (size_t)qtok * LDH + h * 128 + comp * 64 + hh * 8;
#pragma unroll
    for (int ks = 0; ks < 4; ++ks) qf[ks] = *(const bf16x8*)(q + ks * 16);
  } else {
    const int qt = active ? qtok : tok0;
    const bf16_t* q = (const bf16_t*)(ws + W_B) + (size_t)qt * LDH + h * 64 + hh * 8;
#pragma unroll
    for (int ks = 0; ks < 4; ++ks) qf[ks] = *(const bf16x8*)(q + ks * 16);
    const bf16_t* qp = (const bf16_t*)(ws + F_ZCQ) + (size_t)qt * 512 + h * 32 + hh * 8;
    bf16x8 a = *(const bf16x8*)(qp), c = *(const bf16x8*)(qp + 16);
    const float2* rt = (const float2*)(ws + W_ROPE) + (size_t)(active ? qpos : qpos0) * 16 + hh * 8;
    float o1[8], o2[8];
#pragma unroll
    for (int j = 0; j < 8; ++j) {
      const float x1 = bf2f((bf16_t)a[j]), x2 = bf2f((bf16_t)c[j]); const float2 cs = rt[j];
      o1[j] = x1 * cs.x - x2 * cs.y; o2[j] = x1 * cs.y + x2 * cs.x;
    }
    u32x4 w1, w2;
    w1.x = pk2(o1[0], o1[1]); w1.y = pk2(o1[2], o1[3]); w1.z = pk2(o1[4], o1[5]); w1.w = pk2(o1[6], o1[7]);
    w2.x = pk2(o2[0], o2[1]); w2.y = pk2(o2[2], o2[3]); w2.z = pk2(o2[4], o2[5]); w2.w = pk2(o2[6], o2[7]);
    qf[4] = __builtin_bit_cast(bf16x8, w1); qf[5] = __builtin_bit_cast(bf16x8, w2);
  }

  const bf16_t* kg; const bf16_t* kpe; const bf16_t* vg;
  if (MODE == 0) {
    kg = (const bf16_t*)(ws + W_D) + (size_t)krow0 * LDH + h * 128;
    kpe = nullptr;
    vg = grp == 0 ? (const bf16_t*)(ws + W_D2) + (size_t)(b * 1024 + h * 128) * SEQP : (const bf16_t*)(ws + W_D2 + SZ_VTP) + (size_t)(b * 1024 + h * 128) * LKS;
  } else {
    kg = (const bf16_t*)(ws + W_D) + (size_t)krow0 * LDH + h * 64;
    kpe = (const bf16_t*)(ws + W_KPE) + (size_t)krow0 * 32;
    vg = grp == 0 ? (const bf16_t*)(ws + W_D2) + (size_t)(b * 1024 + h * 64) * SEQP : (const bf16_t*)(ws + W_D2 + SZ_VTP) + (size_t)(b * 1024 + h * 64) * LKS;
  }
  u32x4 rk[NKC], rv[NVC];
  int koff[NKC], voff[NVC];
#pragma unroll
  for (int i = 0; i < NKC; ++i) { const int q = tid + 256 * i; koff[i] = (q / KCH) * LDH + (q % KCH) * 8; }
#pragma unroll
  for (int i = 0; i < NVC; ++i) { const int q = tid + 256 * i; voff[i] = (q >> 3) * Lk + (q & 7) * 8; }
  auto gloadK = [&](int kt) {
    const bf16_t* ktile = kg + (size_t)kt * 64 * LDH;
#pragma unroll
    for (int i = 0; i < NKC; ++i) {
      if (MODE == 0) rk[i] = *(const u32x4*)(ktile + koff[i]);
      else {
        const int q = tid + 256 * i; const int row = q / KCH, ch = q % KCH;
        const bf16_t* src = (ch < 8) ? kg + (size_t)(kt * 64 + row) * LDH + ch * 8 : kpe + (size_t)(kt * 64 + row) * 32 + (ch - 8) * 8;
        rk[i] = *(const u32x4*)src;
      }
    }
  };
  auto gloadV = [&](int kt) {
    const bf16_t* vtile = vg + kt * 64;
#pragma unroll
    for (int i = 0; i < NVC; ++i) rv[i] = *(const u32x4*)(vtile + voff[i]);
  };
  auto lwriteK = [&](int buf) {
    char* base = lds + buf * BUF;
#pragma unroll
    for (int i = 0; i < NKC; ++i) { const int q = tid + 256 * i; const int row = q / KCH, ch = q % KCH; *(u32x4*)(base + row * KSTR + ch * 16) = rk[i]; }
  };
  auto lwriteV = [&](int buf) {
    char* base = lds + buf * BUF;
#pragma unroll
    for (int i = 0; i < NVC; ++i) { const int q = tid + 256 * i; const int row = q >> 3, ch = q & 7; *(u32x4*)(base + KBYTES + row * 144 + ch * 16) = rv[i]; }
  };

  f32x16 O[DV / 32];
#pragma unroll
  for (int i = 0; i < DV / 32; ++i)
#pragma unroll
    for (int r = 0; r < 16; ++r) O[i][r] = 0.f;
  float m = -1e30f, l = 0.f;
  const float* btab = (const float*)(ws + W_MISC) + 64 + h * 192;
  __shared__ float s_bt[192];
  if (MODE == 0 && tid < 192) s_bt[tid] = btab[tid];

  gloadK(0); gloadV(0); lwriteK(0); lwriteV(0);
  __syncthreads();
  for (int kt = 0; kt < nkt; ++kt) {
    const bool more = (kt + 1 < nkt);
    if (more) { gloadK(kt + 1); if (MODE == 1) gloadV(kt + 1); }
    if (active && kt <= my_last) {
      const char* base = lds + (kt & 1) * BUF;
      f32x16 S[2];
      const char* kp0 = base + l31 * KSTR + comp * 128 + hh * 16;
#pragma unroll
      for (int sub = 0; sub < 2; ++sub) {
#pragma unroll
        for (int r = 0; r < 16; ++r) S[sub][r] = 0.f;
#pragma unroll
        for (int ks = 0; ks < DQ / 16; ++ks) {
          bf16x8 kf = *(const bf16x8*)(kp0 + sub * 32 * KSTR + ks * 32);
          S[sub] = mfma32(kf, qf[ks], S[sub]);
        }
      }
      if (MODE == 0) {
        const int kpos0 = kt * 64;
        if (kpos0 + 63 > qpos0 - 91) {
#pragma unroll
          for (int sub = 0; sub < 2; ++sub)
#pragma unroll
            for (int r = 0; r < 16; ++r) {
              int rel = kpos0 + sub * 32 + accrow(r, hh) - qpos; rel = rel < -128 ? -128 : rel;
              S[sub][r] += s_bt[rel + 128];
            }
        }
      }
      __builtin_amdgcn_sched_barrier(0);
      float mx = S[0][0];
#pragma unroll
      for (int sub = 0; sub < 2; ++sub)
#pragma unroll
        for (int r = 0; r < 16; ++r) mx = fmaxf(mx, S[sub][r]);
      mx = fmaxf(mx, __shfl_xor(mx, 32));
      if (__any(mx > m)) {
        const float mn = fmaxf(m, mx);
        const float alpha = __builtin_amdgcn_exp2f(m - mn);
        m = mn; l *= alpha;
#pragma unroll
        for (int i = 0; i < DV / 32; ++i)
#pragma unroll
          for (int r = 0; r < 16; ++r) O[i][r] *= alpha;
      }
      f32v2_t ps2 = {0.f, 0.f}; const f32v2_t m2 = {m, m};
#pragma unroll
      for (int sub = 0; sub < 2; ++sub)
#pragma unroll
        for (int r = 0; r < 16; r += 2) {
          f32v2_t v = (f32v2_t){S[sub][r], S[sub][r + 1]} - m2;
          v[0] = __builtin_amdgcn_exp2f(v[0]); v[1] = __builtin_amdgcn_exp2f(v[1]);
          S[sub][r] = v[0]; S[sub][r + 1] = v[1]; ps2 += v;
        }
      l += ps2[0] + ps2[1];
      if (MODE == 0 && more) { lwriteK((kt + 1) & 1); gloadV(kt + 1); }
      const char* vp0 = base + KBYTES + l31 * 144 + hh * 16;
#pragma unroll
      for (int sub = 0; sub < 2; ++sub)
#pragma unroll
        for (int s = 0; s < 2; ++s) {
          u32x4 w;
          w.x = pk2(S[sub][8 * s + 0], S[sub][8 * s + 1]); w.y = pk2(S[sub][8 * s + 2], S[sub][8 * s + 3]);
          w.z = pk2(S[sub][8 * s + 4], S[sub][8 * s + 5]); w.w = pk2(S[sub][8 * s + 6], S[sub][8 * s + 7]);
          const bf16x8 pf = __builtin_bit_cast(bf16x8, w);
          __builtin_amdgcn_sched_barrier(0);
#pragma unroll
          for (int blk = 0; blk < DV / 32; ++blk) {
            bf16x8 vf = *(const bf16x8*)(vp0 + blk * 32 * 144 + sub * 64 + s * 32);
            O[blk] = mfma32(vf, pf, O[blk]);
          }
        }
    }
    if (more) { if (MODE == 1) lwriteK((kt + 1) & 1); lwriteV((kt + 1) & 1); }
    __syncthreads();
  }
  const float lt = l + __shfl_xor(l, 32);
  const float inv = 1.f / lt;
  if (MODE == 0) {
    float* xch = (float*)lds;
    const float lam = ((const float*)(ws + W_MISC))[0];
    if (comp == 1) {
#pragma unroll
      for (int blk = 0; blk < 4; ++blk)
#pragma unroll
        for (int r = 0; r < 16; ++r) xch[(qsub * 32 + l31) * 132 + blk * 32 + accrow(r, hh)] = O[blk][r] * inv * lam;
    }
    __syncthreads();
    if (comp == 0 && !dry) {
      float ss = 0.f;
#pragma unroll
      for (int blk = 0; blk < 4; ++blk)
#pragma unroll
        for (int r = 0; r < 16; ++r) { const float v = O[blk][r] * inv - xch[(qsub * 32 + l31) * 132 + blk * 32 + accrow(r, hh)]; O[blk][r] = v; ss += v * v; }
      ss += __shfl_xor(ss, 32);
      const float rs = rsqrtf(ss * (1.f / 128.f) + EPS) * 0.8f;
      bf16_t* o = (bf16_t*)(ws + W_C) + (size_t)qtok * LDH + h * 128;
      const float* sg = p.in[10];
#pragma unroll
      for (int blk = 0; blk < 4; ++blk)
#pragma unroll
        for (int g = 0; g < 4; ++g) {
          const int dv = blk * 32 + 8 * g + 4 * hh;
          f32x4 gg = *(const f32x4*)(sg + dv);
          u32x2 w; w.x = pk2(O[blk][4 * g] * rs * gg[0], O[blk][4 * g + 1] * rs * gg[1]); w.y = pk2(O[blk][4 * g + 2] * rs * gg[2], O[blk][4 * g + 3] * rs * gg[3]);
          *(u32x2*)(o + dv) = w;
        }
    }
    __syncthreads();
  } else {
    if (active && !dry) {
      bf16_t* o = (bf16_t*)(ws + W_B) + (size_t)qtok * LDH + h * 64;
#pragma unroll
      for (int blk = 0; blk < 2; ++blk)
#pragma unroll
        for (int g = 0; g < 4; ++g) {
          const int dv = blk * 32 + 8 * g + 4 * hh;
          u32x2 w; w.x = pk2(O[blk][4 * g] * inv, O[blk][4 * g + 1] * inv); w.y = pk2(O[blk][4 * g + 2] * inv, O[blk][4 * g + 3] * inv);
          *(u32x2*)(o + dv) = w;
        }
    }
  }
}

__device__ void attn_item_mla(const Params& p, char* lds, int grp, int b, int h, int qblk, int dry) {
  constexpr int KSTR = 208, KBYTES = 64 * KSTR, BUF = KBYTES + 64 * 144;
  char* ws = p.ws;
  int tid = threadIdx.x; asm volatile("" : "+v"(tid));
  const int lane = tid & 63, wid = tid >> 6, hh = lane >> 5, l31 = lane & 31;
  const int Lk = grp == 0 ? SEQP : LKS;
  const int tok0 = grp == 0 ? (b * SEQ + qblk * 256) : (TP + b * 64);
  const int qpos0 = grp == 0 ? qblk * 256 : PAST;
  const int krow0 = grp == 0 ? b * SEQ : TP + b * LKS;
  const int nkt = grp == 0 ? (4 * qblk + 4) : 33;
  const int my_last = grp == 0 ? (4 * qblk + wid) : 32;
  const bool active = grp == 0 ? true : (wid == 0);
  bf16x8 qf[2][6];
#pragma unroll
  for (int qs = 0; qs < 2; ++qs) {
    const int qt = active ? tok0 + wid * 64 + qs * 32 + l31 : tok0;
    const int qp = active ? qpos0 + wid * 64 + qs * 32 + l31 : qpos0;
    const bf16_t* q = (const bf16_t*)(ws + W_B) + (size_t)qt * LDH + h * 64 + hh * 8;
#pragma unroll
    for (int ks = 0; ks < 4; ++ks) qf[qs][ks] = *(const bf16x8*)(q + ks * 16);
    const bf16_t* qpe = (const bf16_t*)(ws + F_ZCQ) + (size_t)qt * 512 + h * 32 + hh * 8;
    const bf16x8 a = *(const bf16x8*)(qpe), c = *(const bf16x8*)(qpe + 16);
    const float2* rt = (const float2*)(ws + W_ROPE) + (size_t)qp * 16 + hh * 8;
    float o1[8], o2[8];
#pragma unroll
    for (int j = 0; j < 8; ++j) {
      const float x1 = bf2f((bf16_t)a[j]), x2 = bf2f((bf16_t)c[j]); const float2 cs = rt[j];
      o1[j] = x1 * cs.x - x2 * cs.y; o2[j] = x1 * cs.y + x2 * cs.x;
    }
    u32x4 w1, w2;
    w1.x = pk2(o1[0], o1[1]); w1.y = pk2(o1[2], o1[3]); w1.z = pk2(o1[4], o1[5]); w1.w = pk2(o1[6], o1[7]);
    w2.x = pk2(o2[0], o2[1]); w2.y = pk2(o2[2], o2[3]); w2.z = pk2(o2[4], o2[5]); w2.w = pk2(o2[6], o2[7]);
    qf[qs][4] = __builtin_bit_cast(bf16x8, w1); qf[qs][5] = __builtin_bit_cast(bf16x8, w2);
  }
  const bf16_t* kg = (const bf16_t*)(ws + W_D) + (size_t)krow0 * LDH + h * 64;
  const bf16_t* kpe = (const bf16_t*)(ws + W_KPE) + (size_t)krow0 * 32;
  const bf16_t* vg = grp == 0 ? (const bf16_t*)(ws + W_D2) + (size_t)(b * 1024 + h * 64) * SEQP : (const bf16_t*)(ws + W_D2 + SZ_VTP) + (size_t)(b * 1024 + h * 64) * LKS;
  u32x4 rk[3], rv[2];
  auto gload = [&](int kt) {
#pragma unroll
    for (int i = 0; i < 3; ++i) {
      const int q = tid + 256 * i; const int row = q / 12, ch = q % 12;
      const bf16_t* src = (ch < 8) ? kg + (size_t)(kt * 64 + row) * LDH + ch * 8 : kpe + (size_t)(kt * 64 + row) * 32 + (ch - 8) * 8;
      rk[i] = *(const u32x4*)src;
    }
#pragma unroll
    for (int i = 0; i < 2; ++i) { const int q = tid + 256 * i; const int row = q >> 3, ch = q & 7; rv[i] = *(const u32x4*)(vg + (size_t)row * Lk + kt * 64 + ch * 8); }
  };
  auto lwrite = [&](int buf) {
    char* base = lds + buf * BUF;
#pragma unroll
    for (int i = 0; i < 3; ++i) { const int q = tid + 256 * i; const int row = q / 12, ch = q % 12; *(u32x4*)(base + row * KSTR + ch * 16) = rk[i]; }
#pragma unroll
    for (int i = 0; i < 2; ++i) { const int q = tid + 256 * i; const int row = q >> 3, ch = q & 7; *(u32x4*)(base + KBYTES + row * 144 + ch * 16) = rv[i]; }
  };
  f32x16 O[2][2];
#pragma unroll
  for (int qs = 0; qs < 2; ++qs)
#pragma unroll
    for (int i = 0; i < 2; ++i)
#pragma unroll
      for (int r = 0; r < 16; ++r) O[qs][i][r] = 0.f;
  float m[2] = {-1e30f, -1e30f}, l[2] = {0.f, 0.f};
  gload(0); lwrite(0);
  __syncthreads();
  for (int kt = 0; kt < nkt; ++kt) {
    const bool more = (kt + 1 < nkt);
    if (more) gload(kt + 1);
    if (active && kt <= my_last) {
      const char* base = lds + (kt & 1) * BUF;
      const char* kp0 = base + l31 * KSTR + hh * 16;
      const char* vp0 = base + KBYTES + l31 * 144 + hh * 16;
#pragma unroll 1
      for (int sub = 0; sub < 2; ++sub) {
        f32x16 S[2];
#pragma unroll
        for (int r = 0; r < 16; ++r) { S[0][r] = 0.f; S[1][r] = 0.f; }
#pragma unroll
        for (int ks = 0; ks < 6; ++ks) {
          const bf16x8 kf = *(const bf16x8*)(kp0 + sub * 32 * KSTR + ks * 32);
          S[0] = mfma32(kf, qf[0][ks], S[0]);
          S[1] = mfma32(kf, qf[1][ks], S[1]);
        }
#pragma unroll
        for (int qs = 0; qs < 2; ++qs) {
          float mx = S[qs][0];
#pragma unroll
          for (int r = 1; r < 16; ++r) mx = fmaxf(mx, S[qs][r]);
          mx = fmaxf(mx, __shfl_xor(mx, 32));
          if (__any(mx > m[qs])) {
            const float mn = fmaxf(m[qs], mx);
            const float alpha = __builtin_amdgcn_exp2f(m[qs] - mn);
            m[qs] = mn; l[qs] *= alpha;
#pragma unroll
            for (int i = 0; i < 2; ++i)
#pragma unroll
              for (int r = 0; r < 16; ++r) O[qs][i][r] *= alpha;
          }
          f32v2_t ps2 = {0.f, 0.f}; const f32v2_t m2 = {m[qs], m[qs]};
#pragma unroll
          for (int r = 0; r < 16; r += 2) {
            f32v2_t v = (f32v2_t){S[qs][r], S[qs][r + 1]} - m2;
            v[0] = __builtin_amdgcn_exp2f(v[0]); v[1] = __builtin_amdgcn_exp2f(v[1]);
            S[qs][r] = v[0]; S[qs][r + 1] = v[1]; ps2 += v;
          }
          l[qs] += ps2[0] + ps2[1];
        }
#pragma unroll
        for (int s2 = 0; s2 < 2; ++s2) {
          u32x4 w0, w1;
          w0.x = pk2(S[0][8 * s2 + 0], S[0][8 * s2 + 1]); w0.y = pk2(S[0][8 * s2 + 2], S[0][8 * s2 + 3]);
          w0.z = pk2(S[0][8 * s2 + 4], S[0][8 * s2 + 5]); w0.w = pk2(S[0][8 * s2 + 6], S[0][8 * s2 + 7]);
          w1.x = pk2(S[1][8 * s2 + 0], S[1][8 * s2 + 1]); w1.y = pk2(S[1][8 * s2 + 2], S[1][8 * s2 + 3]);
          w1.z = pk2(S[1][8 * s2 + 4], S[1][8 * s2 + 5]); w1.w = pk2(S[1][8 * s2 + 6], S[1][8 * s2 + 7]);
          const bf16x8 pf0 = __builtin_bit_cast(bf16x8, w0), pf1 = __builtin_bit_cast(bf16x8, w1);
#pragma unroll
          for (int blk = 0; blk < 2; ++blk) {
            const bf16x8 vf = *(const bf16x8*)(vp0 + blk * 32 * 144 + sub * 64 + s2 * 32);
            O[0][blk] = mfma32(vf, pf0, O[0][blk]);
            O[1][blk] = mfma32(vf, pf1, O[1][blk]);
          }
        }
      }
    }
    if (more) lwrite((kt + 1) & 1);
    __syncthreads();
  }
  if (active && !dry) {
#pragma unroll
    for (int qs = 0; qs < 2; ++qs) {
      const float lt = l[qs] + __shfl_xor(l[qs], 32);
      const float inv = 1.f / lt;
      const int qtok = tok0 + wid * 64 + qs * 32 + l31;
      bf16_t* o = (bf16_t*)(ws + W_B) + (size_t)qtok * LDH + h * 64;
#pragma unroll
      for (int blk = 0; blk < 2; ++blk)
#pragma unroll
        for (int g = 0; g < 4; ++g) {
          const int dv = blk * 32 + 8 * g + 4 * hh;
          u32x2 w; w.x = pk2(O[qs][blk][4 * g] * inv, O[qs][blk][4 * g + 1] * inv); w.y = pk2(O[qs][blk][4 * g + 2] * inv, O[qs][blk][4 * g + 3] * inv);
          *(u32x2*)(o + dv) = w;
        }
    }
  }
}

__device__ void phase_attn_diff(const Params& p, char* lds, int* s_item, int dry) {
  const int x = blockIdx.x & 7;
  const int total = 512 + 8;
  unsigned* q = (unsigned*)(p.ws + W_BAR) + QW + dry * 8 + x;
  for (;;) {
    if (threadIdx.x == 0) *s_item = (int)__hip_atomic_fetch_add(q, 1u, __ATOMIC_RELAXED, __HIP_MEMORY_SCOPE_AGENT);
    __syncthreads();
    const int u = *s_item;
    __syncthreads();
    if (u >= total) break;
    int grp = 0, bh, qblk = 0;
    if (u < 256) { qblk = 63 - (u >> 3); bh = (u & 7) * 8 + x; }
    else if (u < 264) { grp = 1; bh = (u - 256) * 8 + x; }
    else { const int v = u - 8; qblk = 63 - (v >> 3); bh = (v & 7) * 8 + x; }
    attn_item<0>(p, lds, grp, bh >> 3, bh & 7, qblk, dry);
  }
}
__device__ void phase_attn_mla(const Params& p, char* lds, int* s_item, int dry) {
  const int x = blockIdx.x & 7;
  const int total = 256 + 16;
  unsigned* q = (unsigned*)(p.ws + W_BAR) + QW + 16 + dry * 8 + x;
  for (;;) {
    if (threadIdx.x == 0) *s_item = (int)__hip_atomic_fetch_add(q, 1u, __ATOMIC_RELAXED, __HIP_MEMORY_SCOPE_AGENT);
    __syncthreads();
    const int u = *s_item;
    __syncthreads();
    if (u >= total) break;
    int grp = 0, bh, qblk = 0;
    if (u < 128) { qblk = 15 - (u >> 4); bh = (u & 15) * 8 + x; }
    else if (u < 144) { grp = 1; bh = (u - 128) * 8 + x; }
    else { const int v = u - 16; qblk = 15 - (v >> 4); bh = (v & 15) * 8 + x; }
    attn_item_mla(p, lds, grp, bh >> 4, bh & 15, qblk, dry);
  }
}

__device__ void phase_mla_expand(const Params& p, char* lds) {
  char* ws = p.ws;
  const int lane = threadIdx.x & 63, wid = threadIdx.x >> 6, wr = wid >> 1, wc = wid & 1, hh = lane >> 5, l31 = lane & 31;
  for (int it = 0, setB = 0;; ++it) {
    int mt, nt;
    if (!setB) { if (!tile_at(260, 12, it, mt, nt)) { setB = 1; it = -1; continue; } }
    else if (!tile_at(388, 16, it, mt, nt)) break;
    f32x16 acc[2][2]; zero_acc(acc);
    const int m0 = mt * 128, n0 = nt * 128;
    if (!setB) {
      gemm_mainloop<true>((const bf16_t*)(ws + F_CQ) + (size_t)m0 * LDQ, LDQ, (const bf16_t*)(ws + W_WUQ) + (size_t)n0 * LDQ, LDQ, 256, acc, lds, 2 * ((mt + nt) & 7));
      const float sc = 0.10206207261596577f * LOG2E;
#pragma unroll
      for (int i = 0; i < 2; ++i)
#pragma unroll
        for (int j = 0; j < 2; ++j) {
          const int tok = m0 + wr * 64 + i * 32 + l31; const int cb = n0 + wc * 64 + j * 32;
          if (nt < 8) st_bf16_sw((bf16_t*)(ws + W_B) + (size_t)tok * LDH + cb, acc[i][j], hh, sc);
          else st_bf16_sw((bf16_t*)(ws + F_ZCQ) + (size_t)tok * 512 + (cb - 1024), acc[i][j], hh, sc);
        }
    } else if (nt < 8) {
      gemm_mainloop<true>((const bf16_t*)(ws + W_G) + (size_t)m0 * LDK, LDK, (const bf16_t*)(ws + W_WUKV) + (size_t)n0 * LDK, LDK, 128, acc, lds, 2 * ((mt + nt) & 7));
#pragma unroll
      for (int i = 0; i < 2; ++i)
#pragma unroll
        for (int j = 0; j < 2; ++j) {
          const int row = m0 + wr * 64 + i * 32 + l31; const int cb = n0 + wc * 64 + j * 32;
          st_bf16_sw((bf16_t*)(ws + W_D) + (size_t)row * LDH + cb, acc[i][j], hh, 1.f);
        }
    } else {
      gemm_mainloop<false>((const bf16_t*)(ws + W_G) + (size_t)m0 * LDK, LDK, (const bf16_t*)(ws + W_WUKV) + (size_t)n0 * LDK, LDK, 128, acc, lds, 2 * ((mt + nt) & 7));
#pragma unroll
      for (int i = 0; i < 2; ++i)
#pragma unroll
        for (int j = 0; j < 2; ++j) {
          const int mb = m0 + wr * 64 + i * 32; const int nn = n0 - 1024 + wc * 64 + j * 32 + l31;
          bf16_t* vt; int key32;
          if (mb < TP) { const int b = mb >> 12; vt = (bf16_t*)(ws + W_D2) + ((size_t)(b * 1024 + nn)) * SEQP; key32 = mb & 4095; }
          else { const int x = mb - TP; const int b = x / LKS; vt = (bf16_t*)(ws + W_D2 + SZ_VTP) + ((size_t)(b * 1024 + nn)) * LKS; key32 = x - b * LKS; }
          vt_store(vt, key32, acc[i][j], hh);
        }
    }
  }
}

__device__ void phase_merge(const Params& p, char* lds) {
  char* ws = p.ws;
  const int lane = threadIdx.x & 63, wid = threadIdx.x >> 6, wr = wid >> 1, wc = wid & 1, hh = lane >> 5, l31 = lane & 31;
  const bf16_t* gates = (const bf16_t*)(p.out + O_Y);
  bf16_t* mg = (bf16_t*)(ws + W_F);
  for (int it = 0;; ++it) {
    int mt, nt; if (!tile_at(260, 8, it, mt, nt)) break;
    const int m0 = mt * 128, n0 = nt * 128;
    {
      f32x16 acc[2][2]; zero_acc(acc);
      gemm_mainloop<true>((const bf16_t*)(ws + W_C) + (size_t)m0 * LDH, LDH, (const bf16_t*)(ws + W_WA) + (size_t)n0 * LDH, LDH, 1024, acc, lds, 2 * ((mt + nt) & 7));
#pragma unroll
      for (int i = 0; i < 2; ++i)
#pragma unroll
        for (int j = 0; j < 2; ++j) {
          const int tok = m0 + wr * 64 + i * 32 + l31; const int cb = n0 + wc * 64 + j * 32;
          const bf16_t* gp = gates + (size_t)tok * 2048 + cb + 4 * hh;
          bf16_t* op = mg + (size_t)tok * LDH + cb + 4 * hh;
#pragma unroll
          for (int g = 0; g < 4; ++g) {
            const u32x2 gv = *(const u32x2*)(gp + 8 * g);
            u32x2 w;
            w.x = pk2(acc[i][j][4 * g] * bflo(gv.x), acc[i][j][4 * g + 1] * bfhi(gv.x));
            w.y = pk2(acc[i][j][4 * g + 2] * bflo(gv.y), acc[i][j][4 * g + 3] * bfhi(gv.y));
            *(u32x2*)(op + 8 * g) = w;
          }
        }
    }
    {
      f32x16 acc[2][2]; zero_acc(acc);
      gemm_mainloop<true>((const bf16_t*)(ws + W_B) + (size_t)m0 * LDH, LDH, (const bf16_t*)(ws + W_WB) + (size_t)n0 * LDH, LDH, 1024, acc, lds, 2 * ((mt + nt) & 7));
      int l31b = l31; asm volatile("" : "+v"(l31b));
#pragma unroll
      for (int i = 0; i < 2; ++i)
#pragma unroll
        for (int j = 0; j < 2; ++j) {
          const int tok = m0 + wr * 64 + i * 32 + l31b; const int cb = n0 + wc * 64 + j * 32;
          const bf16_t* gp = gates + (size_t)tok * 2048 + 1024 + cb + 4 * hh;
          bf16_t* op = mg + (size_t)tok * LDH + cb + 4 * hh;
#pragma unroll
          for (int g = 0; g < 4; ++g) {
            const u32x2 gv = *(const u32x2*)(gp + 8 * g);
            const u32x2 pv = *(const u32x2*)(op + 8 * g);
            u32x2 w;
            w.x = pk2(bflo(pv.x) + acc[i][j][4 * g] * bflo(gv.x), bfhi(pv.x) + acc[i][j][4 * g + 1] * bfhi(gv.x));
            w.y = pk2(bflo(pv.y) + acc[i][j][4 * g + 2] * bflo(gv.y), bfhi(pv.y) + acc[i][j][4 * g + 3] * bfhi(gv.y));
            *(u32x2*)(op + 8 * g) = w;
          }
        }
    }
  }
}

__device__ void phase_outproj(const Params& p, char* lds) {
  char* ws = p.ws;
  const int lane = threadIdx.x & 63, wid = threadIdx.x >> 6, wr = wid >> 1, wc = wid & 1, hh = lane >> 5, l31 = lane & 31;
  float* x1 = (float*)(ws + D_X1);
  for (int it = 0;; ++it) {
    int mt, nt; if (!tile_at(260, 8, it, mt, nt)) break;
    const int m0 = mt * 128, n0 = nt * 128;
    f32x16 acc[2][2]; zero_acc(acc);
    gemm_mainloop<true>((const bf16_t*)(ws + W_F) + (size_t)m0 * LDH, LDH, (const bf16_t*)(ws + W_WO) + (size_t)n0 * LDH, LDH, 1024, acc, lds, 2 * ((mt + nt) & 7));
#pragma unroll
    for (int i = 0; i < 2; ++i)
#pragma unroll
      for (int j = 0; j < 2; ++j) {
        const int tok = m0 + wr * 64 + i * 32 + l31; const int cb = n0 + wc * 64 + j * 32 + 4 * hh;
        const float* xr = ((tok < TP) ? p.in[0] + (size_t)tok * 1024 : p.in[1] + (size_t)(tok - TP) * 1024) + cb;
        float* orow = x1 + (size_t)tok * 1024 + cb;
#pragma unroll
        for (int g = 0; g < 4; ++g) {
          const f32x4 xv = *(const f32x4*)(xr + 8 * g);
          f32x4 w = {xv[0] + acc[i][j][4 * g], xv[1] + acc[i][j][4 * g + 1], xv[2] + acc[i][j][4 * g + 2], xv[3] + acc[i][j][4 * g + 3]};
          *(f32x4*)(orow + 8 * g) = w;
        }
      }
  }
}

__device__ void phase_ffn_norm(const Params& p) {
  char* ws = p.ws;
  const int gtid = blockIdx.x * 256 + threadIdx.x, gthreads = gridDim.x * 256;
  const int gw = gtid >> 6, nw = gthreads >> 6, lane = threadIdx.x & 63;
  const float* x1 = (const float*)(ws + D_X1); bf16_t* hf = (bf16_t*)(ws + W_C); const float* g = p.in[19];
  for (int t = gw; t < T; t += nw) {
    const float* x = x1 + (size_t)t * DM;
    f32x4 v[4]; float ss = 0.f;
#pragma unroll
    for (int i = 0; i < 4; ++i) { v[i] = *(const f32x4*)(x + i * 256 + lane * 4); ss += v[i][0] * v[i][0] + v[i][1] * v[i][1] + v[i][2] * v[i][2] + v[i][3] * v[i][3]; }
    ss = wave_sum(ss);
    const float rs = rsqrtf(ss * (1.f / DM) + EPS);
#pragma unroll
    for (int i = 0; i < 4; ++i) {
      f32x4 gg = *(const f32x4*)(g + i * 256 + lane * 4);
      u32x2 w; w.x = pk2(v[i][0] * rs * gg[0], v[i][1] * rs * gg[1]); w.y = pk2(v[i][2] * rs * gg[2], v[i][3] * rs * gg[3]);
      *(u32x2*)(hf + (size_t)t * LDH + i * 256 + lane * 4) = w;
    }
  }
  unsigned char* q8 = (unsigned char*)(ws + W_F); float* qs = (float*)(ws + W_F + 33554432);
  for (int r = gw; r < 2 * 16384; r += nw) {
    const float* src = (r < 16384) ? p.in[22] + (size_t)r * DM : p.in[23] + (size_t)(r - 16384) * DM;
    f32x4 v[4]; float am = 0.f;
#pragma unroll
    for (int i = 0; i < 4; ++i) { v[i] = *(const f32x4*)(src + lane * 16 + i * 4); am = fmaxf(am, fmaxf(fmaxf(fabsf(v[i][0]), fabsf(v[i][1])), fmaxf(fabsf(v[i][2]), fabsf(v[i][3])))); }
#pragma unroll
    for (int o = 32; o >= 1; o >>= 1) am = fmaxf(am, __shfl_xor(am, o));
    const float sc = am > 0.f ? 224.f / am : 1.f;
    u32x4 w;
#pragma unroll
    for (int i = 0; i < 4; ++i) {
      int d = 0;
      d = __builtin_amdgcn_cvt_pk_fp8_f32(v[i][0] * sc, v[i][1] * sc, d, false);
      d = __builtin_amdgcn_cvt_pk_fp8_f32(v[i][2] * sc, v[i][3] * sc, d, true);
      w[i] = (unsigned)d;
    }
    *(u32x4*)(q8 + (r < 16384 ? (size_t)r * 2048 : (size_t)(r - 16384) * 2048 + 1024) + lane * 16) = w;
    if (lane == 0) qs[r] = am > 0.f ? am / 224.f : 1.f;
  }
}

__device__ void phase_peer_q(const Params& p, char* lds) {
  char* ws = p.ws;
  const int lane = threadIdx.x & 63, wid = threadIdx.x >> 6, wr = wid >> 1, wc = wid & 1, hh = lane >> 5, l31 = lane & 31;
  bf16_t* pq = (bf16_t*)(ws + W_B);
  for (int it = 0;; ++it) {
    int mt, nt; if (!tile_at(260, 8, it, mt, nt)) break;
    const int m0 = mt * 128, n0 = nt * 128;
    f32x16 acc[2][2]; zero_acc(acc);
    gemm_mainloop<true>((const bf16_t*)(ws + W_C) + (size_t)m0 * LDH, LDH, (const bf16_t*)(ws + W_WQ) + (size_t)n0 * LDH, LDH, 1024, acc, lds, 2 * ((mt + nt) & 7));
#pragma unroll
    for (int i = 0; i < 2; ++i)
#pragma unroll
      for (int j = 0; j < 2; ++j) {
        const int tok = m0 + wr * 64 + i * 32 + l31; const int cb = n0 + wc * 64 + j * 32;
        st_bf16_sw(pq + (size_t)tok * LDH + cb, acc[i][j], hh, 1.f);
      }
  }
}

__device__ __forceinline__ unsigned fkey(float f) { unsigned u = __float_as_uint(f); return (u & 0x80000000u) ? ~u : (u | 0x80000000u); }
__device__ __forceinline__ float fkey_inv(unsigned k) { unsigned u = (k & 0x80000000u) ? (k & 0x7fffffffu) : ~k; return __uint_as_float(u); }
__device__ __forceinline__ void insert16(unsigned (&L)[16], unsigned x) {
#pragma unroll
  for (int i = 0; i < 16; ++i) { const unsigned hi = x > L[i] ? x : L[i]; x = x > L[i] ? L[i] : x; L[i] = hi; }
}
__device__ __forceinline__ void cswap_desc(unsigned& a, unsigned& b) { const unsigned hi = a > b ? a : b, lo = a > b ? b : a; a = hi; b = lo; }
__device__ __forceinline__ void sort16_desc(unsigned (&a)[16]) {
#pragma unroll
  for (int k = 2; k <= 16; k <<= 1)
#pragma unroll
    for (int j = k >> 1; j > 0; j >>= 1)
#pragma unroll
      for (int i = 0; i < 16; ++i) {
        const int l = i ^ j;
        if (l > i) { if ((i & k) == 0) cswap_desc(a[i], a[l]); else cswap_desc(a[l], a[i]); }
      }
}
template <bool SORT>
__device__ __forceinline__ void merge16_desc(unsigned (&a)[16], const unsigned (&b)[16]) {
#pragma unroll
  for (int i = 0; i < 16; ++i) a[i] = a[i] > b[15 - i] ? a[i] : b[15 - i];
  if (SORT) {
#pragma unroll
    for (int j = 8; j > 0; j >>= 1)
#pragma unroll
      for (int i = 0; i < 16; ++i) { const int l = i ^ j; if (l > i) cswap_desc(a[i], a[l]); }
  }
}
__device__ void phase_peer_select(const Params& p, char* lds) {
  char* ws = p.ws;
  const int tid = threadIdx.x, lane = tid & 63, wid = tid >> 6, hh = lane >> 5, l31 = lane & 31;
  const bf16_t* pq = (const bf16_t*)(ws + W_B); const bf16_t* keys = (const bf16_t*)(ws + W_KEYS);
  int* seli = (int*)(ws + D_SELI); float* selw = (float*)(ws + D_SELW);
  float* S = (float*)lds;
  unsigned* LH = (unsigned*)lds;
  unsigned* LF = LH + 2 * 64 * 20;
  for (int u = blockIdx.x; u < 520 * 8; u += gridDim.x) {
    const int tt = u >> 3, h = u & 7; const int t0 = tt * 64;
    {
      const int c = wid >> 1;
      f32x16 acc[2][2]; zero_acc(acc);
      const bf16_t* ap = pq + (size_t)(t0 + l31) * LDH + h * 128 + c * 64 + hh * 8;
      const bf16_t* bp = keys + ((size_t)((h * 2 + c) * 128 + (wid & 1) * 64 + l31)) * 64 + hh * 8;
#pragma unroll
      for (int ks = 0; ks < 4; ++ks) {
        bf16x8 a0 = *(const bf16x8*)(ap + ks * 16), a1 = *(const bf16x8*)(ap + 32 * LDH + ks * 16);
        bf16x8 b0 = *(const bf16x8*)(bp + ks * 16), b1 = *(const bf16x8*)(bp + 32 * 64 + ks * 16);
        acc[0][0] = mfma32(a0, b0, acc[0][0]); acc[0][1] = mfma32(a0, b1, acc[0][1]);
        acc[1][0] = mfma32(a1, b0, acc[1][0]); acc[1][1] = mfma32(a1, b1, acc[1][1]);
      }
#pragma unroll
      for (int i = 0; i < 2; ++i)
#pragma unroll
        for (int j = 0; j < 2; ++j)
#pragma unroll
          for (int r = 0; r < 16; ++r) S[(i * 32 + accrow(r, hh)) * 260 + c * 128 + (wid & 1) * 64 + j * 32 + l31] = acc[i][j][r];
    }
    __syncthreads();
    const int tok = lane, c = wid & 1, half = wid >> 1;
    unsigned L[16];
    {
      const float* sp = S + tok * 260 + c * 128 + half * 64;
#pragma unroll
      for (int grp = 0; grp < 4; ++grp) {
        unsigned G[16];
#pragma unroll
        for (int n4 = 0; n4 < 4; ++n4) {
          const f32x4 v = *(const f32x4*)(sp + grp * 16 + n4 * 4);
          const unsigned ib = (unsigned)(127 - (half * 64 + grp * 16 + n4 * 4));
#pragma unroll
          for (int e = 0; e < 4; ++e) G[n4 * 4 + e] = (fkey(v[e]) & ~127u) | (ib - e);
        }
        sort16_desc(G);
        if (grp == 0) {
#pragma unroll
          for (int i = 0; i < 16; ++i) L[i] = G[i];
        } else merge16_desc<true>(L, G);
      }
    }
    __syncthreads();
    if (half == 1) {
#pragma unroll
      for (int i = 0; i < 16; i += 4) { u32x4 w = {L[i], L[i + 1], L[i + 2], L[i + 3]}; *(u32x4*)(LH + (c * 64 + tok) * 20 + i) = w; }
    }
    __syncthreads();
    if (half == 0) {
      unsigned G[16];
#pragma unroll
      for (int i = 0; i < 16; i += 4) {
        const u32x4 w = *(const u32x4*)(LH + (c * 64 + tok) * 20 + i);
        G[i] = w[0]; G[i + 1] = w[1]; G[i + 2] = w[2]; G[i + 3] = w[3];
      }
      merge16_desc<true>(L, G);
#pragma unroll
      for (int i = 0; i < 16; i += 4) { u32x4 w = {L[i], L[i + 1], L[i + 2], L[i + 3]}; *(u32x4*)(LF + (c * 64 + tok) * 20 + i) = w; }
    }
    __syncthreads();
    if (wid == 0) {
      float a[16], b[16];
#pragma unroll
      for (int i = 0; i < 16; ++i) a[i] = fkey_inv(L[i]);
#pragma unroll
      for (int j = 0; j < 16; j += 4) {
        const u32x4 w = *(const u32x4*)(LF + (64 + tok) * 20 + j);
        b[j] = fkey_inv(w[0]); b[j + 1] = fkey_inv(w[1]); b[j + 2] = fkey_inv(w[2]); b[j + 3] = fkey_inv(w[3]);
      }
      unsigned M[16], G[16];
#pragma unroll
      for (int j = 0; j < 16; ++j) M[j] = (fkey(a[0] + b[j]) & ~255u) | (unsigned)(255 - j);
      sort16_desc(M);
#define PK_CAND(i, j) ((fkey(a[i] + b[j]) & ~255u) | (unsigned)(255 - ((i) * 16 + (j))))
      G[0] = PK_CAND(1, 0); G[1] = PK_CAND(1, 1); G[2] = PK_CAND(1, 2); G[3] = PK_CAND(1, 3); G[4] = PK_CAND(1, 4); G[5] = PK_CAND(1, 5); G[6] = PK_CAND(1, 6); G[7] = PK_CAND(1, 7);
      G[8] = PK_CAND(2, 0); G[9] = PK_CAND(2, 1); G[10] = PK_CAND(2, 2); G[11] = PK_CAND(2, 3); G[12] = PK_CAND(2, 4); G[13] = 0u; G[14] = 0u; G[15] = 0u;
      sort16_desc(G); merge16_desc<true>(M, G);
      G[0] = PK_CAND(3, 0); G[1] = PK_CAND(3, 1); G[2] = PK_CAND(3, 2); G[3] = PK_CAND(3, 3); G[4] = PK_CAND(4, 0); G[5] = PK_CAND(4, 1); G[6] = PK_CAND(4, 2);
      G[7] = PK_CAND(5, 0); G[8] = PK_CAND(5, 1); G[9] = PK_CAND(6, 0); G[10] = PK_CAND(6, 1); G[11] = PK_CAND(7, 0); G[12] = PK_CAND(7, 1); G[13] = 0u; G[14] = 0u; G[15] = 0u;
      sort16_desc(G); merge16_desc<true>(M, G);
      G[0] = PK_CAND(8, 0); G[1] = PK_CAND(9, 0); G[2] = PK_CAND(10, 0); G[3] = PK_CAND(11, 0); G[4] = PK_CAND(12, 0); G[5] = PK_CAND(13, 0); G[6] = PK_CAND(14, 0); G[7] = PK_CAND(15, 0);
#pragma unroll
      for (int i = 8; i < 16; ++i) G[i] = 0u;
      sort16_desc(G); merge16_desc<true>(M, G);
#undef PK_CAND
      const float mx = fkey_inv(M[0]);
      float ev[16], den = 0.f;
#pragma unroll
      for (int k = 0; k < 16; ++k) { ev[k] = __expf(fkey_inv(M[k]) - mx); den += ev[k]; }
      const float rden = 1.f / den;
      const size_t o = ((size_t)(t0 + tok) * 8 + h) * 16;
#pragma unroll
      for (int k4 = 0; k4 < 16; k4 += 4) {
        int id[4]; f32x4 wv;
#pragma unroll
        for (int e = 0; e < 4; ++e) {
          const int flat = 255 - (int)(M[k4 + e] & 255u);
          const int i1 = 127 - (int)(LF[tok * 20 + (flat >> 4)] & 127u), i2 = 127 - (int)(LF[(64 + tok) * 20 + (flat & 15)] & 127u);
          id[e] = i1 * 128 + i2; wv[e] = ev[k4 + e] * rden;
        }
        *(int4*)(seli + o + k4) = make_int4(id[0], id[1], id[2], id[3]);
        *(f32x4*)(selw + o + k4) = wv;
      }
    }
    __syncthreads();
  }
}

__device__ __forceinline__ void peer_token_part(const Params& p, int t, int e_lo, int e_hi, float (&ov)[16], int lane) {
  char* ws = p.ws;
  const bf16_t* hf = (const bf16_t*)(ws + W_C);
  const unsigned char* u8 = (const unsigned char*)(ws + W_F); const unsigned char* v8 = u8 + 1024;
  const float* qs = (const float*)(ws + W_F + 33554432);
  const int* seli = (const int*)(ws + D_SELI); const float* selw = (const float*)(ws + D_SELW);
  f32v2_t hv[8], o2[8];
  {
    u32x4 a = *(const u32x4*)(hf + (size_t)t * LDH + lane * 16), b = *(const u32x4*)(hf + (size_t)t * LDH + lane * 16 + 8);
#pragma unroll
    for (int i = 0; i < 4; ++i) { hv[i] = (f32v2_t){bflo(a[i]), bfhi(a[i])}; hv[4 + i] = (f32v2_t){bflo(b[i]), bfhi(b[i])}; }
#pragma unroll
    for (int i = 0; i < 8; ++i) o2[i] = (f32v2_t){ov[2 * i], ov[2 * i + 1]};
  }
  const int myi0 = seli[(size_t)t * 128 + lane], myi1 = seli[(size_t)t * 128 + 64 + lane];
  const float mysu0 = qs[myi0], mysu1 = qs[myi1];
  const float myw0 = selw[(size_t)t * 128 + lane] * qs[16384 + myi0], myw1 = selw[(size_t)t * 128 + 64 + lane] * qs[16384 + myi1];
  const int b0 = lane & 1, b1 = lane & 2, b2 = lane & 4;
  for (int e0 = e_lo; e0 < e_hi; e0 += 8) {
    u32x4 ua[8], va[8];
    const int esel = (e0 & 63) + (lane & 7);
    const float sul = __shfl(e0 < 64 ? mysu0 : mysu1, esel), gwl = __shfl(e0 < 64 ? myw0 : myw1, esel);
#pragma unroll
    for (int k = 0; k < 8; ++k) {
      const int idx = __shfl(e0 < 64 ? myi0 : myi1, (e0 & 63) + k);
      ua[k] = *(const u32x4*)(u8 + (size_t)idx * 2048 + lane * 16);
      va[k] = *(const u32x4*)(v8 + (size_t)idx * 2048 + lane * 16);
    }
    float d[8];
#pragma unroll
    for (int k = 0; k < 8; ++k) {
      f32v2_t acc = {0.f, 0.f};
#pragma unroll
      for (int i = 0; i < 4; ++i) {
        const f32v2_t lo = __builtin_amdgcn_cvt_pk_f32_fp8((int)ua[k][i], false), hi = __builtin_amdgcn_cvt_pk_f32_fp8((int)ua[k][i], true);
        acc = hv[2 * i] * lo + acc; acc = hv[2 * i + 1] * hi + acc;
      }
      d[k] = acc[0] + acc[1];
    }
    float v4[4], v2[2], v1;
#pragma unroll
    for (int j = 0; j < 4; ++j) { const float keep = b0 ? d[2 * j + 1] : d[2 * j], send = b0 ? d[2 * j] : d[2 * j + 1]; v4[j] = keep + __shfl_xor(send, 1); }
#pragma unroll
    for (int j = 0; j < 2; ++j) { const float keep = b1 ? v4[2 * j + 1] : v4[2 * j], send = b1 ? v4[2 * j] : v4[2 * j + 1]; v2[j] = keep + __shfl_xor(send, 2); }
    { const float keep = b2 ? v2[1] : v2[0], send = b2 ? v2[0] : v2[1]; v1 = keep + __shfl_xor(send, 4); }
    v1 += __shfl_xor(v1, 8); v1 += __shfl_xor(v1, 16); v1 += __shfl_xor(v1, 32);
    const float dl = v1 * sul;
    const float wl = gwl * (0.5f * dl * (1.f + erff(dl * 0.70710678118654752f)));
#pragma unroll
    for (int k = 0; k < 8; ++k) {
      const float w = __builtin_bit_cast(float, __builtin_amdgcn_readlane(__builtin_bit_cast(int, wl), k));
      const f32v2_t w2 = {w, w};
#pragma unroll
      for (int i = 0; i < 4; ++i) {
        const f32v2_t lo = __builtin_amdgcn_cvt_pk_f32_fp8((int)va[k][i], false), hi = __builtin_amdgcn_cvt_pk_f32_fp8((int)va[k][i], true);
        o2[2 * i] = w2 * lo + o2[2 * i]; o2[2 * i + 1] = w2 * hi + o2[2 * i + 1];
      }
    }
  }
#pragma unroll
  for (int i = 0; i < 8; ++i) { ov[2 * i] = o2[i][0]; ov[2 * i + 1] = o2[i][1]; }
}
__device__ __forceinline__ void peer_token_finish(const Params& p, int t, float (&ov)[16], int lane) {
  const float* xr = (const float*)(p.ws + D_X1) + (size_t)t * DM + lane * 16; const float* g = p.in[24] + lane * 16;
  float ss = 0.f;
#pragma unroll
  for (int i = 0; i < 4; ++i) { f32x4 a = *(const f32x4*)(xr + i * 4); ov[4 * i] += a[0]; ov[4 * i + 1] += a[1]; ov[4 * i + 2] += a[2]; ov[4 * i + 3] += a[3]; }
#pragma unroll
  for (int i = 0; i < 16; ++i) ss += ov[i] * ov[i];
  ss = wave_sum(ss);
  const float rs = rsqrtf(ss * (1.f / DM) + EPS);
  float* y = p.out + O_Y + (size_t)t * DM + lane * 16;
#pragma unroll
  for (int i = 0; i < 4; ++i) {
    f32x4 ga = *(const f32x4*)(g + i * 4); f32x4 o;
    o[0] = ov[4 * i] * rs * ga[0]; o[1] = ov[4 * i + 1] * rs * ga[1]; o[2] = ov[4 * i + 2] * rs * ga[2]; o[3] = ov[4 * i + 3] * rs * ga[3];
    *(f32x4*)(y + i * 4) = o;
  }
}
__device__ void phase_peer_gather(const Params& p, char* lds) {
  const int wid = threadIdx.x >> 6, lane = threadIdx.x & 63;
  const int gw = blockIdx.x * 4 + wid, nw = gridDim.x * 4;
  const int t_main = (T / nw) * nw;
  for (int t = gw; t < t_main; t += nw) {
    float ov[16];
#pragma unroll
    for (int i = 0; i < 16; ++i) ov[i] = 0.f;
    peer_token_part(p, t, 0, 128, ov, lane);
    peer_token_finish(p, t, ov, lane);
  }
  float* part = (float*)lds;
  for (int t = t_main + blockIdx.x; t < T; t += gridDim.x) {
    float ov[16];
#pragma unroll
    for (int i = 0; i < 16; ++i) ov[i] = 0.f;
    peer_token_part(p, t, wid * 32, wid * 32 + 32, ov, lane);
    if (wid > 0) {
#pragma unroll
      for (int i = 0; i < 4; ++i) { f32x4 w = {ov[4 * i], ov[4 * i + 1], ov[4 * i + 2], ov[4 * i + 3]}; *(f32x4*)(part + wid * 1024 + lane * 16 + i * 4) = w; }
    }
    __syncthreads();
    if (wid == 0) {
#pragma unroll
      for (int w = 1; w < 4; ++w)
#pragma unroll
        for (int i = 0; i < 4; ++i) { const f32x4 v = *(const f32x4*)(part + w * 1024 + lane * 16 + i * 4); ov[4 * i] += v[0]; ov[4 * i + 1] += v[1]; ov[4 * i + 2] += v[2]; ov[4 * i + 3] += v[3]; }
      peer_token_finish(p, t, ov, lane);
    }
    __syncthreads();
  }
}

constexpr int NPHASE = 12;
__global__ void __launch_bounds__(256, 2) mega(Params p, int ph_lo, int ph_hi, int dupmask) {
  __shared__ __attribute__((aligned(16))) char lds[73728];
  __shared__ int s_item;
  __shared__ unsigned s_bar[4];
  unsigned* bar = (unsigned*)(p.ws + W_BAR);
  const unsigned xcc = xb_xcc_id();
  if (threadIdx.x < 4) s_bar[threadIdx.x] = 0u;
  if (threadIdx.x == 0 && ph_hi - ph_lo > 1) (void)xb_add(&bar[XB_XCNT(xcc)], 1u);
  __syncthreads();
  if (ph_hi > 4096) cg::this_grid().sync();
#define RUN_PHASE(PH, CALL)                                                       \
  if ((ONLY < 0 || ONLY == PH) && ph_lo <= PH && PH < ph_hi) {                    \
    const int nrep = 1 + ((dupmask >> PH) & 1);                                   \
    for (int rep = 0; rep < nrep; ++rep) {                                        \
      const int dry = (rep + 1 < nrep); (void)dry;                                \
      CALL;                                                                       \
      if (dry) grid_barrier(bar, xcc, s_bar);                                     \
    }                                                                             \
    if (PH + 1 < ph_hi) {                                                         \
      grid_barrier(bar, xcc, s_bar);                                              \
    }                                                                             \
  }
  RUN_PHASE(0, phase_prep(p))
  RUN_PHASE(1, phase_inproj(p, lds))
  RUN_PHASE(2, phase_small(p))
  RUN_PHASE(3, phase_attn_diff(p, lds, &s_item, dry))
  RUN_PHASE(4, phase_mla_expand(p, lds))
  RUN_PHASE(5, phase_attn_mla(p, lds, &s_item, dry))
  RUN_PHASE(6, phase_merge(p, lds))
  RUN_PHASE(7, phase_outproj(p, lds))
  RUN_PHASE(8, phase_ffn_norm(p))
  RUN_PHASE(9, phase_peer_q(p, lds))
  RUN_PHASE(10, phase_peer_select(p, lds))
  RUN_PHASE(11, phase_peer_gather(p, lds))
}

extern "C" void kernel_launch(void* const* d_in, const int* in_sizes, int n_in, void* d_out, int out_size, void* d_ws, size_t ws_size,
                              hipStream_t stream) {
  if (ws_size < W_END || n_in < 25) { fprintf(stderr, "workspace too small: %zu < %zu\n", ws_size, (size_t)W_END); return; }
  static int grid_blocks = 0;
  if (!grid_blocks) {
    int dev = 0, cus = 0, per_cu = 0;
    hipGetDevice(&dev);
    hipDeviceGetAttribute(&cus, hipDeviceAttributeMultiprocessorCount, dev);
    hipOccupancyMaxActiveBlocksPerMultiprocessor(&per_cu, mega, 256, 0);
    if (per_cu > 2) per_cu = 2;
    grid_blocks = cus * per_cu;
  }
  Params p{};
  for (int i = 0; i < 25; ++i) p.in[i] = (const float*)d_in[i];
  p.out = (float*)d_out; p.ws = (char*)d_ws; p.nblocks = (unsigned)grid_blocks; p.pad = 0;
  hipMemsetAsync((char*)d_ws + W_BAR, 0, 16384, stream);
#if MULTI_LAUNCH
  for (int ph = 0; ph < NPHASE; ++ph) {
    hipLaunchKernelGGL(mega, dim3(grid_blocks), dim3(256), 0, stream, p, ph, ph + 1, 0);
  }
#else
  int lo = 0, hi = NPHASE, dup = DUPMASK;
  void* args[] = {&p, &lo, &hi, &dup};
  hipError_t e = hipLaunchCooperativeKernel((void*)mega, dim3(grid_blocks), dim3(256), args, 0, stream);
  if (e != hipSuccess) fprintf(stderr, "cooperative launch failed: %s (grid %d)\n", hipGetErrorString(e), grid_blocks);
#endif
}
```

```cpp
#include <hip/hip_runtime.h>
#include <hip/hip_cooperative_groups.h>
#include <cstdio>
#include <cstdint>
namespace cg = cooperative_groups;

#ifndef ONLY
#define ONLY (-1)
#endif
#ifndef DUPMASK
#define DUPMASK 0
#endif
#ifndef MULTI_LAUNCH
#define MULTI_LAUNCH 0
#endif

typedef unsigned short bf16_t;
typedef short bf16x8 __attribute__((ext_vector_type(8)));
typedef float f32x4 __attribute__((ext_vector_type(4)));
typedef float f32x16 __attribute__((ext_vector_type(16)));
typedef unsigned u32x4 __attribute__((ext_vector_type(4)));
typedef unsigned u32x2 __attribute__((ext_vector_type(2)));

constexpr int DM = 1024;
constexpr int TP = 32768, TS = 512, T = TP + TS;
constexpr int SEQ = 4096, PAST = 2048, LKS = 2112;
constexpr int R = TP + 8 * LKS;
constexpr int NIN = 5632;
constexpr int LDH = 1088;
constexpr int LDQ = 288;
constexpr int LDK = 160;
constexpr int SEQP = 4160;
constexpr float LOG2E = 1.4426950408889634f;
constexpr float EPS = 1e-6f;

constexpr size_t O_Y = 0;
constexpr size_t O_KP = 34078720, O_VP = 67633152, O_CP = 101187584, O_EP = 105381888;
constexpr size_t O_KS = 106430464, O_VS = 106954752, O_CS = 107479040, O_ES = 107544576;

constexpr size_t W_WIN = 0;
constexpr size_t W_WUQ = W_WIN + (size_t)NIN * LDH * 2;
constexpr size_t W_WUKV = W_WUQ + (size_t)1536 * LDQ * 2;
constexpr size_t W_WA = W_WUKV + (size_t)2048 * LDK * 2;
constexpr size_t W_WB = W_WA + (size_t)1024 * LDH * 2;
constexpr size_t W_WO = W_WB + (size_t)1024 * LDH * 2;
constexpr size_t W_WQ = W_WO + (size_t)1024 * LDH * 2;
constexpr size_t W_KEYS = W_WQ + (size_t)1024 * LDH * 2;
constexpr size_t W_ROPE = W_KEYS + 262144;
constexpr size_t W_MISC = W_ROPE + 524288;
constexpr size_t W_BAR = W_MISC + 8192;
constexpr int QW = 3584;
constexpr size_t SZ_ACT = (size_t)T * LDH * 2;
constexpr size_t W_B = W_BAR + 16384;
constexpr size_t W_C = W_B + SZ_ACT;
constexpr size_t W_D = W_C + SZ_ACT;
constexpr size_t SZ_VTP = (size_t)8 * 1024 * SEQP * 2, SZ_VTS = (size_t)8 * 1024 * LKS * 2;
constexpr size_t W_D2 = W_D + (size_t)R * LDH * 2;
constexpr size_t W_F = W_D2 + SZ_VTP + SZ_VTS;
constexpr size_t F_ZCQ = W_F, F_ZCKV = F_ZCQ + 34078720, F_ZKR = F_ZCKV + 17039360, F_CQ = F_ZKR + 4259840;
constexpr size_t SZ_F = (F_CQ - W_F) + (size_t)T * LDQ * 2;
static_assert(SZ_F >= SZ_ACT, "merged must fit in F");
constexpr size_t W_G = W_F + SZ_F;
constexpr size_t W_KPE = W_G + (size_t)R * LDK * 2;
constexpr size_t W_END = W_KPE + (size_t)R * 32 * 2;
static_assert(W_END <= 536870912ull, "workspace budget");
constexpr size_t D_X1 = W_D, D_SELI = W_D + 136314880, D_SELW = D_SELI + 17039360;
static_assert(D_SELW + 17039360 <= W_F, "x1 + sel must fit in D");

struct Params {
  const float* in[25];
  float* out;
  char* ws;
  unsigned nblocks;
  unsigned pad;
};

typedef __bf16 bf16v2_t __attribute__((ext_vector_type(2)));
typedef float f32v2_t __attribute__((ext_vector_type(2)));
__device__ __forceinline__ unsigned pk2(float lo, float hi) { f32v2_t v = {lo, hi}; bf16v2_t r = __builtin_convertvector(v, bf16v2_t); return __builtin_bit_cast(unsigned, r); }
__device__ __forceinline__ bf16_t f2bf(float x) { return (bf16_t)(pk2(x, 0.f) & 0xffffu); }
__device__ __forceinline__ float bf2f(bf16_t v) { return __uint_as_float(((unsigned)v) << 16); }
__device__ __forceinline__ float bflo(unsigned w) { return __uint_as_float(w << 16); }
__device__ __forceinline__ float bfhi(unsigned w) { return __uint_as_float(w & 0xffff0000u); }
__device__ __forceinline__ float wave_sum(float v) {
#pragma unroll
  for (int o = 32; o >= 1; o >>= 1) v += __shfl_xor(v, o);
  return v;
}
__device__ __forceinline__ f32x16 mfma32(bf16x8 a, bf16x8 b, f32x16 c) { return __builtin_amdgcn_mfma_f32_32x32x16_bf16(a, b, c, 0, 0, 0); }
__device__ __forceinline__ int accrow(int reg, int hh) { return (reg & 3) + 8 * (reg >> 2) + 4 * hh; }
__device__ __forceinline__ int kperm(int k) { return (k & ~12) | ((k & 4) << 1) | ((k & 8) >> 1); }

__device__ __forceinline__ int keyrow_of_token(int t) {
  if (t < TP) return t;
  int ts = t - TP; return TP + (ts >> 6) * LKS + PAST + (ts & 63);
}

#define XB_XCNT(j)  (256  + 64 * (j))
#define XB_XSUB(j)  (1280 + 64 * (j))
#define XB_XGEN(j)  (2304 + 64 * (j))
#define XB_TOP      3328
#define XB_TOPGEN   3392
__device__ __forceinline__ unsigned xb_ld(unsigned* p)              { return __hip_atomic_load(p, __ATOMIC_RELAXED, __HIP_MEMORY_SCOPE_AGENT); }
__device__ __forceinline__ unsigned xb_add(unsigned* p, unsigned v) { return __hip_atomic_fetch_add(p, v, __ATOMIC_RELAXED, __HIP_MEMORY_SCOPE_AGENT); }
__device__ __forceinline__ unsigned xb_xcc_id() { return (unsigned)__builtin_amdgcn_s_getreg((3 << 11) | 20) & 0xFu; }
__device__ __forceinline__ void grid_barrier(unsigned* bar, unsigned xcc, volatile unsigned* st) {
  asm volatile("s_waitcnt vmcnt(0)" ::: "memory");
  __syncthreads();
  if (threadIdx.x == 0) {
    __builtin_amdgcn_s_waitcnt(0);
    unsigned nloc = st[0], nx = st[1];
    if (nloc == 0u) {
      const unsigned G = gridDim.x;
      for (;;) {
        unsigned sum = 0u, cnt = 0u, mine = 0u;
#pragma unroll
        for (unsigned j = 0; j < 16; ++j) { const unsigned c = xb_ld(&bar[XB_XCNT(j)]); sum += c; cnt += (c > 0u) ? 1u : 0u; mine = (j == xcc) ? c : mine; }
        if (sum == G) { nloc = mine; nx = cnt; break; }
        __builtin_amdgcn_s_sleep(1);
      }
      st[0] = nloc; st[1] = nx;
    }
    const unsigned old = xb_add(&bar[XB_XSUB(xcc)], 1u);
    const unsigned gen = old / nloc;
    if (old + 1u == (gen + 1u) * nloc) {
      __builtin_amdgcn_fence(__ATOMIC_RELEASE, "agent");
      asm volatile("s_waitcnt vmcnt(0)" ::: "memory");
      const unsigned og = xb_add(&bar[XB_TOP], 1u);
      const unsigned tg = og / nx;
      if (og + 1u == (tg + 1u) * nx) xb_add(&bar[XB_TOPGEN], 1u);
      else { while (xb_ld(&bar[XB_TOPGEN]) == tg) __builtin_amdgcn_s_sleep(1); }
      __builtin_amdgcn_fence(__ATOMIC_ACQUIRE, "agent");
      xb_add(&bar[XB_XGEN(xcc)], 1u);
      asm volatile("s_waitcnt vmcnt(0)" ::: "memory");
    } else {
      while (xb_ld(&bar[XB_XGEN(xcc)]) == gen) __builtin_amdgcn_s_sleep(1);
      __builtin_amdgcn_fence(__ATOMIC_ACQUIRE, "agent");
      asm volatile("s_waitcnt vmcnt(0)" ::: "memory");
    }
  }
  __syncthreads();
}

constexpr int GEMM_BUF = 32768;
typedef __attribute__((address_space(3))) unsigned lds_u32_t;
typedef __attribute__((address_space(1))) const unsigned glb_u32_t;
__device__ __forceinline__ void glds16(const bf16_t* g, char* l) {
  __builtin_amdgcn_global_load_lds((glb_u32_t*)g, (lds_u32_t*)l, 16, 0, 0);
}
template <bool SW>
__device__ __forceinline__ void gemm_mainloop(const bf16_t* __restrict__ A, int lda, const bf16_t* __restrict__ Bt, int ldb, int K,
                                              f32x16 (&acc)[2][2], char* lds, int kstart) {
  const int tid = threadIdx.x, lane = tid & 63, wid = tid >> 6;
  const int wr = wid >> 1, wc = wid & 1, l31 = lane & 31, hh = lane >> 5;
  const int lrow = wid * 32 + (lane >> 3);
  const int nk = K >> 6;
  kstart &= (nk - 1);
  const bf16_t* ap[4]; const bf16_t* bp[4];
#pragma unroll
  for (int i = 0; i < 4; ++i) {
    const int row = lrow + 8 * i; const int ch = (lane & 7) ^ ((row >> 1) & 7);
    ap[i] = A + (size_t)row * lda + ch * 8; bp[i] = Bt + (size_t)row * ldb + ch * 8;
  }
  char* ldst = lds + (wid * 32) * 128 + lane * 16;
#pragma unroll
  for (int i = 0; i < 4; ++i) { glds16(ap[i] + kstart * 64, ldst + i * 1024); glds16(bp[i] + kstart * 64, ldst + 16384 + i * 1024); }
  asm volatile("s_waitcnt vmcnt(0)" ::: "memory");
  __syncthreads();
  const int swz = (l31 >> 1) & 7;
  const int roffA = (wr * 64 + l31) * 128, roffB = 16384 + (wc * 64 + l31) * 128;
#pragma unroll 1
  for (int kt = 0; kt < nk; ++kt) {
    const bool more = (kt + 1 < nk);
    if (more) {
      char* d = ldst + ((kt + 1) & 1) * GEMM_BUF;
      const int ko = ((kt + 1 + kstart) & (nk - 1)) * 64;
#pragma unroll
      for (int i = 0; i < 4; ++i) { glds16(ap[i] + ko, d + i * 1024); glds16(bp[i] + ko, d + 16384 + i * 1024); }
    }
    const char* base = lds + (kt & 1) * GEMM_BUF;
#pragma unroll
    for (int ks = 0; ks < 4; ++ks) {
      const int co = ((2 * ks + hh) ^ swz) * 16;
      bf16x8 a0 = *(const bf16x8*)(base + roffA + co), a1 = *(const bf16x8*)(base + roffA + 32 * 128 + co);
      bf16x8 b0 = *(const bf16x8*)(base + roffB + co), b1 = *(const bf16x8*)(base + roffB + 32 * 128 + co);
      if (SW) {
        acc[0][0] = mfma32(b0, a0, acc[0][0]); acc[0][1] = mfma32(b1, a0, acc[0][1]);
        acc[1][0] = mfma32(b0, a1, acc[1][0]); acc[1][1] = mfma32(b1, a1, acc[1][1]);
      } else {
        acc[0][0] = mfma32(a0, b0, acc[0][0]); acc[0][1] = mfma32(a0, b1, acc[0][1]);
        acc[1][0] = mfma32(a1, b0, acc[1][0]); acc[1][1] = mfma32(a1, b1, acc[1][1]);
      }
    }
    asm volatile("s_waitcnt vmcnt(0)" ::: "memory");
    __syncthreads();
  }
}
__device__ __forceinline__ bool tile_at(int nMt, int nNt, int it, int& mt, int& nt) {
  const int x = blockIdx.x & 7, lb = blockIdx.x >> 3, nloc = gridDim.x >> 3;
  const int mb = (x * nMt) >> 3, mc = (((x + 1) * nMt) >> 3) - mb;
  const int idx = lb + it * nloc;
  if (idx >= mc * nNt) return false;
  const int g = idx / (8 * nNt); const int rem = idx - g * 8 * nNt;
  const int left = mc - g * 8; const int gsz = left < 8 ? left : 8;
  mt = mb + g * 8 + rem % gsz; nt = rem / gsz;
  return true;
}
__device__ __forceinline__ void zero_acc(f32x16 (&acc)[2][2]) {
#pragma unroll
  for (int i = 0; i < 2; ++i)
#pragma unroll
    for (int j = 0; j < 2; ++j)
#pragma unroll
      for (int r = 0; r < 16; ++r) acc[i][j][r] = 0.f;
}

__device__ __forceinline__ void vt_store(bf16_t* vt_row, int key32, const f32x16& a, int hh) {
#pragma unroll
  for (int g = 0; g < 4; ++g) {
    const int pos = key32 + (g >> 1) * 16 + hh * 8 + (g & 1) * 4;
    u32x2 w; w.x = pk2(a[4 * g], a[4 * g + 1]); w.y = pk2(a[4 * g + 2], a[4 * g + 3]);
    *(u32x2*)(vt_row + pos) = w;
  }
}

__device__ __forceinline__ void st_bf16_sw(bf16_t* row, const f32x16& a, int hh, float sc) {
#pragma unroll
  for (int g = 0; g < 4; ++g) { u32x2 w; w.x = pk2(a[4 * g] * sc, a[4 * g + 1] * sc); w.y = pk2(a[4 * g + 2] * sc, a[4 * g + 3] * sc); *(u32x2*)(row + 8 * g + 4 * hh) = w; }
}
__device__ __forceinline__ void st_f32_sw(float* row, const f32x16& a, int hh) {
#pragma unroll
  for (int g = 0; g < 4; ++g) { f32x4 w = {a[4 * g], a[4 * g + 1], a[4 * g + 2], a[4 * g + 3]}; *(f32x4*)(row + 8 * g + 4 * hh) = w; }
}

__device__ void phase_prep(const Params& p) {
  const int gtid = blockIdx.x * 256 + threadIdx.x, gthreads = gridDim.x * 256;
  const int gw = gtid >> 6, nw = gthreads >> 6, lane = threadIdx.x & 63;
  char* ws = p.ws;
  {
    bf16_t* dst = (bf16_t*)(ws + W_WIN); const float* src = p.in[8];
    for (int u = gtid; u < NIN * 128; u += gthreads) {
      const int n = u % NIN, k0 = (u / NIN) * 8;
      int col = n; bool valid = true;
      if (n >= 3584) col = n - 96; else if (n >= 3488) valid = false;
      float v[8];
#pragma unroll
      for (int j = 0; j < 8; ++j) v[j] = valid ? src[(size_t)(k0 + j) * 5536 + col] : 0.f;
      u32x4 w; w.x = pk2(v[0], v[1]); w.y = pk2(v[2], v[3]); w.z = pk2(v[4], v[5]); w.w = pk2(v[6], v[7]);
      *(u32x4*)(dst + (size_t)n * LDH + k0) = w;
    }
  }
  {
    bf16_t* dst = (bf16_t*)(ws + W_WUQ); const float* src = p.in[12];
    for (int u = gtid; u < 1536 * 32; u += gthreads) {
      const int n = u % 1536, k0 = (u / 1536) * 8;
      int col = (n < 1024) ? ((n >> 6) * 96 + (n & 63)) : (((n - 1024) >> 5) * 96 + 64 + ((n - 1024) & 31));
      float v[8];
#pragma unroll
      for (int j = 0; j < 8; ++j) v[j] = src[(size_t)(k0 + j) * 1536 + col];
      u32x4 w; w.x = pk2(v[0], v[1]); w.y = pk2(v[2], v[3]); w.z = pk2(v[4], v[5]); w.w = pk2(v[6], v[7]);
      *(u32x4*)(dst + (size_t)n * LDQ + k0) = w;
    }
  }
  {
    bf16_t* dst = (bf16_t*)(ws + W_WUKV);
    for (int u = gtid; u < 2048 * 16; u += gthreads) {
      const int n = u % 2048, k0 = (u / 2048) * 8;
      const float* src = (n < 1024) ? p.in[14] : p.in[15]; const int col = n & 1023;
      float v[8];
#pragma unroll
      for (int j = 0; j < 8; ++j) v[j] = src[(size_t)(k0 + j) * 1024 + col];
      u32x4 w; w.x = pk2(v[0], v[1]); w.y = pk2(v[2], v[3]); w.z = pk2(v[4], v[5]); w.w = pk2(v[6], v[7]);
      *(u32x4*)(dst + (size_t)n * LDK + k0) = w;
    }
  }
  {
    for (int u = gtid; u < 4 * 1024 * 128; u += gthreads) {
      const int which = u >> 17, uu = u & 131071;
      const int n = uu & 1023, k0 = (uu >> 10) * 8;
      const float* src = which == 0 ? p.in[16] : which == 1 ? p.in[17] : which == 2 ? p.in[18] : p.in[20];
      bf16_t* dst = (bf16_t*)(ws + (which == 0 ? W_WA : which == 1 ? W_WB : which == 2 ? W_WO : W_WQ));
      float v[8];
#pragma unroll
      for (int j = 0; j < 8; ++j) v[j] = src[(size_t)(k0 + j) * 1024 + n];
      u32x4 w; w.x = pk2(v[0], v[1]); w.y = pk2(v[2], v[3]); w.z = pk2(v[4], v[5]); w.w = pk2(v[6], v[7]);
      *(u32x4*)(dst + (size_t)n * LDH + k0) = w;
    }
  }
  {
    bf16_t* dst = (bf16_t*)(ws + W_KEYS); const float* src = p.in[21];
    for (int u = gtid; u < 16 * 128 * 64 / 4; u += gthreads) {
      f32x4 v = *(const f32x4*)(src + (size_t)u * 4);
      u32x2 w; w.x = pk2(v[0], v[1]); w.y = pk2(v[2], v[3]);
      *(u32x2*)(dst + (size_t)u * 4) = w;
    }
  }
  {
    bf16_t* hb = (bf16_t*)(ws + W_B); const float* g = p.in[7];
    for (int t = gw; t < T; t += nw) {
      const float* x = (t < TP) ? p.in[0] + (size_t)t * DM : p.in[1] + (size_t)(t - TP) * DM;
      f32x4 v[4]; float ss = 0.f;
#pragma unroll
      for (int i = 0; i < 4; ++i) { v[i] = *(const f32x4*)(x + i * 256 + lane * 4); ss += v[i][0] * v[i][0] + v[i][1] * v[i][1] + v[i][2] * v[i][2] + v[i][3] * v[i][3]; }
      ss = wave_sum(ss);
      const float rs = rsqrtf(ss * (1.f / DM) + EPS);
#pragma unroll
      for (int i = 0; i < 4; ++i) {
        f32x4 gg = *(const f32x4*)(g + i * 256 + lane * 4);
        u32x2 w; w.x = pk2(v[i][0] * rs * gg[0], v[i][1] * rs * gg[1]); w.y = pk2(v[i][2] * rs * gg[2], v[i][3] * rs * gg[3]);
        *(u32x2*)(hb + (size_t)t * LDH + i * 256 + lane * 4) = w;
      }
    }
  }
  {
    bf16_t* dk = (bf16_t*)(ws + W_D); const float* src = p.in[2];
    for (int u = gtid; u < 8 * PAST * 256; u += gthreads) {
      const int e = u * 4; const int row = e >> 10, c = e & 1023; const int b = row >> 11, j = row & 2047;
      f32x4 v = *(const f32x4*)(src + (size_t)e);
      u32x2 w; w.x = pk2(v[0], v[1]); w.y = pk2(v[2], v[3]);
      *(u32x2*)(dk + (size_t)(TP + b * LKS + j) * LDH + c) = w;
    }
    bf16_t* ck = (bf16_t*)(ws + W_G); const float* s2 = p.in[4];
    for (int u = gtid; u < 8 * PAST * 32; u += gthreads) {
      const int e = u * 4; const int row = e >> 7, c = e & 127; const int b = row >> 11, j = row & 2047;
      f32x4 v = *(const f32x4*)(s2 + (size_t)e);
      u32x2 w; w.x = pk2(v[0], v[1]); w.y = pk2(v[2], v[3]);
      *(u32x2*)(ck + (size_t)(TP + b * LKS + j) * LDK + c) = w;
    }
    bf16_t* kp = (bf16_t*)(ws + W_KPE); const float* s3 = p.in[5];
    for (int u = gtid; u < 8 * PAST * 8; u += gthreads) {
      const int e = u * 4; const int row = e >> 5, c = e & 31; const int b = row >> 11, j = row & 2047;
      f32x4 v = *(const f32x4*)(s3 + (size_t)e);
      u32x2 w; w.x = pk2(v[0], v[1]); w.y = pk2(v[2], v[3]);
      *(u32x2*)(kp + (size_t)(TP + b * LKS + j) * 32 + c) = w;
    }
  }
  {
    bf16_t* vt = (bf16_t*)(ws + W_D2 + SZ_VTP); const float* src = p.in[3];
    for (int u = gtid; u < 8 * 256 * 1024; u += gthreads) {
      const int c = u & 1023, pg = (u >> 10) & 255, b = u >> 18;
      const int p0 = pg * 8;
      float v[8];
#pragma unroll
      for (int i = 0; i < 8; ++i) { const int key = kperm(p0 + i); v[i] = src[((size_t)(b * PAST + key)) * 1024 + c]; }
      u32x4 w; w.x = pk2(v[0], v[1]); w.y = pk2(v[2], v[3]); w.z = pk2(v[4], v[5]); w.w = pk2(v[6], v[7]);
      *(u32x4*)(vt + ((size_t)(b * 1024 + c)) * LKS + p0) = w;
    }
  }
  {
    float2* rt = (float2*)(ws + W_ROPE);
    for (int u = gtid; u < 4096 * 16; u += gthreads) {
      const int pos = u >> 4, i = u & 15;
      const float inv = powf(10000.0f, -(float)i / 16.0f);
      const float ang = (float)pos * inv;
      rt[u] = make_float2(cosf(ang), sinf(ang));
    }
    float* misc = (float*)(ws + W_MISC);
    if (gw == 0) {
      const float* lp = p.in[9];
      float a = lp[lane] * lp[64 + lane], b = lp[128 + lane] * lp[192 + lane];
      a = wave_sum(a); b = wave_sum(b);
      if (lane == 0) misc[0] = expf(a) - expf(b) + 0.2f;
    }
    for (int u = gtid; u < 8 * 192; u += gthreads) {
      const int h = u / 192, idx = u % 192; const int rel = idx - 128;
      const int n = rel < 0 ? -rel : rel;
      int bucket = rel > 0 ? 16 : 0;
      if (n < 8) bucket += n;
      else { int lg = 8 + (n >= 12) + (n >= 16) + (n >= 23) + (n >= 32) + (n >= 46) + (n >= 64) + (n >= 91); bucket += lg > 15 ? 15 : lg; }
      misc[64 + u] = (p.in[6][bucket * 8 + h] - p.in[6][15 * 8 + h]) * LOG2E;
    }
  }
}

__device__ void phase_inproj(const Params& p, char* lds) {
  char* ws = p.ws;
  const bf16_t* hb = (const bf16_t*)(ws + W_B); const bf16_t* wt = (const bf16_t*)(ws + W_WIN);
  const int lane = threadIdx.x & 63, wid = threadIdx.x >> 6, wr = wid >> 1, wc = wid & 1, hh = lane >> 5, l31 = lane & 31;
  for (int it = 0;; ++it) {
    int mt, nt; if (!tile_at(260, 44, it, mt, nt)) break;
    const int m0 = mt * 128, n0 = nt * 128;
    f32x16 acc[2][2]; zero_acc(acc);
    const bool samp = (m0 >= TP);
    if (nt >= 16 && nt < 24) {
      gemm_mainloop<false>(hb + (size_t)m0 * LDH, LDH, wt + (size_t)n0 * LDH, LDH, DM, acc, lds, 2 * ((mt + nt) & 7));
#pragma unroll
      for (int i = 0; i < 2; ++i)
#pragma unroll
        for (int j = 0; j < 2; ++j) {
          const int mb = m0 + wr * 64 + i * 32; const int nn = n0 - 2048 + wc * 64 + j * 32 + l31;
          float* o = (samp ? p.out + O_VS + (size_t)(mb - TP) * 1024 : p.out + O_VP + (size_t)mb * 1024) + nn;
#pragma unroll
          for (int r = 0; r < 16; ++r) o[(size_t)accrow(r, hh) * 1024] = acc[i][j][r];
          bf16_t* vt; int key32;
          if (!samp) { const int b = mb >> 12; vt = (bf16_t*)(ws + W_D2) + ((size_t)(b * 1024 + nn)) * SEQP; key32 = mb & 4095; }
          else { const int ts = mb - TP; const int b = ts >> 6; vt = (bf16_t*)(ws + W_D2 + SZ_VTP) + ((size_t)(b * 1024 + nn)) * LKS; key32 = PAST + (ts & 63); }
          vt_store(vt, key32, acc[i][j], hh);
        }
      continue;
    }
    gemm_mainloop<true>(hb + (size_t)m0 * LDH, LDH, wt + (size_t)n0 * LDH, LDH, DM, acc, lds, 2 * ((mt + nt) & 7));
#pragma unroll
    for (int i = 0; i < 2; ++i)
#pragma unroll
      for (int j = 0; j < 2; ++j) {
        const int tok = m0 + wr * 64 + i * 32 + l31; const int cb = n0 + wc * 64 + j * 32;
        if (nt < 8) {
          st_bf16_sw((bf16_t*)(ws + W_C) + (size_t)tok * LDH + cb, acc[i][j], hh, 0.125f * LOG2E);
        } else if (nt < 16) {
          st_f32_sw((samp ? p.out + O_KS + (size_t)(tok - TP) * 1024 : p.out + O_KP + (size_t)tok * 1024) + (cb - 1024), acc[i][j], hh);
          st_bf16_sw((bf16_t*)(ws + W_D) + (size_t)keyrow_of_token(tok) * LDH + (cb - 1024), acc[i][j], hh, 1.f);
        } else if (nt < 26) {
          st_f32_sw((float*)(ws + F_ZCQ) + (size_t)tok * 256 + (cb - 3072), acc[i][j], hh);
        } else if (nt == 26) {
          st_f32_sw((float*)(ws + F_ZCKV) + (size_t)tok * 128 + (cb - 3328), acc[i][j], hh);
        } else if (nt == 27) {
          if (cb == 3456) st_f32_sw((float*)(ws + F_ZKR) + (size_t)tok * 32, acc[i][j], hh);
        } else {
          f32x16 sg;
#pragma unroll
          for (int r = 0; r < 16; ++r) sg[r] = __builtin_amdgcn_rcpf(1.f + __expf(-acc[i][j][r]));
          st_bf16_sw((bf16_t*)(p.out + O_Y) + (size_t)tok * 2048 + (cb - 3584), sg, hh, 1.f);
        }
      }
  }
}

__device__ void phase_small(const Params& p) {
  char* ws = p.ws;
  const int gw = (blockIdx.x * 256 + threadIdx.x) >> 6, nw = (gridDim.x * 256) >> 6, lane = threadIdx.x & 63;
  const float* zcq = (const float*)(ws + F_ZCQ); const float* zckv = (const float*)(ws + F_ZCKV); const float* zkr = (const float*)(ws + F_ZKR);
  bf16_t* cq = (bf16_t*)(ws + F_CQ); bf16_t* ckva = (bf16_t*)(ws + W_G); bf16_t* kpea = (bf16_t*)(ws + W_KPE);
  const float2* rt = (const float2*)(ws + W_ROPE);
  for (int t = gw; t < T; t += nw) {
    {
      f32x4 v = *(const f32x4*)(zcq + (size_t)t * 256 + lane * 4);
      float ss = wave_sum(v[0] * v[0] + v[1] * v[1] + v[2] * v[2] + v[3] * v[3]);
      const float rs = rsqrtf(ss * (1.f / 256.f) + EPS);
      f32x4 g = *(const f32x4*)(p.in[11] + lane * 4);
      u32x2 w; w.x = pk2(v[0] * rs * g[0], v[1] * rs * g[1]); w.y = pk2(v[2] * rs * g[2], v[3] * rs * g[3]);
      *(u32x2*)(cq + (size_t)t * LDQ + lane * 4) = w;
    }
    const int kr = keyrow_of_token(t);
    {
      float2 v = *(const float2*)(zckv + (size_t)t * 128 + lane * 2);
      float ss = wave_sum(v.x * v.x + v.y * v.y);
      const float rs = rsqrtf(ss * (1.f / 128.f) + EPS);
      float2 g = *(const float2*)(p.in[13] + lane * 2);
      const float a = v.x * rs * g.x, b = v.y * rs * g.y;
      float* o = (t < TP) ? p.out + O_CP + (size_t)t * 128 : p.out + O_CS + (size_t)(t - TP) * 128;
      *(float2*)(o + lane * 2) = make_float2(a, b);
      *(unsigned*)(ckva + (size_t)kr * LDK + lane * 2) = pk2(a, b);
    }
    {
      const int pos = (t < TP) ? (t & 4095) : (PAST + ((t - TP) & 63));
      const int i = lane & 15;
      const float x1 = zkr[(size_t)t * 32 + i], x2 = zkr[(size_t)t * 32 + 16 + i];
      const float2 cs = rt[pos * 16 + i];
      const float r = (lane < 16) ? (x1 * cs.x - x2 * cs.y) : (x1 * cs.y + x2 * cs.x);
      if (lane < 32) {
        float* o = (t < TP) ? p.out + O_EP + (size_t)t * 32 : p.out + O_ES + (size_t)(t - TP) * 32;
        o[lane] = r; kpea[(size_t)kr * 32 + lane] = f2bf(r);
      }
    }
  }
}

template <int MODE>
__device__ void attn_item(const Params& p, char* lds, int grp  , int b, int h, int qblk, int dry) {
  constexpr int DQ = MODE == 0 ? 64 : 96;
  constexpr int KROW = MODE == 0 ? 128 : 96;
  constexpr int KSTR = MODE == 0 ? 272 : 208;
  constexpr int DV = MODE == 0 ? 128 : 64;
  constexpr int NH = MODE == 0 ? 8 : 16;
  constexpr int KBYTES = 64 * KSTR;
  constexpr int BUF = KBYTES + DV * 144;
  constexpr int KCH = KROW / 8;
  constexpr int NKC = 64 * KCH / 256;
  constexpr int NVC = DV * 8 / 256;
  char* ws = p.ws;
  const int tid = threadIdx.x, lane = tid & 63, wid = tid >> 6, hh = lane >> 5, l31 = lane & 31;
  const int qsub = MODE == 0 ? (wid >> 1) : wid;
  const int comp = MODE == 0 ? (wid & 1) : 0;
  const int QB = MODE == 0 ? 64 : 128;
  const int Lk = grp == 0 ? SEQP : LKS;
  const int tok0 = grp == 0 ? (b * SEQ + qblk * QB) : (TP + b * 64);
  const int qpos0 = grp == 0 ? qblk * QB : PAST;
  const int krow0 = grp == 0 ? b * SEQ : TP + b * LKS;
  int nkt;
  if (grp == 0) nkt = MODE == 0 ? (qblk + 1) : (2 * qblk + 2); else nkt = 33;
  int my_last = nkt - 1; bool active = true;
  if (MODE == 1) { if (grp == 0) my_last = 2 * qblk + (wid >> 1); else active = (wid < 2); }
  const int qtok = tok0 + qsub * 32 + l31;
  const int qpos = qpos0 + qsub * 32 + l31;

  bf16x8 qf[DQ / 16];
  if (MODE == 0) {
    const bf16_t* q = (const bf16_t*)(ws + W_C) + (size_t)qtok * LDH + h * 128 + comp * 64 + hh * 8;
#pragma unroll
    for (int ks = 0; ks < 4; ++ks) qf[ks] = *(const bf16x8*)(q + ks * 16);
  } else {
    const int qt = active ? qtok : tok0;
    const bf16_t* q = (const bf16_t*)(ws + W_B) + (size_t)qt * LDH + h * 64 + hh * 8;
#pragma unroll
    for (int ks = 0; ks < 4; ++ks) qf[ks] = *(const bf16x8*)(q + ks * 16);
    const bf16_t* qp = (const bf16_t*)(ws + F_ZCQ) + (size_t)qt * 512 + h * 32 + hh * 8;
    bf16x8 a = *(const bf16x8*)(qp), c = *(const bf16x8*)(qp + 16);
    const float2* rt = (const float2*)(ws + W_ROPE) + (size_t)(active ? qpos : qpos0) * 16 + hh * 8;
    float o1[8], o2[8];
#pragma unroll
    for (int j = 0; j < 8; ++j) {
      const float x1 = bf2f((bf16_t)a[j]), x2 = bf2f((bf16_t)c[j]); const float2 cs = rt[j];
      o1[j] = x1 * cs.x - x2 * cs.y; o2[j] = x1 * cs.y + x2 * cs.x;
    }
    u32x4 w1, w2;
    w1.x = pk2(o1[0], o1[1]); w1.y = pk2(o1[2], o1[3]); w1.z = pk2(o1[4], o1[5]); w1.w = pk2(o1[6], o1[7]);
    w2.x = pk2(o2[0], o2[1]); w2.y = pk2(o2[2], o2[3]); w2.z = pk2(o2[4], o2[5]); w2.w = pk2(o2[6], o2[7]);
    qf[4] = __builtin_bit_cast(bf16x8, w1); qf[5] = __builtin_bit_cast(bf16x8, w2);
  }

  const bf16_t* kg; const bf16_t* kpe; const bf16_t* vg;
  if (MODE == 0) {
    kg = (const bf16_t*)(ws + W_D) + (size_t)krow0 * LDH + h * 128;
    kpe = nullptr;
    vg = grp == 0 ? (const bf16_t*)(ws + W_D2) + (size_t)(b * 1024 + h * 128) * SEQP : (const bf16_t*)(ws + W_D2 + SZ_VTP) + (size_t)(b * 1024 + h * 128) * LKS;
  } else {
    kg = (const bf16_t*)(ws + W_D) + (size_t)krow0 * LDH + h * 64;
    kpe = (const bf16_t*)(ws + W_KPE) + (size_t)krow0 * 32;
    vg = grp == 0 ? (const bf16_t*)(ws + W_D2) + (size_t)(b * 1024 + h * 64) * SEQP : (const bf16_t*)(ws + W_D2 + SZ_VTP) + (size_t)(b * 1024 + h * 64) * LKS;
  }
  u32x4 rk[NKC], rv[NVC];
  int koff[NKC], voff[NVC];
#pragma unroll
  for (int i = 0; i < NKC; ++i) { const int q = tid + 256 * i; koff[i] = (q / KCH) * LDH + (q % KCH) * 8; }
#pragma unroll
  for (int i = 0; i < NVC; ++i) { const int q = tid + 256 * i; voff[i] = (q >> 3) * Lk + (q & 7) * 8; }
  auto gloadK = [&](int kt) {
    const bf16_t* ktile = kg + (size_t)kt * 64 * LDH;
#pragma unroll
    for (int i = 0; i < NKC; ++i) {
      if (MODE == 0) rk[i] = *(const u32x4*)(ktile + koff[i]);
      else {
        const int q = tid + 256 * i; const int row = q / KCH, ch = q % KCH;
        const bf16_t* src = (ch < 8) ? kg + (size_t)(kt * 64 + row) * LDH + ch * 8 : kpe + (size_t)(kt * 64 + row) * 32 + (ch - 8) * 8;
        rk[i] = *(const u32x4*)src;
      }
    }
  };
  auto gloadV = [&](int kt) {
    const bf16_t* vtile = vg + kt * 64;
#pragma unroll
    for (int i = 0; i < NVC; ++i) rv[i] = *(const u32x4*)(vtile + voff[i]);
  };
  auto lwriteK = [&](int buf) {
    char* base = lds + buf * BUF;
#pragma unroll
    for (int i = 0; i < NKC; ++i) { const int q = tid + 256 * i; const int row = q / KCH, ch = q % KCH; *(u32x4*)(base + row * KSTR + ch * 16) = rk[i]; }
  };
  auto lwriteV = [&](int buf) {
    char* base = lds + buf * BUF;
#pragma unroll
    for (int i = 0; i < NVC; ++i) { const int q = tid + 256 * i; const int row = q >> 3, ch = q & 7; *(u32x4*)(base + KBYTES + row * 144 + ch * 16) = rv[i]; }
  };

  f32x16 O[DV / 32];
#pragma unroll
  for (int i = 0; i < DV / 32; ++i)
#pragma unroll
    for (int r = 0; r < 16; ++r) O[i][r] = 0.f;
  float m = -1e30f, l = 0.f;
  const float* btab = (const float*)(ws + W_MISC) + 64 + h * 192;
  __shared__ float s_bt[192];
  if (MODE == 0 && tid < 192) s_bt[tid] = btab[tid];

  gloadK(0); gloadV(0); lwriteK(0); lwriteV(0);
  __syncthreads();
  for (int kt = 0; kt < nkt; ++kt) {
    const bool more = (kt + 1 < nkt);
    if (more) { gloadK(kt + 1); if (MODE == 1) gloadV(kt + 1); }
    if (active && kt <= my_last) {
      const char* base = lds + (kt & 1) * BUF;
      f32x16 S[2];
      const char* kp0 = base + l31 * KSTR + comp * 128 + hh * 16;
#pragma unroll
      for (int sub = 0; sub < 2; ++sub) {
#pragma unroll
        for (int r = 0; r < 16; ++r) S[sub][r] = 0.f;
#pragma unroll
        for (int ks = 0; ks < DQ / 16; ++ks) {
          bf16x8 kf = *(const bf16x8*)(kp0 + sub * 32 * KSTR + ks * 32);
          S[sub] = mfma32(kf, qf[ks], S[sub]);
        }
      }
      if (MODE == 0) {
        const int kpos0 = kt * 64;
        if (kpos0 + 63 > qpos0 - 91) {
#pragma unroll
          for (int sub = 0; sub < 2; ++sub)
#pragma unroll
            for (int r = 0; r < 16; ++r) {
              int rel = kpos0 + sub * 32 + accrow(r, hh) - qpos; rel = rel < -128 ? -128 : rel;
              S[sub][r] += s_bt[rel + 128];
            }
        }
      }
      __builtin_amdgcn_sched_barrier(0);
      float mx = S[0][0];
#pragma unroll
      for (int sub = 0; sub < 2; ++sub)
#pragma unroll
        for (int r = 0; r < 16; ++r) mx = fmaxf(mx, S[sub][r]);
      mx = fmaxf(mx, __shfl_xor(mx, 32));
      if (__any(mx > m + 8.0f)) {
        const float mn = fmaxf(m, mx);
        const float alpha = __builtin_amdgcn_exp2f(m - mn);
        m = mn; l *= alpha;
#pragma unroll
        for (int i = 0; i < DV / 32; ++i)
#pragma unroll
          for (int r = 0; r < 16; ++r) O[i][r] *= alpha;
      }
      f32v2_t ps2 = {0.f, 0.f}; const f32v2_t m2 = {m, m};
#pragma unroll
      for (int sub = 0; sub < 2; ++sub)
#pragma unroll
        for (int r = 0; r < 16; r += 2) {
          f32v2_t v = (f32v2_t){S[sub][r], S[sub][r + 1]} - m2;
          v[0] = __builtin_amdgcn_exp2f(v[0]); v[1] = __builtin_amdgcn_exp2f(v[1]);
          S[sub][r] = v[0]; S[sub][r + 1] = v[1]; ps2 += v;
        }
      l += ps2[0] + ps2[1];
      if (MODE == 0 && more) { lwriteK((kt + 1) & 1); gloadV(kt + 1); }
      const char* vp0 = base + KBYTES + l31 * 144 + hh * 16;
#pragma unroll
      for (int sub = 0; sub < 2; ++sub)
#pragma unroll
        for (int s = 0; s < 2; ++s) {
          u32x4 w;
          w.x = pk2(S[sub][8 * s + 0], S[sub][8 * s + 1]); w.y = pk2(S[sub][8 * s + 2], S[sub][8 * s + 3]);
          w.z = pk2(S[sub][8 * s + 4], S[sub][8 * s + 5]); w.w = pk2(S[sub][8 * s + 6], S[sub][8 * s + 7]);
          const bf16x8 pf = __builtin_bit_cast(bf16x8, w);
          __builtin_amdgcn_sched_barrier(0);
#pragma unroll
          for (int blk = 0; blk < DV / 32; ++blk) {
            bf16x8 vf = *(const bf16x8*)(vp0 + blk * 32 * 144 + sub * 64 + s * 32);
            O[blk] = mfma32(vf, pf, O[blk]);
          }
        }
    }
    if (more) { if (MODE == 1) lwriteK((kt + 1) & 1); lwriteV((kt + 1) & 1); }
    __syncthreads();
  }
  const float lt = l + __shfl_xor(l, 32);
  const float inv = 1.f / lt;
  if (MODE == 0) {
    float* xch = (float*)lds;
    const float lam = ((const float*)(ws + W_MISC))[0];
    if (comp == 1) {
#pragma unroll
      for (int blk = 0; blk < 4; ++blk)
#pragma unroll
        for (int r = 0; r < 16; ++r) xch[(qsub * 32 + l31) * 132 + blk * 32 + accrow(r, hh)] = O[blk][r] * inv * lam;
    }
    __syncthreads();
    if (comp == 0 && !dry) {
      float ss = 0.f;
#pragma unroll
      for (int blk = 0; blk < 4; ++blk)
#pragma unroll
        for (int r = 0; r < 16; ++r) { const float v = O[blk][r] * inv - xch[(qsub * 32 + l31) * 132 + blk * 32 + accrow(r, hh)]; O[blk][r] = v; ss += v * v; }
      ss += __shfl_xor(ss, 32);
      const float rs = rsqrtf(ss * (1.f / 128.f) + EPS) * 0.8f;
      bf16_t* o = (bf16_t*)(ws + W_C) + (size_t)qtok * LDH + h * 128;
      const float* sg = p.in[10];
#pragma unroll
      for (int blk = 0; blk < 4; ++blk)
#pragma unroll
        for (int g = 0; g < 4; ++g) {
          const int dv = blk * 32 + 8 * g + 4 * hh;
          f32x4 gg = *(const f32x4*)(sg + dv);
          u32x2 w; w.x = pk2(O[blk][4 * g] * rs * gg[0], O[blk][4 * g + 1] * rs * gg[1]); w.y = pk2(O[blk][4 * g + 2] * rs * gg[2], O[blk][4 * g + 3] * rs * gg[3]);
          *(u32x2*)(o + dv) = w;
        }
    }
    __syncthreads();
  } else {
    if (active && !dry) {
      bf16_t* o = (bf16_t*)(ws + W_B) + (size_t)qtok * LDH + h * 64;
#pragma unroll
      for (int blk = 0; blk < 2; ++blk)
#pragma unroll
        for (int g = 0; g < 4; ++g) {
          const int dv = blk * 32 + 8 * g + 4 * hh;
          u32x2 w; w.x = pk2(O[blk][4 * g] * inv, O[blk][4 * g + 1] * inv); w.y = pk2(O[blk][4 * g + 2] * inv, O[blk][4 * g + 3] * inv);
          *(u32x2*)(o + dv) = w;
        }
    }
  }
}

__device__ void attn_item_mla(const Params& p, char* lds, int grp, int b, int h, int qblk, int dry) {
  constexpr int KSTR = 208, KBYTES = 64 * KSTR, BUF = KBYTES + 64 * 144;
  char* ws = p.ws;
  int tid = threadIdx.x; asm volatile("" : "+v"(tid));
  const int lane = tid & 63, wid = tid >> 6, hh = lane >> 5, l31 = lane & 31;
  const int Lk = grp == 0 ? SEQP : LKS;
  const int tok0 = grp == 0 ? (b * SEQ + qblk * 256) : (TP + b * 64);
  const int qpos0 = grp == 0 ? qblk * 256 : PAST;
  const int krow0 = grp == 0 ? b * SEQ : TP + b * LKS;
  const int nkt = grp == 0 ? (4 * qblk + 4) : 33;
  const int my_last = grp == 0 ? (4 * qblk + wid) : 32;
  const bool active = grp == 0 ? true : (wid == 0);
  bf16x8 qf[2][6];
#pragma unroll
  for (int qs = 0; qs < 2; ++qs) {
    const int qt = active ? tok0 + wid * 64 + qs * 32 + l31 : tok0;
    const int qp = active ? qpos0 + wid * 64 + qs * 32 + l31 : qpos0;
    const bf16_t* q = (const bf16_t*)(ws + W_B) + (size_t)qt * LDH + h * 64 + hh * 8;
#pragma unroll
    for (int ks = 0; ks < 4; ++ks) qf[qs][ks] = *(const bf16x8*)(q + ks * 16);
    const bf16_t* qpe = (const bf16_t*)(ws + F_ZCQ) + (size_t)qt * 512 + h * 32 + hh * 8;
    const bf16x8 a = *(const bf16x8*)(qpe), c = *(const bf16x8*)(qpe + 16);
    const float2* rt = (const float2*)(ws + W_ROPE) + (size_t)qp * 16 + hh * 8;
    float o1[8], o2[8];
#pragma unroll
    for (int j = 0; j < 8; ++j) {
      const float x1 = bf2f((bf16_t)a[j]), x2 = bf2f((bf16_t)c[j]); const float2 cs = rt[j];
      o1[j] = x1 * cs.x - x2 * cs.y; o2[j] = x1 * cs.y + x2 * cs.x;
    }
    u32x4 w1, w2;
    w1.x = pk2(o1[0], o1[1]); w1.y = pk2(o1[2], o1[3]); w1.z = pk2(o1[4], o1[5]); w1.w = pk2(o1[6], o1[7]);
    w2.x = pk2(o2[0], o2[1]); w2.y = pk2(o2[2], o2[3]); w2.z = pk2(o2[4], o2[5]); w2.w = pk2(o2[6], o2[7]);
    qf[qs][4] = __builtin_bit_cast(bf16x8, w1); qf[qs][5] = __builtin_bit_cast(bf16x8, w2);
  }
  const bf16_t* kg = (const bf16_t*)(ws + W_D) + (size_t)krow0 * LDH + h * 64;
  const bf16_t* kpe = (const bf16_t*)(ws + W_KPE) + (size_t)krow0 * 32;
  const bf16_t* vg = grp == 0 ? (const bf16_t*)(ws + W_D2) + (size_t)(b * 1024 + h * 64) * SEQP : (const bf16_t*)(ws + W_D2 + SZ_VTP) + (size_t)(b * 1024 + h * 64) * LKS;
  u32x4 rk[3], rv[2];
  auto gload = [&](int kt) {
#pragma unroll
    for (int i = 0; i < 3; ++i) {
      const int q = tid + 256 * i; const int row = q / 12, ch = q % 12;
      const bf16_t* src = (ch < 8) ? kg + (size_t)(kt * 64 + row) * LDH + ch * 8 : kpe + (size_t)(kt * 64 + row) * 32 + (ch - 8) * 8;
      rk[i] = *(const u32x4*)src;
    }
#pragma unroll
    for (int i = 0; i < 2; ++i) { const int q = tid + 256 * i; const int row = q >> 3, ch = q & 7; rv[i] = *(const u32x4*)(vg + (size_t)row * Lk + kt * 64 + ch * 8); }
  };
  auto lwrite = [&](int buf) {
    char* base = lds + buf * BUF;
#pragma unroll
    for (int i = 0; i < 3; ++i) { const int q = tid + 256 * i; const int row = q / 12, ch = q % 12; *(u32x4*)(base + row * KSTR + ch * 16) = rk[i]; }
#pragma unroll
    for (int i = 0; i < 2; ++i) { const int q = tid + 256 * i; const int row = q >> 3, ch = q & 7; *(u32x4*)(base + KBYTES + row * 144 + ch * 16) = rv[i]; }
  };
  f32x16 O[2][2];
#pragma unroll
  for (int qs = 0; qs < 2; ++qs)
#pragma unroll
    for (int i = 0; i < 2; ++i)
#pragma unroll
      for (int r = 0; r < 16; ++r) O[qs][i][r] = 0.f;
  float m[2] = {-1e30f, -1e30f}, l[2] = {0.f, 0.f};
  gload(0); lwrite(0);
  __syncthreads();
  for (int kt = 0; kt < nkt; ++kt) {
    const bool more = (kt + 1 < nkt);
    if (more) gload(kt + 1);
    if (active && kt <= my_last) {
      const char* base = lds + (kt & 1) * BUF;
      const char* kp0 = base + l31 * KSTR + hh * 16;
      const char* vp0 = base + KBYTES + l31 * 144 + hh * 16;
#pragma unroll 1
      for (int sub = 0; sub < 2; ++sub) {
        f32x16 S[2];
#pragma unroll
        for (int r = 0; r < 16; ++r) { S[0][r] = 0.f; S[1][r] = 0.f; }
#pragma unroll
        for (int ks = 0; ks < 6; ++ks) {
          const bf16x8 kf = *(const bf16x8*)(kp0 + sub * 32 * KSTR + ks * 32);
          S[0] = mfma32(kf, qf[0][ks], S[0]);
          S[1] = mfma32(kf, qf[1][ks], S[1]);
        }
#pragma unroll
        for (int qs = 0; qs < 2; ++qs) {
          float mx = S[qs][0];
#pragma unroll
          for (int r = 1; r < 16; ++r) mx = fmaxf(mx, S[qs][r]);
          mx = fmaxf(mx, __shfl_xor(mx, 32));
          if (__any(mx > m[qs] + 8.0f)) {
            const float mn = fmaxf(m[qs], mx);
            const float alpha = __builtin_amdgcn_exp2f(m[qs] - mn);
            m[qs] = mn; l[qs] *= alpha;
#pragma unroll
            for (int i = 0; i < 2; ++i)
#pragma unroll
              for (int r = 0; r < 16; ++r) O[qs][i][r] *= alpha;
          }
          f32v2_t ps2 = {0.f, 0.f}; const f32v2_t m2 = {m[qs], m[qs]};
#pragma unroll
          for (int r = 0; r < 16; r += 2) {
            f32v2_t v = (f32v2_t){S[qs][r], S[qs][r + 1]} - m2;
            v[0] = __builtin_amdgcn_exp2f(v[0]); v[1] = __builtin_amdgcn_exp2f(v[1]);
            S[qs][r] = v[0]; S[qs][r + 1] = v[1]; ps2 += v;
          }
          l[qs] += ps2[0] + ps2[1];
        }
#pragma unroll
        for (int s2 = 0; s2 < 2; ++s2) {
          u32x4 w0, w1;
          w0.x = pk2(S[0][8 * s2 + 0], S[0][8 * s2 + 1]); w0.y = pk2(S[0][8 * s2 + 2], S[0][8 * s2 + 3]);
          w0.z = pk2(S[0][8 * s2 + 4], S[0][8 * s2 + 5]); w0.w = pk2(S[0][8 * s2 + 6], S[0][8 * s2 + 7]);
          w1.x = pk2(S[1][8 * s2 + 0], S[1][8 * s2 + 1]); w1.y = pk2(S[1][8 * s2 + 2], S[1][8 * s2 + 3]);
          w1.z = pk2(S[1][8 * s2 + 4], S[1][8 * s2 + 5]); w1.w = pk2(S[1][8 * s2 + 6], S[1][8 * s2 + 7]);
          const bf16x8 pf0 = __builtin_bit_cast(bf16x8, w0), pf1 = __builtin_bit_cast(bf16x8, w1);
#pragma unroll
          for (int blk = 0; blk < 2; ++blk) {
            const bf16x8 vf = *(const bf16x8*)(vp0 + blk * 32 * 144 + sub * 64 + s2 * 32);
            O[0][blk] = mfma32(vf, pf0, O[0][blk]);
            O[1][blk] = mfma32(vf, pf1, O[1][blk]);
          }
        }
      }
    }
    if (more) lwrite((kt + 1) & 1);
    __syncthreads();
  }
  if (active && !dry) {
#pragma unroll
    for (int qs = 0; qs < 2; ++qs) {
      const float lt = l[qs] + __shfl_xor(l[qs], 32);
      const float inv = 1.f / lt;
      const int qtok = tok0 + wid * 64 + qs * 32 + l31;
      bf16_t* o = (bf16_t*)(ws + W_B) + (size_t)qtok * LDH + h * 64;
#pragma unroll
      for (int blk = 0; blk < 2; ++blk)
#pragma unroll
        for (int g = 0; g < 4; ++g) {
          const int dv = blk * 32 + 8 * g + 4 * hh;
          u32x2 w; w.x = pk2(O[qs][blk][4 * g] * inv, O[qs][blk][4 * g + 1] * inv); w.y = pk2(O[qs][blk][4 * g + 2] * inv, O[qs][blk][4 * g + 3] * inv);
          *(u32x2*)(o + dv) = w;
        }
    }
  }
}

__device__ void phase_attn_diff(const Params& p, char* lds, int* s_item, int dry) {
  const int x = blockIdx.x & 7;
  const int total = 512 + 8;
  unsigned* q = (unsigned*)(p.ws + W_BAR) + QW + dry * 8 + x;
  for (;;) {
    if (threadIdx.x == 0) *s_item = (int)__hip_atomic_fetch_add(q, 1u, __ATOMIC_RELAXED, __HIP_MEMORY_SCOPE_AGENT);
    __syncthreads();
    const int u = *s_item;
    __syncthreads();
    if (u >= total) break;
    int grp = 0, bh, qblk = 0;
    if (u < 256) { qblk = 63 - (u >> 3); bh = (u & 7) * 8 + x; }
    else if (u < 264) { grp = 1; bh = (u - 256) * 8 + x; }
    else { const int v = u - 8; qblk = 63 - (v >> 3); bh = (v & 7) * 8 + x; }
    attn_item<0>(p, lds, grp, bh >> 3, bh & 7, qblk, dry);
  }
}
__device__ void phase_attn_mla(const Params& p, char* lds, int* s_item, int dry) {
  const int x = blockIdx.x & 7;
  const int total = 256 + 16;
  unsigned* q = (unsigned*)(p.ws + W_BAR) + QW + 16 + dry * 8 + x;
  for (;;) {
    if (threadIdx.x == 0) *s_item = (int)__hip_atomic_fetch_add(q, 1u, __ATOMIC_RELAXED, __HIP_MEMORY_SCOPE_AGENT);
    __syncthreads();
    const int u = *s_item;
    __syncthreads();
    if (u >= total) break;
    int grp = 0, bh, qblk = 0;
    if (u < 128) { qblk = 15 - (u >> 4); bh = (u & 15) * 8 + x; }
    else if (u < 144) { grp = 1; bh = (u - 128) * 8 + x; }
    else { const int v = u - 16; qblk = 15 - (v >> 4); bh = (v & 15) * 8 + x; }
    attn_item_mla(p, lds, grp, bh >> 4, bh & 15, qblk, dry);
  }
}

__device__ void phase_mla_expand(const Params& p, char* lds) {
  char* ws = p.ws;
  const int lane = threadIdx.x & 63, wid = threadIdx.x >> 6, wr = wid >> 1, wc = wid & 1, hh = lane >> 5, l31 = lane & 31;
  for (int it = 0, setB = 0;; ++it) {
    int mt, nt;
    if (!setB) { if (!tile_at(260, 12, it, mt, nt)) { setB = 1; it = -1; continue; } }
    else if (!tile_at(388, 16, it, mt, nt)) break;
    f32x16 acc[2][2]; zero_acc(acc);
    const int m0 = mt * 128, n0 = nt * 128;
    if (!setB) {
      gemm_mainloop<true>((const bf16_t*)(ws + F_CQ) + (size_t)m0 * LDQ, LDQ, (const bf16_t*)(ws + W_WUQ) + (size_t)n0 * LDQ, LDQ, 256, acc, lds, 2 * ((mt + nt) & 7));
      const float sc = 0.10206207261596577f * LOG2E;
#pragma unroll
      for (int i = 0; i < 2; ++i)
#pragma unroll
        for (int j = 0; j < 2; ++j) {
          const int tok = m0 + wr * 64 + i * 32 + l31; const int cb = n0 + wc * 64 + j * 32;
          if (nt < 8) st_bf16_sw((bf16_t*)(ws + W_B) + (size_t)tok * LDH + cb, acc[i][j], hh, sc);
          else st_bf16_sw((bf16_t*)(ws + F_ZCQ) + (size_t)tok * 512 + (cb - 1024), acc[i][j], hh, sc);
        }
    } else if (nt < 8) {
      gemm_mainloop<true>((const bf16_t*)(ws + W_G) + (size_t)m0 * LDK, LDK, (const bf16_t*)(ws + W_WUKV) + (size_t)n0 * LDK, LDK, 128, acc, lds, 2 * ((mt + nt) & 7));
#pragma unroll
      for (int i = 0; i < 2; ++i)
#pragma unroll
        for (int j = 0; j < 2; ++j) {
          const int row = m0 + wr * 64 + i * 32 + l31; const int cb = n0 + wc * 64 + j * 32;
          st_bf16_sw((bf16_t*)(ws + W_D) + (size_t)row * LDH + cb, acc[i][j], hh, 1.f);
        }
    } else {
      gemm_mainloop<false>((const bf16_t*)(ws + W_G) + (size_t)m0 * LDK, LDK, (const bf16_t*)(ws + W_WUKV) + (size_t)n0 * LDK, LDK, 128, acc, lds, 2 * ((mt + nt) & 7));
#pragma unroll
      for (int i = 0; i < 2; ++i)
#pragma unroll
        for (int j = 0; j < 2; ++j) {
          const int mb = m0 + wr * 64 + i * 32; const int nn = n0 - 1024 + wc * 64 + j * 32 + l31;
          bf16_t* vt; int key32;
          if (mb < TP) { const int b = mb >> 12; vt = (bf16_t*)(ws + W_D2) + ((size_t)(b * 1024 + nn)) * SEQP; key32 = mb & 4095; }
          else { const int x = mb - TP; const int b = x / LKS; vt = (bf16_t*)(ws + W_D2 + SZ_VTP) + ((size_t)(b * 1024 + nn)) * LKS; key32 = x - b * LKS; }
          vt_store(vt, key32, acc[i][j], hh);
        }
    }
  }
}

__device__ void phase_merge(const Params& p, char* lds) {
  char* ws = p.ws;
  const int lane = threadIdx.x & 63, wid = threadIdx.x >> 6, wr = wid >> 1, wc = wid & 1, hh = lane >> 5, l31 = lane & 31;
  const bf16_t* gates = (const bf16_t*)(p.out + O_Y);
  bf16_t* mg = (bf16_t*)(ws + W_F);
  for (int it = 0;; ++it) {
    int mt, nt; if (!tile_at(260, 8, it, mt, nt)) break;
    const int m0 = mt * 128, n0 = nt * 128;
    {
      f32x16 acc[2][2]; zero_acc(acc);
      gemm_mainloop<true>((const bf16_t*)(ws + W_C) + (size_t)m0 * LDH, LDH, (const bf16_t*)(ws + W_WA) + (size_t)n0 * LDH, LDH, 1024, acc, lds, 2 * ((mt + nt) & 7));
#pragma unroll
      for (int i = 0; i < 2; ++i)
#pragma unroll
        for (int j = 0; j < 2; ++j) {
          const int tok = m0 + wr * 64 + i * 32 + l31; const int cb = n0 + wc * 64 + j * 32;
          const bf16_t* gp = gates + (size_t)tok * 2048 + cb + 4 * hh;
          bf16_t* op = mg + (size_t)tok * LDH + cb + 4 * hh;
#pragma unroll
          for (int g = 0; g < 4; ++g) {
            const u32x2 gv = *(const u32x2*)(gp + 8 * g);
            u32x2 w;
            w.x = pk2(acc[i][j][4 * g] * bflo(gv.x), acc[i][j][4 * g + 1] * bfhi(gv.x));
            w.y = pk2(acc[i][j][4 * g + 2] * bflo(gv.y), acc[i][j][4 * g + 3] * bfhi(gv.y));
            *(u32x2*)(op + 8 * g) = w;
          }
        }
    }
    {
      f32x16 acc[2][2]; zero_acc(acc);
      gemm_mainloop<true>((const bf16_t*)(ws + W_B) + (size_t)m0 * LDH, LDH, (const bf16_t*)(ws + W_WB) + (size_t)n0 * LDH, LDH, 1024, acc, lds, 2 * ((mt + nt) & 7));
      int l31b = l31; asm volatile("" : "+v"(l31b));
#pragma unroll
      for (int i = 0; i < 2; ++i)
#pragma unroll
        for (int j = 0; j < 2; ++j) {
          const int tok = m0 + wr * 64 + i * 32 + l31b; const int cb = n0 + wc * 64 + j * 32;
          const bf16_t* gp = gates + (size_t)tok * 2048 + 1024 + cb + 4 * hh;
          bf16_t* op = mg + (size_t)tok * LDH + cb + 4 * hh;
#pragma unroll
          for (int g = 0; g < 4; ++g) {
            const u32x2 gv = *(const u32x2*)(gp + 8 * g);
            const u32x2 pv = *(const u32x2*)(op + 8 * g);
            u32x2 w;
            w.x = pk2(bflo(pv.x) + acc[i][j][4 * g] * bflo(gv.x), bfhi(pv.x) + acc[i][j][4 * g + 1] * bfhi(gv.x));
            w.y = pk2(bflo(pv.y) + acc[i][j][4 * g + 2] * bflo(gv.y), bfhi(pv.y) + acc[i][j][4 * g + 3] * bfhi(gv.y));
            *(u32x2*)(op + 8 * g) = w;
          }
        }
    }
  }
}

__device__ void phase_outproj(const Params& p, char* lds) {
  char* ws = p.ws;
  const int lane = threadIdx.x & 63, wid = threadIdx.x >> 6, wr = wid >> 1, wc = wid & 1, hh = lane >> 5, l31 = lane & 31;
  float* x1 = (float*)(ws + D_X1);
  for (int it = 0;; ++it) {
    int mt, nt; if (!tile_at(260, 8, it, mt, nt)) break;
    const int m0 = mt * 128, n0 = nt * 128;
    f32x16 acc[2][2]; zero_acc(acc);
    gemm_mainloop<true>((const bf16_t*)(ws + W_F) + (size_t)m0 * LDH, LDH, (const bf16_t*)(ws + W_WO) + (size_t)n0 * LDH, LDH, 1024, acc, lds, 2 * ((mt + nt) & 7));
#pragma unroll
    for (int i = 0; i < 2; ++i)
#pragma unroll
      for (int j = 0; j < 2; ++j) {
        const int tok = m0 + wr * 64 + i * 32 + l31; const int cb = n0 + wc * 64 + j * 32 + 4 * hh;
        const float* xr = ((tok < TP) ? p.in[0] + (size_t)tok * 1024 : p.in[1] + (size_t)(tok - TP) * 1024) + cb;
        float* orow = x1 + (size_t)tok * 1024 + cb;
#pragma unroll
        for (int g = 0; g < 4; ++g) {
          const f32x4 xv = *(const f32x4*)(xr + 8 * g);
          f32x4 w = {xv[0] + acc[i][j][4 * g], xv[1] + acc[i][j][4 * g + 1], xv[2] + acc[i][j][4 * g + 2], xv[3] + acc[i][j][4 * g + 3]};
          *(f32x4*)(orow + 8 * g) = w;
        }
      }
  }
}

__device__ void phase_ffn_norm(const Params& p) {
  char* ws = p.ws;
  const int gtid = blockIdx.x * 256 + threadIdx.x, gthreads = gridDim.x * 256;
  const int gw = gtid >> 6, nw = gthreads >> 6, lane = threadIdx.x & 63;
  const float* x1 = (const float*)(ws + D_X1); bf16_t* hf = (bf16_t*)(ws + W_C); const float* g = p.in[19];
  for (int t = gw; t < T; t += nw) {
    const float* x = x1 + (size_t)t * DM;
    f32x4 v[4]; float ss = 0.f;
#pragma unroll
    for (int i = 0; i < 4; ++i) { v[i] = *(const f32x4*)(x + i * 256 + lane * 4); ss += v[i][0] * v[i][0] + v[i][1] * v[i][1] + v[i][2] * v[i][2] + v[i][3] * v[i][3]; }
    ss = wave_sum(ss);
    const float rs = rsqrtf(ss * (1.f / DM) + EPS);
#pragma unroll
    for (int i = 0; i < 4; ++i) {
      f32x4 gg = *(const f32x4*)(g + i * 256 + lane * 4);
      u32x2 w; w.x = pk2(v[i][0] * rs * gg[0], v[i][1] * rs * gg[1]); w.y = pk2(v[i][2] * rs * gg[2], v[i][3] * rs * gg[3]);
      *(u32x2*)(hf + (size_t)t * LDH + i * 256 + lane * 4) = w;
    }
  }
  unsigned char* q8 = (unsigned char*)(ws + W_F); float* qs = (float*)(ws + W_F + 33554432);
  for (int r = gw; r < 2 * 16384; r += nw) {
    const float* src = (r < 16384) ? p.in[22] + (size_t)r * DM : p.in[23] + (size_t)(r - 16384) * DM;
    f32x4 v[4]; float am = 0.f;
#pragma unroll
    for (int i = 0; i < 4; ++i) { v[i] = *(const f32x4*)(src + lane * 16 + i * 4); am = fmaxf(am, fmaxf(fmaxf(fabsf(v[i][0]), fabsf(v[i][1])), fmaxf(fabsf(v[i][2]), fabsf(v[i][3])))); }
#pragma unroll
    for (int o = 32; o >= 1; o >>= 1) am = fmaxf(am, __shfl_xor(am, o));
    const float sc = am > 0.f ? 224.f / am : 1.f;
    u32x4 w;
#pragma unroll
    for (int i = 0; i < 4; ++i) {
      int d = 0;
      d = __builtin_amdgcn_cvt_pk_fp8_f32(v[i][0] * sc, v[i][1] * sc, d, false);
      d = __builtin_amdgcn_cvt_pk_fp8_f32(v[i][2] * sc, v[i][3] * sc, d, true);
      w[i] = (unsigned)d;
    }
    *(u32x4*)(q8 + (r < 16384 ? (size_t)r * 2048 : (size_t)(r - 16384) * 2048 + 1024) + lane * 16) = w;
    if (lane == 0) qs[r] = am > 0.f ? am / 224.f : 1.f;
  }
}

__device__ void phase_peer_q(const Params& p, char* lds) {
  char* ws = p.ws;
  const int lane = threadIdx.x & 63, wid = threadIdx.x >> 6, wr = wid >> 1, wc = wid & 1, hh = lane >> 5, l31 = lane & 31;
  bf16_t* pq = (bf16_t*)(ws + W_B);
  for (int it = 0;; ++it) {
    int mt, nt; if (!tile_at(260, 8, it, mt, nt)) break;
    const int m0 = mt * 128, n0 = nt * 128;
    f32x16 acc[2][2]; zero_acc(acc);
    gemm_mainloop<true>((const bf16_t*)(ws + W_C) + (size_t)m0 * LDH, LDH, (const bf16_t*)(ws + W_WQ) + (size_t)n0 * LDH, LDH, 1024, acc, lds, 2 * ((mt + nt) & 7));
#pragma unroll
    for (int i = 0; i < 2; ++i)
#pragma unroll
      for (int j = 0; j < 2; ++j) {
        const int tok = m0 + wr * 64 + i * 32 + l31; const int cb = n0 + wc * 64 + j * 32;
        st_bf16_sw(pq + (size_t)tok * LDH + cb, acc[i][j], hh, 1.f);
      }
  }
}

__device__ __forceinline__ unsigned fkey(float f) { unsigned u = __float_as_uint(f); return (u & 0x80000000u) ? ~u : (u | 0x80000000u); }
__device__ __forceinline__ float fkey_inv(unsigned k) { unsigned u = (k & 0x80000000u) ? (k & 0x7fffffffu) : ~k; return __uint_as_float(u); }
__device__ __forceinline__ void insert16(unsigned (&L)[16], unsigned x) {
#pragma unroll
  for (int i = 0; i < 16; ++i) { const unsigned hi = x > L[i] ? x : L[i]; x = x > L[i] ? L[i] : x; L[i] = hi; }
}
__device__ __forceinline__ void cswap_desc(unsigned& a, unsigned& b) { const unsigned hi = a > b ? a : b, lo = a > b ? b : a; a = hi; b = lo; }
__device__ __forceinline__ void sort16_desc(unsigned (&a)[16]) {
#pragma unroll
  for (int k = 2; k <= 16; k <<= 1)
#pragma unroll
    for (int j = k >> 1; j > 0; j >>= 1)
#pragma unroll
      for (int i = 0; i < 16; ++i) {
        const int l = i ^ j;
        if (l > i) { if ((i & k) == 0) cswap_desc(a[i], a[l]); else cswap_desc(a[l], a[i]); }
      }
}
template <bool SORT>
__device__ __forceinline__ void merge16_desc(unsigned (&a)[16], const unsigned (&b)[16]) {
#pragma unroll
  for (int i = 0; i < 16; ++i) a[i] = a[i] > b[15 - i] ? a[i] : b[15 - i];
  if (SORT) {
#pragma unroll
    for (int j = 8; j > 0; j >>= 1)
#pragma unroll
      for (int i = 0; i < 16; ++i) { const int l = i ^ j; if (l > i) cswap_desc(a[i], a[l]); }
  }
}
__device__ void phase_peer_select(const Params& p, char* lds) {
  char* ws = p.ws;
  const int tid = threadIdx.x, lane = tid & 63, wid = tid >> 6, hh = lane >> 5, l31 = lane & 31;
  const bf16_t* pq = (const bf16_t*)(ws + W_B); const bf16_t* keys = (const bf16_t*)(ws + W_KEYS);
  int* seli = (int*)(ws + D_SELI); float* selw = (float*)(ws + D_SELW);
  float* S = (float*)lds;
  unsigned* LH = (unsigned*)lds;
  unsigned* LF = LH + 2 * 64 * 20;
  for (int u = blockIdx.x; u < 520 * 8; u += gridDim.x) {
    const int tt = u >> 3, h = u & 7; const int t0 = tt * 64;
    {
      const int c = wid >> 1;
      f32x16 acc[2][2]; zero_acc(acc);
      const bf16_t* ap = pq + (size_t)(t0 + l31) * LDH + h * 128 + c * 64 + hh * 8;
      const bf16_t* bp = keys + ((size_t)((h * 2 + c) * 128 + (wid & 1) * 64 + l31)) * 64 + hh * 8;
#pragma unroll
      for (int ks = 0; ks < 4; ++ks) {
        bf16x8 a0 = *(const bf16x8*)(ap + ks * 16), a1 = *(const bf16x8*)(ap + 32 * LDH + ks * 16);
        bf16x8 b0 = *(const bf16x8*)(bp + ks * 16), b1 = *(const bf16x8*)(bp + 32 * 64 + ks * 16);
        acc[0][0] = mfma32(a0, b0, acc[0][0]); acc[0][1] = mfma32(a0, b1, acc[0][1]);
        acc[1][0] = mfma32(a1, b0, acc[1][0]); acc[1][1] = mfma32(a1, b1, acc[1][1]);
      }
#pragma unroll
      for (int i = 0; i < 2; ++i)
#pragma unroll
        for (int j = 0; j < 2; ++j)
#pragma unroll
          for (int r = 0; r < 16; ++r) S[(i * 32 + accrow(r, hh)) * 260 + c * 128 + (wid & 1) * 64 + j * 32 + l31] = acc[i][j][r];
    }
    __syncthreads();
    const int tok = lane, c = wid & 1, half = wid >> 1;
    unsigned L[16];
    {
      const float* sp = S + tok * 260 + c * 128 + half * 64;
#pragma unroll
      for (int grp = 0; grp < 4; ++grp) {
        unsigned G[16];
#pragma unroll
        for (int n4 = 0; n4 < 4; ++n4) {
          const f32x4 v = *(const f32x4*)(sp + grp * 16 + n4 * 4);
          const unsigned ib = (unsigned)(127 - (half * 64 + grp * 16 + n4 * 4));
#pragma unroll
          for (int e = 0; e < 4; ++e) G[n4 * 4 + e] = (fkey(v[e]) & ~127u) | (ib - e);
        }
        sort16_desc(G);
        if (grp == 0) {
#pragma unroll
          for (int i = 0; i < 16; ++i) L[i] = G[i];
        } else merge16_desc<true>(L, G);
      }
    }
    __syncthreads();
    if (half == 1) {
#pragma unroll
      for (int i = 0; i < 16; i += 4) { u32x4 w = {L[i], L[i + 1], L[i + 2], L[i + 3]}; *(u32x4*)(LH + (c * 64 + tok) * 20 + i) = w; }
    }
    __syncthreads();
    if (half == 0) {
      unsigned G[16];
#pragma unroll
      for (int i = 0; i < 16; i += 4) {
        const u32x4 w = *(const u32x4*)(LH + (c * 64 + tok) * 20 + i);
        G[i] = w[0]; G[i + 1] = w[1]; G[i + 2] = w[2]; G[i + 3] = w[3];
      }
      merge16_desc<true>(L, G);
#pragma unroll
      for (int i = 0; i < 16; i += 4) { u32x4 w = {L[i], L[i + 1], L[i + 2], L[i + 3]}; *(u32x4*)(LF + (c * 64 + tok) * 20 + i) = w; }
    }
    __syncthreads();
    if (wid == 0) {
      float a[16], b[16];
#pragma unroll
      for (int i = 0; i < 16; ++i) a[i] = fkey_inv(L[i]);
#pragma unroll
      for (int j = 0; j < 16; j += 4) {
        const u32x4 w = *(const u32x4*)(LF + (64 + tok) * 20 + j);
        b[j] = fkey_inv(w[0]); b[j + 1] = fkey_inv(w[1]); b[j + 2] = fkey_inv(w[2]); b[j + 3] = fkey_inv(w[3]);
      }
      unsigned M[16], G[16];
#pragma unroll
      for (int j = 0; j < 16; ++j) M[j] = (fkey(a[0] + b[j]) & ~255u) | (unsigned)(255 - j);
      sort16_desc(M);
#define PK_CAND(i, j) ((fkey(a[i] + b[j]) & ~255u) | (unsigned)(255 - ((i) * 16 + (j))))
      G[0] = PK_CAND(1, 0); G[1] = PK_CAND(1, 1); G[2] = PK_CAND(1, 2); G[3] = PK_CAND(1, 3); G[4] = PK_CAND(1, 4); G[5] = PK_CAND(1, 5); G[6] = PK_CAND(1, 6); G[7] = PK_CAND(1, 7);
      G[8] = PK_CAND(2, 0); G[9] = PK_CAND(2, 1); G[10] = PK_CAND(2, 2); G[11] = PK_CAND(2, 3); G[12] = PK_CAND(2, 4); G[13] = 0u; G[14] = 0u; G[15] = 0u;
      sort16_desc(G); merge16_desc<true>(M, G);
      G[0] = PK_CAND(3, 0); G[1] = PK_CAND(3, 1); G[2] = PK_CAND(3, 2); G[3] = PK_CAND(3, 3); G[4] = PK_CAND(4, 0); G[5] = PK_CAND(4, 1); G[6] = PK_CAND(4, 2);
      G[7] = PK_CAND(5, 0); G[8] = PK_CAND(5, 1); G[9] = PK_CAND(6, 0); G[10] = PK_CAND(6, 1); G[11] = PK_CAND(7, 0); G[12] = PK_CAND(7, 1); G[13] = 0u; G[14] = 0u; G[15] = 0u;
      sort16_desc(G); merge16_desc<true>(M, G);
      G[0] = PK_CAND(8, 0); G[1] = PK_CAND(9, 0); G[2] = PK_CAND(10, 0); G[3] = PK_CAND(11, 0); G[4] = PK_CAND(12, 0); G[5] = PK_CAND(13, 0); G[6] = PK_CAND(14, 0); G[7] = PK_CAND(15, 0);
#pragma unroll
      for (int i = 8; i < 16; ++i) G[i] = 0u;
      sort16_desc(G); merge16_desc<true>(M, G);
#undef PK_CAND
      const float mx = fkey_inv(M[0]);
      float ev[16], den = 0.f;
#pragma unroll
      for (int k = 0; k < 16; ++k) { ev[k] = __expf(fkey_inv(M[k]) - mx); den += ev[k]; }
      const float rden = 1.f / den;
      const size_t o = ((size_t)(t0 + tok) * 8 + h) * 16;
#pragma unroll
      for (int k4 = 0; k4 < 16; k4 += 4) {
        int id[4]; f32x4 wv;
#pragma unroll
        for (int e = 0; e < 4; ++e) {
          const int flat = 255 - (int)(M[k4 + e] & 255u);
          const int i1 = 127 - (int)(LF[tok * 20 + (flat >> 4)] & 127u), i2 = 127 - (int)(LF[(64 + tok) * 20 + (flat & 15)] & 127u);
          id[e] = i1 * 128 + i2; wv[e] = ev[k4 + e] * rden;
        }
        *(int4*)(seli + o + k4) = make_int4(id[0], id[1], id[2], id[3]);
        *(f32x4*)(selw + o + k4) = wv;
      }
    }
    __syncthreads();
  }
}

__device__ __forceinline__ void peer_token_part(const Params& p, int t, int e_lo, int e_hi, float (&ov)[16], int lane) {
  char* ws = p.ws;
  const bf16_t* hf = (const bf16_t*)(ws + W_C);
  const unsigned char* u8 = (const unsigned char*)(ws + W_F); const unsigned char* v8 = u8 + 1024;
  const float* qs = (const float*)(ws + W_F + 33554432);
  const int* seli = (const int*)(ws + D_SELI); const float* selw = (const float*)(ws + D_SELW);
  f32v2_t hv[8], o2[8];
  {
    u32x4 a = *(const u32x4*)(hf + (size_t)t * LDH + lane * 16), b = *(const u32x4*)(hf + (size_t)t * LDH + lane * 16 + 8);
#pragma unroll
    for (int i = 0; i < 4; ++i) { hv[i] = (f32v2_t){bflo(a[i]), bfhi(a[i])}; hv[4 + i] = (f32v2_t){bflo(b[i]), bfhi(b[i])}; }
#pragma unroll
    for (int i = 0; i < 8; ++i) o2[i] = (f32v2_t){ov[2 * i], ov[2 * i + 1]};
  }
  const int myi0 = seli[(size_t)t * 128 + lane], myi1 = seli[(size_t)t * 128 + 64 + lane];
  const float mysu0 = qs[myi0], mysu1 = qs[myi1];
  const float myw0 = selw[(size_t)t * 128 + lane] * qs[16384 + myi0], myw1 = selw[(size_t)t * 128 + 64 + lane] * qs[16384 + myi1];
  const int b0 = lane & 1, b1 = lane & 2, b2 = lane & 4;
  for (int e0 = e_lo; e0 < e_hi; e0 += 8) {
    u32x4 ua[8], va[8];
    const int esel = (e0 & 63) + (lane & 7);
    const float sul = __shfl(e0 < 64 ? mysu0 : mysu1, esel), gwl = __shfl(e0 < 64 ? myw0 : myw1, esel);
#pragma unroll
    for (int k = 0; k < 8; ++k) {
      const int idx = __shfl(e0 < 64 ? myi0 : myi1, (e0 & 63) + k);
      ua[k] = *(const u32x4*)(u8 + (size_t)idx * 2048 + lane * 16);
      va[k] = *(const u32x4*)(v8 + (size_t)idx * 2048 + lane * 16);
    }
    float d[8];
#pragma unroll
    for (int k = 0; k < 8; ++k) {
      f32v2_t acc = {0.f, 0.f};
#pragma unroll
      for (int i = 0; i < 4; ++i) {
        const f32v2_t lo = __builtin_amdgcn_cvt_pk_f32_fp8((int)ua[k][i], false), hi = __builtin_amdgcn_cvt_pk_f32_fp8((int)ua[k][i], true);
        acc = hv[2 * i] * lo + acc; acc = hv[2 * i + 1] * hi + acc;
      }
      d[k] = acc[0] + acc[1];
    }
    float v4[4], v2[2], v1;
#pragma unroll
    for (int j = 0; j < 4; ++j) { const float keep = b0 ? d[2 * j + 1] : d[2 * j], send = b0 ? d[2 * j] : d[2 * j + 1]; v4[j] = keep + __shfl_xor(send, 1); }
#pragma unroll
    for (int j = 0; j < 2; ++j) { const float keep = b1 ? v4[2 * j + 1] : v4[2 * j], send = b1 ? v4[2 * j] : v4[2 * j + 1]; v2[j] = keep + __shfl_xor(send, 2); }
    { const float keep = b2 ? v2[1] : v2[0], send = b2 ? v2[0] : v2[1]; v1 = keep + __shfl_xor(send, 4); }
    v1 += __shfl_xor(v1, 8); v1 += __shfl_xor(v1, 16); v1 += __shfl_xor(v1, 32);
    const float dl = v1 * sul;
    const float wl = gwl * (0.5f * dl * (1.f + erff(dl * 0.70710678118654752f)));
#pragma unroll
    for (int k = 0; k < 8; ++k) {
      const float w = __builtin_bit_cast(float, __builtin_amdgcn_readlane(__builtin_bit_cast(int, wl), k));
      const f32v2_t w2 = {w, w};
#pragma unroll
      for (int i = 0; i < 4; ++i) {
        const f32v2_t lo = __builtin_amdgcn_cvt_pk_f32_fp8((int)va[k][i], false), hi = __builtin_amdgcn_cvt_pk_f32_fp8((int)va[k][i], true);
        o2[2 * i] = w2 * lo + o2[2 * i]; o2[2 * i + 1] = w2 * hi + o2[2 * i + 1];
      }
    }
  }
#pragma unroll
  for (int i = 0; i < 8; ++i) { ov[2 * i] = o2[i][0]; ov[2 * i + 1] = o2[i][1]; }
}
__device__ __forceinline__ void peer_token_finish(const Params& p, int t, float (&ov)[16], int lane) {
  const float* xr = (const float*)(p.ws + D_X1) + (size_t)t * DM + lane * 16; const float* g = p.in[24] + lane * 16;
  float ss = 0.f;
#pragma unroll
  for (int i = 0; i < 4; ++i) { f32x4 a = *(const f32x4*)(xr + i * 4); ov[4 * i] += a[0]; ov[4 * i + 1] += a[1]; ov[4 * i + 2] += a[2]; ov[4 * i + 3] += a[3]; }
#pragma unroll
  for (int i = 0; i < 16; ++i) ss += ov[i] * ov[i];
  ss = wave_sum(ss);
  const float rs = rsqrtf(ss * (1.f / DM) + EPS);
  float* y = p.out + O_Y + (size_t)t * DM + lane * 16;
#pragma unroll
  for (int i = 0; i < 4; ++i) {
    f32x4 ga = *(const f32x4*)(g + i * 4); f32x4 o;
    o[0] = ov[4 * i] * rs * ga[0]; o[1] = ov[4 * i + 1] * rs * ga[1]; o[2] = ov[4 * i + 2] * rs * ga[2]; o[3] = ov[4 * i + 3] * rs * ga[3];
    *(f32x4*)(y + i * 4) = o;
  }
}
__device__ void phase_peer_gather(const Params& p, char* lds) {
  const int wid = threadIdx.x >> 6, lane = threadIdx.x & 63;
  const int gw = blockIdx.x * 4 + wid, nw = gridDim.x * 4;
  const int t_main = (T / nw) * nw;
  for (int t = gw; t < t_main; t += nw) {
    float ov[16];
#pragma unroll
    for (int i = 0; i < 16; ++i) ov[i] = 0.f;
    peer_token_part(p, t, 0, 128, ov, lane);
    peer_token_finish(p, t, ov, lane);
  }
  float* part = (float*)lds;
  for (int t = t_main + blockIdx.x; t < T; t += gridDim.x) {
    float ov[16];
#pragma unroll
    for (int i = 0; i < 16; ++i) ov[i] = 0.f;
    peer_token_part(p, t, wid * 32, wid * 32 + 32, ov, lane);
    if (wid > 0) {
#pragma unroll
      for (int i = 0; i < 4; ++i) { f32x4 w = {ov[4 * i], ov[4 * i + 1], ov[4 * i + 2], ov[4 * i + 3]}; *(f32x4*)(part + wid * 1024 + lane * 16 + i * 4) = w; }
    }
    __syncthreads();
    if (wid == 0) {
#pragma unroll
      for (int w = 1; w < 4; ++w)
#pragma unroll
        for (int i = 0; i < 4; ++i) { const f32x4 v = *(const f32x4*)(part + w * 1024 + lane * 16 + i * 4); ov[4 * i] += v[0]; ov[4 * i + 1] += v[1]; ov[4 * i + 2] += v[2]; ov[4 * i + 3] += v[3]; }
      peer_token_finish(p, t, ov, lane);
    }
    __syncthreads();
  }
}

constexpr int NPHASE = 12;
__global__ void __launch_bounds__(256, 2) mega(Params p, int ph_lo, int ph_hi, int dupmask) {
  __shared__ __attribute__((aligned(16))) char lds[73728];
  __shared__ int s_item;
  __shared__ unsigned s_bar[4];
  unsigned* bar = (unsigned*)(p.ws + W_BAR);
  const unsigned xcc = xb_xcc_id();
  if (threadIdx.x < 4) s_bar[threadIdx.x] = 0u;
  if (threadIdx.x == 0 && ph_hi - ph_lo > 1) (void)xb_add(&bar[XB_XCNT(xcc)], 1u);
  __syncthreads();
  if (ph_hi > 4096) cg::this_grid().sync();
#define RUN_PHASE(PH, CALL)                                                       \
  if ((ONLY < 0 || ONLY == PH) && ph_lo <= PH && PH < ph_hi) {                    \
    const int nrep = 1 + ((dupmask >> PH) & 1);                                   \
    for (int rep = 0; rep < nrep; ++rep) {                                        \
      const int dry = (rep + 1 < nrep); (void)dry;                                \
      CALL;                                                                       \
      if (dry) grid_barrier(bar, xcc, s_bar);                                     \
    }                                                                             \
    if (PH + 1 < ph_hi) {                                                         \
      grid_barrier(bar, xcc, s_bar);                                              \
    }                                                                             \
  }
  RUN_PHASE(0, phase_prep(p))
  RUN_PHASE(1, phase_inproj(p, lds))
  RUN_PHASE(2, phase_small(p))
  RUN_PHASE(3, phase_attn_diff(p, lds, &s_item, dry))
  RUN_PHASE(4, phase_mla_expand(p, lds))
  RUN_PHASE(5, phase_attn_mla(p, lds, &s_item, dry))
  RUN_PHASE(6, phase_merge(p, lds))
  RUN_PHASE(7, phase_outproj(p, lds))
  RUN_PHASE(8, phase_ffn_norm(p))
  RUN_PHASE(9, phase_peer_q(p, lds))
  RUN_PHASE(10, phase_peer_select(p, lds))
  RUN_PHASE(11, phase_peer_gather(p, lds))
}

extern "C" void kernel_launch(void* const* d_in, const int* in_sizes, int n_in, void* d_out, int out_size, void* d_ws, size_t ws_size,
                              hipStream_t stream) {
  if (ws_size < W_END || n_in < 25) { fprintf(stderr, "workspace too small: %zu < %zu\n", ws_size, (size_t)W_END); return; }
  static int grid_blocks = 0;
  if (!grid_blocks) {
    int dev = 0, cus = 0, per_cu = 0;
    hipGetDevice(&dev);
    hipDeviceGetAttribute(&cus, hipDeviceAttributeMultiprocessorCount, dev);
    hipOccupancyMaxActiveBlocksPerMultiprocessor(&per_cu, mega, 256, 0);
    if (per_cu > 2) per_cu = 2;
    grid_blocks = cus * per_cu;
  }
  Params p{};
  for (int i = 0; i < 25; ++i) p.in[i] = (const float*)d_in[i];
  p.out = (float*)d_out; p.ws = (char*)d_ws; p.nblocks = (unsigned)grid_blocks; p.pad = 0;
  hipMemsetAsync((char*)d_ws + W_BAR, 0, 16384, stream);
#if MULTI_LAUNCH
  for (int ph = 0; ph < NPHASE; ++ph) {
    hipLaunchKernelGGL(mega, dim3(grid_blocks), dim3(256), 0, stream, p, ph, ph + 1, 0);
  }
#else
  int lo = 0, hi = NPHASE, dup = DUPMASK;
  void* args[] = {&p, &lo, &hi, &dup};
  hipError_t e = hipLaunchCooperativeKernel((void*)mega, dim3(grid_blocks), dim3(256), args, 0, stream);
  if (e != hipSuccess) fprintf(stderr, "cooperative launch failed: %s (grid %d)\n", hipGetErrorString(e), grid_blocks);
#endif
}
```

```cpp
#include <hip/hip_runtime.h>
#include <hip/hip_cooperative_groups.h>
#include <cstdio>
#include <cstdint>
namespace cg = cooperative_groups;

#ifndef ONLY
#define ONLY (-1)
#endif
#ifndef DUPMASK
#define DUPMASK 0
#endif
#ifndef MULTI_LAUNCH
#define MULTI_LAUNCH 0
#endif

typedef unsigned short bf16_t;
typedef short bf16x8 __attribute__((ext_vector_type(8)));
typedef float f32x4 __attribute__((ext_vector_type(4)));
typedef float f32x16 __attribute__((ext_vector_type(16)));
typedef unsigned u32x4 __attribute__((ext_vector_type(4)));
typedef unsigned u32x2 __attribute__((ext_vector_type(2)));

constexpr int DM = 1024;
constexpr int TP = 32768, TS = 512, T = TP + TS;
constexpr int SEQ = 4096, PAST = 2048, LKS = 2112;
constexpr int R = TP + 8 * LKS;
constexpr int NIN = 5632;
constexpr int LDH = 1088;
constexpr int LDQ = 288;
constexpr int LDK = 160;
constexpr int SEQP = 4160;
constexpr float LOG2E = 1.4426950408889634f;
constexpr float EPS = 1e-6f;

constexpr size_t O_Y = 0;
constexpr size_t O_KP = 34078720, O_VP = 67633152, O_CP = 101187584, O_EP = 105381888;
constexpr size_t O_KS = 106430464, O_VS = 106954752, O_CS = 107479040, O_ES = 107544576;

constexpr size_t W_WIN = 0;
constexpr size_t W_WUQ = W_WIN + (size_t)NIN * LDH * 2;
constexpr size_t W_WUKV = W_WUQ + (size_t)1536 * LDQ * 2;
constexpr size_t W_WA = W_WUKV + (size_t)2048 * LDK * 2;
constexpr size_t W_WB = W_WA + (size_t)1024 * LDH * 2;
constexpr size_t W_WO = W_WB + (size_t)1024 * LDH * 2;
constexpr size_t W_WQ = W_WO + (size_t)1024 * LDH * 2;
constexpr size_t W_KEYS = W_WQ + (size_t)1024 * LDH * 2;
constexpr size_t W_ROPE = W_KEYS + 262144;
constexpr size_t W_MISC = W_ROPE + 524288;
constexpr size_t W_BAR = W_MISC + 8192;
constexpr int QW = 3584;
constexpr size_t SZ_ACT = (size_t)T * LDH * 2;
constexpr size_t W_B = W_BAR + 16384;
constexpr size_t W_C = W_B + SZ_ACT;
constexpr size_t W_D = W_C + SZ_ACT;
constexpr size_t SZ_VTP = (size_t)8 * 1024 * SEQP * 2, SZ_VTS = (size_t)8 * 1024 * LKS * 2;
constexpr size_t W_D2 = W_D + (size_t)R * LDH * 2;
constexpr size_t W_F = W_D2 + SZ_VTP + SZ_VTS;
constexpr size_t F_ZCQ = W_F, F_ZCKV = F_ZCQ + 34078720, F_ZKR = F_ZCKV + 17039360, F_CQ = F_ZKR + 4259840;
constexpr size_t SZ_F = (F_CQ - W_F) + (size_t)T * LDQ * 2;
static_assert(SZ_F >= SZ_ACT, "merged must fit in F");
constexpr size_t W_G = W_F + SZ_F;
constexpr size_t W_KPE = W_G + (size_t)R * LDK * 2;
constexpr size_t W_END = W_KPE + (size_t)R * 32 * 2;
static_assert(W_END <= 536870912ull, "workspace budget");
constexpr size_t D_X1 = W_D, D_SELI = W_D + 136314880, D_SELW = D_SELI + 17039360;
static_assert(D_SELW + 17039360 <= W_F, "x1 + sel must fit in D");

struct Params {
  const float* in[25];
  float* out;
  char* ws;
  unsigned nblocks;
  unsigned pad;
};

typedef __bf16 bf16v2_t __attribute__((ext_vector_type(2)));
typedef float f32v2_t __attribute__((ext_vector_type(2)));
__device__ __forceinline__ unsigned pk2(float lo, float hi) { f32v2_t v = {lo, hi}; bf16v2_t r = __builtin_convertvector(v, bf16v2_t); return __builtin_bit_cast(unsigned, r); }
__device__ __forceinline__ bf16_t f2bf(float x) { return (bf16_t)(pk2(x, 0.f) & 0xffffu); }
__device__ __forceinline__ float bf2f(bf16_t v) { return __uint_as_float(((unsigned)v) << 16); }
__device__ __forceinline__ float bflo(unsigned w) { return __uint_as_float(w << 16); }
__device__ __forceinline__ float bfhi(unsigned w) { return __uint_as_float(w & 0xffff0000u); }
__device__ __forceinline__ float wave_sum(float v) {
#pragma unroll
  for (int o = 32; o >= 1; o >>= 1) v += __shfl_xor(v, o);
  return v;
}
__device__ __forceinline__ f32x16 mfma32(bf16x8 a, bf16x8 b, f32x16 c) { return __builtin_amdgcn_mfma_f32_32x32x16_bf16(a, b, c, 0, 0, 0); }
__device__ __forceinline__ int accrow(int reg, int hh) { return (reg & 3) + 8 * (reg >> 2) + 4 * hh; }
__device__ __forceinline__ int kperm(int k) { return (k & ~12) | ((k & 4) << 1) | ((k & 8) >> 1); }

__device__ __forceinline__ int keyrow_of_token(int t) {
  if (t < TP) return t;
  int ts = t - TP; return TP + (ts >> 6) * LKS + PAST + (ts & 63);
}

#define XB_XCNT(j)  (256  + 64 * (j))
#define XB_XSUB(j)  (1280 + 64 * (j))
#define XB_XGEN(j)  (2304 + 64 * (j))
#define XB_TOP      3328
#define XB_TOPGEN   3392
__device__ __forceinline__ unsigned xb_ld(unsigned* p)              { return __hip_atomic_load(p, __ATOMIC_RELAXED, __HIP_MEMORY_SCOPE_AGENT); }
__device__ __forceinline__ unsigned xb_add(unsigned* p, unsigned v) { return __hip_atomic_fetch_add(p, v, __ATOMIC_RELAXED, __HIP_MEMORY_SCOPE_AGENT); }
__device__ __forceinline__ unsigned xb_xcc_id() { return (unsigned)__builtin_amdgcn_s_getreg((3 << 11) | 20) & 0xFu; }
__device__ __forceinline__ void grid_barrier(unsigned* bar, unsigned xcc, volatile unsigned* st) {
  asm volatile("s_waitcnt vmcnt(0)" ::: "memory");
  __syncthreads();
  if (threadIdx.x == 0) {
    __builtin_amdgcn_s_waitcnt(0);
    unsigned nloc = st[0], nx = st[1];
    if (nloc == 0u) {
      const unsigned G = gridDim.x;
      for (;;) {
        unsigned sum = 0u, cnt = 0u, mine = 0u;
#pragma unroll
        for (unsigned j = 0; j < 16; ++j) { const unsigned c = xb_ld(&bar[XB_XCNT(j)]); sum += c; cnt += (c > 0u) ? 1u : 0u; mine = (j == xcc) ? c : mine; }
        if (sum == G) { nloc = mine; nx = cnt; break; }
        __builtin_amdgcn_s_sleep(1);
      }
      st[0] = nloc; st[1] = nx;
    }
    const unsigned old = xb_add(&bar[XB_XSUB(xcc)], 1u);
    const unsigned gen = old / nloc;
    if (old + 1u == (gen + 1u) * nloc) {
      __builtin_amdgcn_fence(__ATOMIC_RELEASE, "agent");
      asm volatile("s_waitcnt vmcnt(0)" ::: "memory");
      const unsigned og = xb_add(&bar[XB_TOP], 1u);
      const unsigned tg = og / nx;
      if (og + 1u == (tg + 1u) * nx) xb_add(&bar[XB_TOPGEN], 1u);
      else { while (xb_ld(&bar[XB_TOPGEN]) == tg) __builtin_amdgcn_s_sleep(1); }
      __builtin_amdgcn_fence(__ATOMIC_ACQUIRE, "agent");
      xb_add(&bar[XB_XGEN(xcc)], 1u);
      asm volatile("s_waitcnt vmcnt(0)" ::: "memory");
    } else {
      while (xb_ld(&bar[XB_XGEN(xcc)]) == gen) __builtin_amdgcn_s_sleep(1);
      __builtin_amdgcn_fence(__ATOMIC_ACQUIRE, "agent");
      asm volatile("s_waitcnt vmcnt(0)" ::: "memory");
    }
  }
  __syncthreads();
}

constexpr int GEMM_BUF = 32768;
typedef __attribute__((address_space(3))) unsigned lds_u32_t;
typedef __attribute__((address_space(1))) const unsigned glb_u32_t;
__device__ __forceinline__ void glds16(const bf16_t* g, char* l) {
  __builtin_amdgcn_global_load_lds((glb_u32_t*)g, (lds_u32_t*)l, 16, 0, 0);
}
template <bool SW>
__device__ __forceinline__ void gemm_mainloop(const bf16_t* __restrict__ A, int lda, const bf16_t* __restrict__ Bt, int ldb, int K,
                                              f32x16 (&acc)[2][2], char* lds, int kstart) {
  const int tid = threadIdx.x, lane = tid & 63, wid = tid >> 6;
  const int wr = wid >> 1, wc = wid & 1, l31 = lane & 31, hh = lane >> 5;
  const int lrow = wid * 32 + (lane >> 3);
  const int nk = K >> 6;
  kstart &= (nk - 1);
  const bf16_t* ap[4]; const bf16_t* bp[4];
#pragma unroll
  for (int i = 0; i < 4; ++i) {
    const int row = lrow + 8 * i; const int ch = (lane & 7) ^ ((row >> 1) & 7);
    ap[i] = A + (size_t)row * lda + ch * 8; bp[i] = Bt + (size_t)row * ldb + ch * 8;
  }
  char* ldst = lds + (wid * 32) * 128 + lane * 16;
#pragma unroll
  for (int i = 0; i < 4; ++i) { glds16(ap[i] + kstart * 64, ldst + i * 1024); glds16(bp[i] + kstart * 64, ldst + 16384 + i * 1024); }
  asm volatile("s_waitcnt vmcnt(0)" ::: "memory");
  __syncthreads();
  const int swz = (l31 >> 1) & 7;
  const int roffA = (wr * 64 + l31) * 128, roffB = 16384 + (wc * 64 + l31) * 128;
#pragma unroll 1
  for (int kt = 0; kt < nk; ++kt) {
    const bool more = (kt + 1 < nk);
    if (more) {
      char* d = ldst + ((kt + 1) & 1) * GEMM_BUF;
      const int ko = ((kt + 1 + kstart) & (nk - 1)) * 64;
#pragma unroll
      for (int i = 0; i < 4; ++i) { glds16(ap[i] + ko, d + i * 1024); glds16(bp[i] + ko, d + 16384 + i * 1024); }
    }
    const char* base = lds + (kt & 1) * GEMM_BUF;
#pragma unroll
    for (int ks = 0; ks < 4; ++ks) {
      const int co = ((2 * ks + hh) ^ swz) * 16;
      bf16x8 a0 = *(const bf16x8*)(base + roffA + co), a1 = *(const bf16x8*)(base + roffA + 32 * 128 + co);
      bf16x8 b0 = *(const bf16x8*)(base + roffB + co), b1 = *(const bf16x8*)(base + roffB + 32 * 128 + co);
      if (SW) {
        acc[0][0] = mfma32(b0, a0, acc[0][0]); acc[0][1] = mfma32(b1, a0, acc[0][1]);
        acc[1][0] = mfma32(b0, a1, acc[1][0]); acc[1][1] = mfma32(b1, a1, acc[1][1]);
      } else {
        acc[0][0] = mfma32(a0, b0, acc[0][0]); acc[0][1] = mfma32(a0, b1, acc[0][1]);
        acc[1][0] = mfma32(a1, b0, acc[1][0]); acc[1][1] = mfma32(a1, b1, acc[1][1]);
      }
    }
    asm volatile("s_waitcnt vmcnt(0)" ::: "memory");
    __syncthreads();
  }
}
__device__ __forceinline__ bool tile_at(int nMt, int nNt, int it, int& mt, int& nt) {
  const int x = blockIdx.x & 7, lb = blockIdx.x >> 3, nloc = gridDim.x >> 3;
  const int mb = (x * nMt) >> 3, mc = (((x + 1) * nMt) >> 3) - mb;
  const int idx = lb + it * nloc;
  if (idx >= mc * nNt) return false;
  const int g = idx / (8 * nNt); const int rem = idx - g * 8 * nNt;
  const int left = mc - g * 8; const int gsz = left < 8 ? left : 8;
  mt = mb + g * 8 + rem % gsz; nt = rem / gsz;
  return true;
}
__device__ __forceinline__ void zero_acc(f32x16 (&acc)[2][2]) {
#pragma unroll
  for (int i = 0; i < 2; ++i)
#pragma unroll
    for (int j = 0; j < 2; ++j)
#pragma unroll
      for (int r = 0; r < 16; ++r) acc[i][j][r] = 0.f;
}

__device__ __forceinline__ void vt_store(bf16_t* vt_row, int key32, const f32x16& a, int hh) {
#pragma unroll
  for (int g = 0; g < 4; ++g) {
    const int pos = key32 + (g >> 1) * 16 + hh * 8 + (g & 1) * 4;
    u32x2 w; w.x = pk2(a[4 * g], a[4 * g + 1]); w.y = pk2(a[4 * g + 2], a[4 * g + 3]);
    *(u32x2*)(vt_row + pos) = w;
  }
}

__device__ __forceinline__ void st_bf16_sw(bf16_t* row, const f32x16& a, int hh, float sc) {
#pragma unroll
  for (int g = 0; g < 4; ++g) { u32x2 w; w.x = pk2(a[4 * g] * sc, a[4 * g + 1] * sc); w.y = pk2(a[4 * g + 2] * sc, a[4 * g + 3] * sc); *(u32x2*)(row + 8 * g + 4 * hh) = w; }
}
__device__ __forceinline__ void st_f32_sw(float* row, const f32x16& a, int hh) {
#pragma unroll
  for (int g = 0; g < 4; ++g) { f32x4 w = {a[4 * g], a[4 * g + 1], a[4 * g + 2], a[4 * g + 3]}; *(f32x4*)(row + 8 * g + 4 * hh) = w; }
}

__device__ void phase_prep(const Params& p) {
  const int gtid = blockIdx.x * 256 + threadIdx.x, gthreads = gridDim.x * 256;
  const int gw = gtid >> 6, nw = gthreads >> 6, lane = threadIdx.x & 63;
  char* ws = p.ws;
  {
    bf16_t* dst = (bf16_t*)(ws + W_WIN); const float* src = p.in[8];
    for (int u = gtid; u < NIN * 128; u += gthreads) {
      const int n = u % NIN, k0 = (u / NIN) * 8;
      int col = n; bool valid = true;
      if (n >= 3584) col = n - 96; else if (n >= 3488) valid = false;
      float v[8];
#pragma unroll
      for (int j = 0; j < 8; ++j) v[j] = valid ? src[(size_t)(k0 + j) * 5536 + col] : 0.f;
      u32x4 w; w.x = pk2(v[0], v[1]); w.y = pk2(v[2], v[3]); w.z = pk2(v[4], v[5]); w.w = pk2(v[6], v[7]);
      *(u32x4*)(dst + (size_t)n * LDH + k0) = w;
    }
  }
  {
    bf16_t* dst = (bf16_t*)(ws + W_WUQ); const float* src = p.in[12];
    for (int u = gtid; u < 1536 * 32; u += gthreads) {
      const int n = u % 1536, k0 = (u / 1536) * 8;
      int col = (n < 1024) ? ((n >> 6) * 96 + (n & 63)) : (((n - 1024) >> 5) * 96 + 64 + ((n - 1024) & 31));
      float v[8];
#pragma unroll
      for (int j = 0; j < 8; ++j) v[j] = src[(size_t)(k0 + j) * 1536 + col];
      u32x4 w; w.x = pk2(v[0], v[1]); w.y = pk2(v[2], v[3]); w.z = pk2(v[4], v[5]); w.w = pk2(v[6], v[7]);
      *(u32x4*)(dst + (size_t)n * LDQ + k0) = w;
    }
  }
  {
    bf16_t* dst = (bf16_t*)(ws + W_WUKV);
    for (int u = gtid; u < 2048 * 16; u += gthreads) {
      const int n = u % 2048, k0 = (u / 2048) * 8;
      const float* src = (n < 1024) ? p.in[14] : p.in[15]; const int col = n & 1023;
      float v[8];
#pragma unroll
      for (int j = 0; j < 8; ++j) v[j] = src[(size_t)(k0 + j) * 1024 + col];
      u32x4 w; w.x = pk2(v[0], v[1]); w.y = pk2(v[2], v[3]); w.z = pk2(v[4], v[5]); w.w = pk2(v[6], v[7]);
      *(u32x4*)(dst + (size_t)n * LDK + k0) = w;
    }
  }
  {
    for (int u = gtid; u < 4 * 1024 * 128; u += gthreads) {
      const int which = u >> 17, uu = u & 131071;
      const int n = uu & 1023, k0 = (uu >> 10) * 8;
      const float* src = which == 0 ? p.in[16] : which == 1 ? p.in[17] : which == 2 ? p.in[18] : p.in[20];
      bf16_t* dst = (bf16_t*)(ws + (which == 0 ? W_WA : which == 1 ? W_WB : which == 2 ? W_WO : W_WQ));
      float v[8];
#pragma unroll
      for (int j = 0; j < 8; ++j) v[j] = src[(size_t)(k0 + j) * 1024 + n];
      u32x4 w; w.x = pk2(v[0], v[1]); w.y = pk2(v[2], v[3]); w.z = pk2(v[4], v[5]); w.w = pk2(v[6], v[7]);
      *(u32x4*)(dst + (size_t)n * LDH + k0) = w;
    }
  }
  {
    bf16_t* dst = (bf16_t*)(ws + W_KEYS); const float* src = p.in[21];
    for (int u = gtid; u < 16 * 128 * 64 / 4; u += gthreads) {
      f32x4 v = *(const f32x4*)(src + (size_t)u * 4);
      u32x2 w; w.x = pk2(v[0], v[1]); w.y = pk2(v[2], v[3]);
      *(u32x2*)(dst + (size_t)u * 4) = w;
    }
  }
  {
    bf16_t* hb = (bf16_t*)(ws + W_B); const float* g = p.in[7];
    for (int t = gw; t < T; t += nw) {
      const float* x = (t < TP) ? p.in[0] + (size_t)t * DM : p.in[1] + (size_t)(t - TP) * DM;
      f32x4 v[4]; float ss = 0.f;
#pragma unroll
      for (int i = 0; i < 4; ++i) { v[i] = *(const f32x4*)(x + i * 256 + lane * 4); ss += v[i][0] * v[i][0] + v[i][1] * v[i][1] + v[i][2] * v[i][2] + v[i][3] * v[i][3]; }
      ss = wave_sum(ss);
      const float rs = rsqrtf(ss * (1.f / DM) + EPS);
#pragma unroll
      for (int i = 0; i < 4; ++i) {
        f32x4 gg = *(const f32x4*)(g + i * 256 + lane * 4);
        u32x2 w; w.x = pk2(v[i][0] * rs * gg[0], v[i][1] * rs * gg[1]); w.y = pk2(v[i][2] * rs * gg[2], v[i][3] * rs * gg[3]);
        *(u32x2*)(hb + (size_t)t * LDH + i * 256 + lane * 4) = w;
      }
    }
  }
  {
    bf16_t* dk = (bf16_t*)(ws + W_D); const float* src = p.in[2];
    for (int u = gtid; u < 8 * PAST * 256; u += gthreads) {
      const int e = u * 4; const int row = e >> 10, c = e & 1023; const int b = row >> 11, j = row & 2047;
      f32x4 v = *(const f32x4*)(src + (size_t)e);
      u32x2 w; w.x = pk2(v[0], v[1]); w.y = pk2(v[2], v[3]);
      *(u32x2*)(dk + (size_t)(TP + b * LKS + j) * LDH + c) = w;
    }
    bf16_t* ck = (bf16_t*)(ws + W_G); const float* s2 = p.in[4];
    for (int u = gtid; u < 8 * PAST * 32; u += gthreads) {
      const int e = u * 4; const int row = e >> 7, c = e & 127; const int b = row >> 11, j = row & 2047;
      f32x4 v = *(const f32x4*)(s2 + (size_t)e);
      u32x2 w; w.x = pk2(v[0], v[1]); w.y = pk2(v[2], v[3]);
      *(u32x2*)(ck + (size_t)(TP + b * LKS + j) * LDK + c) = w;
    }
    bf16_t* kp = (bf16_t*)(ws + W_KPE); const float* s3 = p.in[5];
    for (int u = gtid; u < 8 * PAST * 8; u += gthreads) {
      const int e = u * 4; const int row = e >> 5, c = e & 31; const int b = row >> 11, j = row & 2047;
      f32x4 v = *(const f32x4*)(s3 + (size_t)e);
      u32x2 w; w.x = pk2(v[0], v[1]); w.y = pk2(v[2], v[3]);
      *(u32x2*)(kp + (size_t)(TP + b * LKS + j) * 32 + c) = w;
    }
  }
  {
    bf16_t* vt = (bf16_t*)(ws + W_D2 + SZ_VTP); const float* src = p.in[3];
    for (int u = gtid; u < 8 * 256 * 1024; u += gthreads) {
      const int c = u & 1023, pg = (u >> 10) & 255, b = u >> 18;
      const int p0 = pg * 8;
      float v[8];
#pragma unroll
      for (int i = 0; i < 8; ++i) { const int key = kperm(p0 + i); v[i] = src[((size_t)(b * PAST + key)) * 1024 + c]; }
      u32x4 w; w.x = pk2(v[0], v[1]); w.y = pk2(v[2], v[3]); w.z = pk2(v[4], v[5]); w.w = pk2(v[6], v[7]);
      *(u32x4*)(vt + ((size_t)(b * 1024 + c)) * LKS + p0) = w;
    }
  }
  {
    float2* rt = (float2*)(ws + W_ROPE);
    for (int u = gtid; u < 4096 * 16; u += gthreads) {
      const int pos = u >> 4, i = u & 15;
      const float inv = powf(10000.0f, -(float)i / 16.0f);
      const float ang = (float)pos * inv;
      rt[u] = make_float2(cosf(ang), sinf(ang));
    }
    float* misc = (float*)(ws + W_MISC);
    if (gw == 0) {
      const float* lp = p.in[9];
      float a = lp[lane] * lp[64 + lane], b = lp[128 + lane] * lp[192 + lane];
      a = wave_sum(a); b = wave_sum(b);
      if (lane == 0) misc[0] = expf(a) - expf(b) + 0.2f;
    }
    for (int u = gtid; u < 8 * 192; u += gthreads) {
      const int h = u / 192, idx = u % 192; const int rel = idx - 128;
      const int n = rel < 0 ? -rel : rel;
      int bucket = rel > 0 ? 16 : 0;
      if (n < 8) bucket += n;
      else { int lg = 8 + (n >= 12) + (n >= 16) + (n >= 23) + (n >= 32) + (n >= 46) + (n >= 64) + (n >= 91); bucket += lg > 15 ? 15 : lg; }
      misc[64 + u] = (p.in[6][bucket * 8 + h] - p.in[6][15 * 8 + h]) * LOG2E;
    }
  }
}

__device__ void phase_inproj(const Params& p, char* lds) {
  char* ws = p.ws;
  const bf16_t* hb = (const bf16_t*)(ws + W_B); const bf16_t* wt = (const bf16_t*)(ws + W_WIN);
  const int lane = threadIdx.x & 63, wid = threadIdx.x >> 6, wr = wid >> 1, wc = wid & 1, hh = lane >> 5, l31 = lane & 31;
  for (int it = 0;; ++it) {
    int mt, nt; if (!tile_at(260, 44, it, mt, nt)) break;
    const int m0 = mt * 128, n0 = nt * 128;
    f32x16 acc[2][2]; zero_acc(acc);
    const bool samp = (m0 >= TP);
    if (nt >= 16 && nt < 24) {
      gemm_mainloop<false>(hb + (size_t)m0 * LDH, LDH, wt + (size_t)n0 * LDH, LDH, DM, acc, lds, 2 * ((mt + nt) & 7));
#pragma unroll
      for (int i = 0; i < 2; ++i)
#pragma unroll
        for (int j = 0; j < 2; ++j) {
          const int mb = m0 + wr * 64 + i * 32; const int nn = n0 - 2048 + wc * 64 + j * 32 + l31;
          float* o = (samp ? p.out + O_VS + (size_t)(mb - TP) * 1024 : p.out + O_VP + (size_t)mb * 1024) + nn;
#pragma unroll
          for (int r = 0; r < 16; ++r) o[(size_t)accrow(r, hh) * 1024] = acc[i][j][r];
          bf16_t* vt; int key32;
          if (!samp) { const int b = mb >> 12; vt = (bf16_t*)(ws + W_D2) + ((size_t)(b * 1024 + nn)) * SEQP; key32 = mb & 4095; }
          else { const int ts = mb - TP; const int b = ts >> 6; vt = (bf16_t*)(ws + W_D2 + SZ_VTP) + ((size_t)(b * 1024 + nn)) * LKS; key32 = PAST + (ts & 63); }
          vt_store(vt, key32, acc[i][j], hh);
        }
      continue;
    }
    gemm_mainloop<true>(hb + (size_t)m0 * LDH, LDH, wt + (size_t)n0 * LDH, LDH, DM, acc, lds, 2 * ((mt + nt) & 7));
#pragma unroll
    for (int i = 0; i < 2; ++i)
#pragma unroll
      for (int j = 0; j < 2; ++j) {
        const int tok = m0 + wr * 64 + i * 32 + l31; const int cb = n0 + wc * 64 + j * 32;
        if (nt < 8) {
          st_bf16_sw((bf16_t*)(ws + W_C) + (size_t)tok * LDH + cb, acc[i][j], hh, 0.125f * LOG2E);
        } else if (nt < 16) {
          st_f32_sw((samp ? p.out + O_KS + (size_t)(tok - TP) * 1024 : p.out + O_KP + (size_t)tok * 1024) + (cb - 1024), acc[i][j], hh);
          st_bf16_sw((bf16_t*)(ws + W_D) + (size_t)keyrow_of_token(tok) * LDH + (cb - 1024), acc[i][j], hh, 1.f);
        } else if (nt < 26) {
          st_f32_sw((float*)(ws + F_ZCQ) + (size_t)tok * 256 + (cb - 3072), acc[i][j], hh);
        } else if (nt == 26) {
          st_f32_sw((float*)(ws + F_ZCKV) + (size_t)tok * 128 + (cb - 3328), acc[i][j], hh);
        } else if (nt == 27) {
          if (cb == 3456) st_f32_sw((float*)(ws + F_ZKR) + (size_t)tok * 32, acc[i][j], hh);
        } else {
          f32x16 sg;
#pragma unroll
          for (int r = 0; r < 16; ++r) sg[r] = __builtin_amdgcn_rcpf(1.f + __expf(-acc[i][j][r]));
          st_bf16_sw((bf16_t*)(p.out + O_Y) + (size_t)tok * 2048 + (cb - 3584), sg, hh, 1.f);
        }
      }
  }
}

__device__ void phase_small(const Params& p) {
  char* ws = p.ws;
  const int gw = (blockIdx.x * 256 + threadIdx.x) >> 6, nw = (gridDim.x * 256) >> 6, lane = threadIdx.x & 63;
  const float* zcq = (const float*)(ws + F_ZCQ); const float* zckv = (const float*)(ws + F_ZCKV); const float* zkr = (const float*)(ws + F_ZKR);
  bf16_t* cq = (bf16_t*)(ws + F_CQ); bf16_t* ckva = (bf16_t*)(ws + W_G); bf16_t* kpea = (bf16_t*)(ws + W_KPE);
  const float2* rt = (const float2*)(ws + W_ROPE);
  for (int t = gw; t < T; t += nw) {
    {
      f32x4 v = *(const f32x4*)(zcq + (size_t)t * 256 + lane * 4);
      float ss = wave_sum(v[0] * v[0] + v[1] * v[1] + v[2] * v[2] + v[3] * v[3]);
      const float rs = rsqrtf(ss * (1.f / 256.f) + EPS);
      f32x4 g = *(const f32x4*)(p.in[11] + lane * 4);
      u32x2 w; w.x = pk2(v[0] * rs * g[0], v[1] * rs * g[1]); w.y = pk2(v[2] * rs * g[2], v[3] * rs * g[3]);
      *(u32x2*)(cq + (size_t)t * LDQ + lane * 4) = w;
    }
    const int kr = keyrow_of_token(t);
    {
      float2 v = *(const float2*)(zckv + (size_t)t * 128 + lane * 2);
      float ss = wave_sum(v.x * v.x + v.y * v.y);
      const float rs = rsqrtf(ss * (1.f / 128.f) + EPS);
      float2 g = *(const float2*)(p.in[13] + lane * 2);
      const float a = v.x * rs * g.x, b = v.y * rs * g.y;
      float* o = (t < TP) ? p.out + O_CP + (size_t)t * 128 : p.out + O_CS + (size_t)(t - TP) * 128;
      *(float2*)(o + lane * 2) = make_float2(a, b);
      *(unsigned*)(ckva + (size_t)kr * LDK + lane * 2) = pk2(a, b);
    }
    {
      const int pos = (t < TP) ? (t & 4095) : (PAST + ((t - TP) & 63));
      const int i = lane & 15;
      const float x1 = zkr[(size_t)t * 32 + i], x2 = zkr[(size_t)t * 32 + 16 + i];
      const float2 cs = rt[pos * 16 + i];
      const float r = (lane < 16) ? (x1 * cs.x - x2 * cs.y) : (x1 * cs.y + x2 * cs.x);
      if (lane < 32) {
        float* o = (t < TP) ? p.out + O_EP + (size_t)t * 32 : p.out + O_ES + (size_t)(t - TP) * 32;
        o[lane] = r; kpea[(size_t)kr * 32 + lane] = f2bf(r);
      }
    }
  }
}

template <int MODE>
__device__ void attn_item(const Params& p, char* lds, int grp  , int b, int h, int qblk, int dry) {
  constexpr int DQ = MODE == 0 ? 64 : 96;
  constexpr int KROW = MODE == 0 ? 128 : 96;
  constexpr int KSTR = MODE == 0 ? 272 : 208;
  constexpr int DV = MODE == 0 ? 128 : 64;
  constexpr int NH = MODE == 0 ? 8 : 16;
  constexpr int KBYTES = 64 * KSTR;
  constexpr int BUF = KBYTES + DV * 144;
  constexpr int KCH = KROW / 8;
  constexpr int NKC = 64 * KCH / 256;
  constexpr int NVC = DV * 8 / 256;
  char* ws = p.ws;
  const int tid = threadIdx.x, lane = tid & 63, wid = tid >> 6, hh = lane >> 5, l31 = lane & 31;
  const int qsub = MODE == 0 ? (wid >> 1) : wid;
  const int comp = MODE == 0 ? (wid & 1) : 0;
  const int QB = MODE == 0 ? 64 : 128;
  const int Lk = grp == 0 ? SEQP : LKS;
  const int tok0 = grp == 0 ? (b * SEQ + qblk * QB) : (TP + b * 64);
  const int qpos0 = grp == 0 ? qblk * QB : PAST;
  const int krow0 = grp == 0 ? b * SEQ : TP + b * LKS;
  int nkt;
  if (grp == 0) nkt = MODE == 0 ? (qblk + 1) : (2 * qblk + 2); else nkt = 33;
  int my_last = nkt - 1; bool active = true;
  if (MODE == 1) { if (grp == 0) my_last = 2 * qblk + (wid >> 1); else active = (wid < 2); }
  const int qtok = tok0 + qsub * 32 + l31;
  const int qpos = qpos0 + qsub * 32 + l31;

  bf16x8 qf[DQ / 16];
  if (MODE == 0) {
    const bf16_t* q = (const bf16_t*)(ws + W_C) + (size_t)qtok * LDH + h * 128 + comp * 64 + hh * 8;
#pragma unroll
    for (int ks = 0; ks < 4; ++ks) qf[ks] = *(const bf16x8*)(q + ks * 16);
  } else {
    const int qt = active ? qtok : tok0;
    const bf16_t* q = (const bf16_t*)(ws + W_B) + (size_t)qt * LDH + h * 64 + hh * 8;
#pragma unroll
    for (int ks = 0; ks < 4; ++ks) qf[ks] = *(const bf16x8*)(q + ks * 16);
    const bf16_t* qp = (const bf16_t*)(ws + F_ZCQ) + (size_t)qt * 512 + h * 32 + hh * 8;
    bf16x8 a = *(const bf16x8*)(qp), c = *(const bf16x8*)(qp + 16);
    const float2* rt = (const float2*)(ws + W_ROPE) + (size_t)(active ? qpos : qpos0) * 16 + hh * 8;
    float o1[8], o2[8];
#pragma unroll
    for (int j = 0; j < 8; ++j) {
      const float x1 = bf2f((bf16_t)a[j]), x2 = bf2f((bf16_t)c[j]); const float2 cs = rt[j];
      o1[j] = x1 * cs.x - x2 * cs.y; o2[j] = x1 * cs.y + x2 * cs.x;
    }
    u32x4 w1, w2;
    w1.x = pk2(o1[0], o1[1]); w1.y = pk2(o1[2], o1[3]); w1.z = pk2(o1[4], o1[5]); w1.w = pk2(o1[6], o1[7]);
    w2.x = pk2(o2[0], o2[1]); w2.y = pk2(o2[2], o2[3]); w2.z = pk2(o2[4], o2[5]); w2.w = pk2(o2[6], o2[7]);
    qf[4] = __builtin_bit_cast(bf16x8, w1); qf[5] = __builtin_bit_cast(bf16x8, w2);
  }

  const bf16_t* kg; const bf16_t* kpe; const bf16_t* vg;
  if (MODE == 0) {
    kg = (const bf16_t*)(ws + W_D) + (size_t)krow0 * LDH + h * 128;
    kpe = nullptr;
    vg = grp == 0 ? (const bf16_t*)(ws + W_D2) + (size_t)(b * 1024 + h * 128) * SEQP : (const bf16_t*)(ws + W_D2 + SZ_VTP) + (size_t)(b * 1024 + h * 128) * LKS;
  } else {
    kg = (const bf16_t*)(ws + W_D) + (size_t)krow0 * LDH + h * 64;
    kpe = (const bf16_t*)(ws + W_KPE) + (size_t)krow0 * 32;
    vg = grp == 0 ? (const bf16_t*)(ws + W_D2) + (size_t)(b * 1024 + h * 64) * SEQP : (const bf16_t*)(ws + W_D2 + SZ_VTP) + (size_t)(b * 1024 + h * 64) * LKS;
  }
  u32x4 rk[NKC], rv[NVC];
  int koff[NKC], voff[NVC];
#pragma unroll
  for (int i = 0; i < NKC; ++i) { const int q = tid + 256 * i; koff[i] = (q / KCH) * LDH + (q % KCH) * 8; }
#pragma unroll
  for (int i = 0; i < NVC; ++i) { const int q = tid + 256 * i; voff[i] = (q >> 3) * Lk + (q & 7) * 8; }
  auto gloadK = [&](int kt) {
    const bf16_t* ktile = kg + (size_t)kt * 64 * LDH;
#pragma unroll
    for (int i = 0; i < NKC; ++i) {
      if (MODE == 0) rk[i] = *(const u32x4*)(ktile + koff[i]);
      else {
        const int q = tid + 256 * i; const int row = q / KCH, ch = q % KCH;
        const bf16_t* src = (ch < 8) ? kg + (size_t)(kt * 64 + row) * LDH + ch * 8 : kpe + (size_t)(kt * 64 + row) * 32 + (ch - 8) * 8;
        rk[i] = *(const u32x4*)src;
      }
    }
  };
  auto gloadV = [&](int kt) {
    const bf16_t* vtile = vg + kt * 64;
#pragma unroll
    for (int i = 0; i < NVC; ++i) rv[i] = *(const u32x4*)(vtile + voff[i]);
  };
  auto lwriteK = [&](int buf) {
    char* base = lds + buf * BUF;
#pragma unroll
    for (int i = 0; i < NKC; ++i) { const int q = tid + 256 * i; const int row = q / KCH, ch = q % KCH; *(u32x4*)(base + row * KSTR + ch * 16) = rk[i]; }
  };
  auto lwriteV = [&](int buf) {
    char* base = lds + buf * BUF;
#pragma unroll
    for (int i = 0; i < NVC; ++i) { const int q = tid + 256 * i; const int row = q >> 3, ch = q & 7; *(u32x4*)(base + KBYTES + row * 144 + ch * 16) = rv[i]; }
  };

  f32x16 O[DV / 32];
#pragma unroll
  for (int i = 0; i < DV / 32; ++i)
#pragma unroll
    for (int r = 0; r < 16; ++r) O[i][r] = 0.f;
  float m = -1e30f, l = 0.f;
  const float* btab = (const float*)(ws + W_MISC) + 64 + h * 192;
  __shared__ float s_bt[192];
  if (MODE == 0 && tid < 192) s_bt[tid] = btab[tid];

  gloadK(0); gloadV(0); lwriteK(0); lwriteV(0);
  __syncthreads();
  for (int kt = 0; kt < nkt; ++kt) {
    const bool more = (kt + 1 < nkt);
    if (more) { gloadK(kt + 1); if (MODE == 1) gloadV(kt + 1); }
    if (active && kt <= my_last) {
      const char* base = lds + (kt & 1) * BUF;
      f32x16 S[2];
      const char* kp0 = base + l31 * KSTR + comp * 128 + hh * 16;
#pragma unroll
      for (int sub = 0; sub < 2; ++sub) {
#pragma unroll
        for (int r = 0; r < 16; ++r) S[sub][r] = 0.f;
#pragma unroll
        for (int ks = 0; ks < DQ / 16; ++ks) {
          bf16x8 kf = *(const bf16x8*)(kp0 + sub * 32 * KSTR + ks * 32);
          S[sub] = mfma32(kf, qf[ks], S[sub]);
        }
      }
      if (MODE == 0) {
        const int kpos0 = kt * 64;
        if (kpos0 + 63 > qpos0 - 91) {
#pragma unroll
          for (int sub = 0; sub < 2; ++sub)
#pragma unroll
            for (int r = 0; r < 16; ++r) {
              int rel = kpos0 + sub * 32 + accrow(r, hh) - qpos; rel = rel < -128 ? -128 : rel;
              S[sub][r] += s_bt[rel + 128];
            }
        }
      }
      __builtin_amdgcn_sched_barrier(0);
      float mx = S[0][0];
#pragma unroll
      for (int sub = 0; sub < 2; ++sub)
#pragma unroll
        for (int r = 0; r < 16; ++r) mx = fmaxf(mx, S[sub][r]);
      if (__any(mx > m + 8.0f)) {
        mx = fmaxf(mx, __shfl_xor(mx, 32));
        const float mn = fmaxf(m, mx);
        const float alpha = __builtin_amdgcn_exp2f(m - mn);
        m = mn; l *= alpha;
#pragma unroll
        for (int i = 0; i < DV / 32; ++i)
#pragma unroll
          for (int r = 0; r < 16; ++r) O[i][r] *= alpha;
      }
      f32v2_t ps2 = {0.f, 0.f}; const f32v2_t m2 = {m, m};
#pragma unroll
      for (int sub = 0; sub < 2; ++sub)
#pragma unroll
        for (int r = 0; r < 16; r += 2) {
          f32v2_t v = (f32v2_t){S[sub][r], S[sub][r + 1]} - m2;
          v[0] = __builtin_amdgcn_exp2f(v[0]); v[1] = __builtin_amdgcn_exp2f(v[1]);
          S[sub][r] = v[0]; S[sub][r + 1] = v[1]; ps2 += v;
        }
      l += ps2[0] + ps2[1];
      if (MODE == 0 && more) { lwriteK((kt + 1) & 1); gloadV(kt + 1); }
      const char* vp0 = base + KBYTES + l31 * 144 + hh * 16;
#pragma unroll
      for (int sub = 0; sub < 2; ++sub)
#pragma unroll
        for (int s = 0; s < 2; ++s) {
          u32x4 w;
          w.x = pk2(S[sub][8 * s + 0], S[sub][8 * s + 1]); w.y = pk2(S[sub][8 * s + 2], S[sub][8 * s + 3]);
          w.z = pk2(S[sub][8 * s + 4], S[sub][8 * s + 5]); w.w = pk2(S[sub][8 * s + 6], S[sub][8 * s + 7]);
          const bf16x8 pf = __builtin_bit_cast(bf16x8, w);
          __builtin_amdgcn_sched_barrier(0);
#pragma unroll
          for (int blk = 0; blk < DV / 32; ++blk) {
            bf16x8 vf = *(const bf16x8*)(vp0 + blk * 32 * 144 + sub * 64 + s * 32);
            O[blk] = mfma32(vf, pf, O[blk]);
          }
        }
    }
    if (more) { if (MODE == 1) lwriteK((kt + 1) & 1); lwriteV((kt + 1) & 1); }
    __syncthreads();
  }
  const float lt = l + __shfl_xor(l, 32);
  const float inv = 1.f / lt;
  if (MODE == 0) {
    float* xch = (float*)lds;
    const float lam = ((const float*)(ws + W_MISC))[0];
    if (comp == 1) {
#pragma unroll
      for (int blk = 0; blk < 4; ++blk)
#pragma unroll
        for (int r = 0; r < 16; ++r) xch[(qsub * 32 + l31) * 132 + blk * 32 + accrow(r, hh)] = O[blk][r] * inv * lam;
    }
    __syncthreads();
    if (comp == 0 && !dry) {
      float ss = 0.f;
#pragma unroll
      for (int blk = 0; blk < 4; ++blk)
#pragma unroll
        for (int r = 0; r < 16; ++r) { const float v = O[blk][r] * inv - xch[(qsub * 32 + l31) * 132 + blk * 32 + accrow(r, hh)]; O[blk][r] = v; ss += v * v; }
      ss += __shfl_xor(ss, 32);
      const float rs = rsqrtf(ss * (1.f / 128.f) + EPS) * 0.8f;
      bf16_t* o = (bf16_t*)(ws + W_C) + (size_t)qtok * LDH + h * 128;
      const float* sg = p.in[10];
#pragma unroll
      for (int blk = 0; blk < 4; ++blk)
#pragma unroll
        for (int g = 0; g < 4; ++g) {
          const int dv = blk * 32 + 8 * g + 4 * hh;
          f32x4 gg = *(const f32x4*)(sg + dv);
          u32x2 w; w.x = pk2(O[blk][4 * g] * rs * gg[0], O[blk][4 * g + 1] * rs * gg[1]); w.y = pk2(O[blk][4 * g + 2] * rs * gg[2], O[blk][4 * g + 3] * rs * gg[3]);
          *(u32x2*)(o + dv) = w;
        }
    }
    __syncthreads();
  } else {
    if (active && !dry) {
      bf16_t* o = (bf16_t*)(ws + W_B) + (size_t)qtok * LDH + h * 64;
#pragma unroll
      for (int blk = 0; blk < 2; ++blk)
#pragma unroll
        for (int g = 0; g < 4; ++g) {
          const int dv = blk * 32 + 8 * g + 4 * hh;
          u32x2 w; w.x = pk2(O[blk][4 * g] * inv, O[blk][4 * g + 1] * inv); w.y = pk2(O[blk][4 * g + 2] * inv, O[blk][4 * g + 3] * inv);
          *(u32x2*)(o + dv) = w;
        }
    }
  }
}

__device__ void attn_item_mla(const Params& p, char* lds, int grp, int b, int h, int qblk, int dry) {
  constexpr int KSTR = 208, KBYTES = 64 * KSTR, BUF = KBYTES + 64 * 144;
  char* ws = p.ws;
  int tid = threadIdx.x; asm volatile("" : "+v"(tid));
  const int lane = tid & 63, wid = tid >> 6, hh = lane >> 5, l31 = lane & 31;
  const int Lk = grp == 0 ? SEQP : LKS;
  const int tok0 = grp == 0 ? (b * SEQ + qblk * 256) : (TP + b * 64);
  const int qpos0 = grp == 0 ? qblk * 256 : PAST;
  const int krow0 = grp == 0 ? b * SEQ : TP + b * LKS;
  const int nkt = grp == 0 ? (4 * qblk + 4) : 33;
  const int my_last = grp == 0 ? (4 * qblk + wid) : 32;
  const bool active = grp == 0 ? true : (wid == 0);
  bf16x8 qf[2][6];
#pragma unroll
  for (int qs = 0; qs < 2; ++qs) {
    const int qt = active ? tok0 + wid * 64 + qs * 32 + l31 : tok0;
    const int qp = active ? qpos0 + wid * 64 + qs * 32 + l31 : qpos0;
    const bf16_t* q = (const bf16_t*)(ws + W_B) + (size_t)qt * LDH + h * 64 + hh * 8;
#pragma unroll
    for (int ks = 0; ks < 4; ++ks) qf[qs][ks] = *(const bf16x8*)(q + ks * 16);
    const bf16_t* qpe = (const bf16_t*)(ws + F_ZCQ) + (size_t)qt * 512 + h * 32 + hh * 8;
    const bf16x8 a = *(const bf16x8*)(qpe), c = *(const bf16x8*)(qpe + 16);
    const float2* rt = (const float2*)(ws + W_ROPE) + (size_t)qp * 16 + hh * 8;
    float o1[8], o2[8];
#pragma unroll
    for (int j = 0; j < 8; ++j) {
      const float x1 = bf2f((bf16_t)a[j]), x2 = bf2f((bf16_t)c[j]); const float2 cs = rt[j];
      o1[j] = x1 * cs.x - x2 * cs.y; o2[j] = x1 * cs.y + x2 * cs.x;
    }
    u32x4 w1, w2;
    w1.x = pk2(o1[0], o1[1]); w1.y = pk2(o1[2], o1[3]); w1.z = pk2(o1[4], o1[5]); w1.w = pk2(o1[6], o1[7]);
    w2.x = pk2(o2[0], o2[1]); w2.y = pk2(o2[2], o2[3]); w2.z = pk2(o2[4], o2[5]); w2.w = pk2(o2[6], o2[7]);
    qf[qs][4] = __builtin_bit_cast(bf16x8, w1); qf[qs][5] = __builtin_bit_cast(bf16x8, w2);
  }
  const bf16_t* kg = (const bf16_t*)(ws + W_D) + (size_t)krow0 * LDH + h * 64;
  const bf16_t* kpe = (const bf16_t*)(ws + W_KPE) + (size_t)krow0 * 32;
  const bf16_t* vg = grp == 0 ? (const bf16_t*)(ws + W_D2) + (size_t)(b * 1024 + h * 64) * SEQP : (const bf16_t*)(ws + W_D2 + SZ_VTP) + (size_t)(b * 1024 + h * 64) * LKS;
  u32x4 rk[3], rv[2];
  auto gload = [&](int kt) {
#pragma unroll
    for (int i = 0; i < 3; ++i) {
      const int q = tid + 256 * i; const int row = q / 12, ch = q % 12;
      const bf16_t* src = (ch < 8) ? kg + (size_t)(kt * 64 + row) * LDH + ch * 8 : kpe + (size_t)(kt * 64 + row) * 32 + (ch - 8) * 8;
      rk[i] = *(const u32x4*)src;
    }
#pragma unroll
    for (int i = 0; i < 2; ++i) { const int q = tid + 256 * i; const int row = q >> 3, ch = q & 7; rv[i] = *(const u32x4*)(vg + (size_t)row * Lk + kt * 64 + ch * 8); }
  };
  auto lwrite = [&](int buf) {
    char* base = lds + buf * BUF;
#pragma unroll
    for (int i = 0; i < 3; ++i) { const int q = tid + 256 * i; const int row = q / 12, ch = q % 12; *(u32x4*)(base + row * KSTR + ch * 16) = rk[i]; }
#pragma unroll
    for (int i = 0; i < 2; ++i) { const int q = tid + 256 * i; const int row = q >> 3, ch = q & 7; *(u32x4*)(base + KBYTES + row * 144 + ch * 16) = rv[i]; }
  };
  f32x16 O[2][2];
#pragma unroll
  for (int qs = 0; qs < 2; ++qs)
#pragma unroll
    for (int i = 0; i < 2; ++i)
#pragma unroll
      for (int r = 0; r < 16; ++r) O[qs][i][r] = 0.f;
  float m[2] = {-1e30f, -1e30f}, l[2] = {0.f, 0.f};
  gload(0); lwrite(0);
  __syncthreads();
  for (int kt = 0; kt < nkt; ++kt) {
    const bool more = (kt + 1 < nkt);
    if (more) gload(kt + 1);
    if (active && kt <= my_last) {
      const char* base = lds + (kt & 1) * BUF;
      const char* kp0 = base + l31 * KSTR + hh * 16;
      const char* vp0 = base + KBYTES + l31 * 144 + hh * 16;
#pragma unroll 1
      for (int sub = 0; sub < 2; ++sub) {
        f32x16 S[2];
#pragma unroll
        for (int r = 0; r < 16; ++r) { S[0][r] = 0.f; S[1][r] = 0.f; }
#pragma unroll
        for (int ks = 0; ks < 6; ++ks) {
          const bf16x8 kf = *(const bf16x8*)(kp0 + sub * 32 * KSTR + ks * 32);
          S[0] = mfma32(kf, qf[0][ks], S[0]);
          S[1] = mfma32(kf, qf[1][ks], S[1]);
        }
#pragma unroll
        for (int qs = 0; qs < 2; ++qs) {
          float mx = S[qs][0];
#pragma unroll
          for (int r = 1; r < 16; ++r) mx = fmaxf(mx, S[qs][r]);
          if (__any(mx > m[qs] + 8.0f)) {
            mx = fmaxf(mx, __shfl_xor(mx, 32));
            const float mn = fmaxf(m[qs], mx);
            const float alpha = __builtin_amdgcn_exp2f(m[qs] - mn);
            m[qs] = mn; l[qs] *= alpha;
#pragma unroll
            for (int i = 0; i < 2; ++i)
#pragma unroll
              for (int r = 0; r < 16; ++r) O[qs][i][r] *= alpha;
          }
          f32v2_t ps2 = {0.f, 0.f}; const f32v2_t m2 = {m[qs], m[qs]};
#pragma unroll
          for (int r = 0; r < 16; r += 2) {
            f32v2_t v = (f32v2_t){S[qs][r], S[qs][r + 1]} - m2;
            v[0] = __builtin_amdgcn_exp2f(v[0]); v[1] = __builtin_amdgcn_exp2f(v[1]);
            S[qs][r] = v[0]; S[qs][r + 1] = v[1]; ps2 += v;
          }
          l[qs] += ps2[0] + ps2[1];
        }
#pragma unroll
        for (int s2 = 0; s2 < 2; ++s2) {
          u32x4 w0, w1;
          w0.x = pk2(S[0][8 * s2 + 0], S[0][8 * s2 + 1]); w0.y = pk2(S[0][8 * s2 + 2], S[0][8 * s2 + 3]);
          w0.z = pk2(S[0][8 * s2 + 4], S[0][8 * s2 + 5]); w0.w = pk2(S[0][8 * s2 + 6], S[0][8 * s2 + 7]);
          w1.x = pk2(S[1][8 * s2 + 0], S[1][8 * s2 + 1]); w1.y = pk2(S[1][8 * s2 + 2], S[1][8 * s2 + 3]);
          w1.z = pk2(S[1][8 * s2 + 4], S[1][8 * s2 + 5]); w1.w = pk2(S[1][8 * s2 + 6], S[1][8 * s2 + 7]);
          const bf16x8 pf0 = __builtin_bit_cast(bf16x8, w0), pf1 = __builtin_bit_cast(bf16x8, w1);
#pragma unroll
          for (int blk = 0; blk < 2; ++blk) {
            const bf16x8 vf = *(const bf16x8*)(vp0 + blk * 32 * 144 + sub * 64 + s2 * 32);
            O[0][blk] = mfma32(vf, pf0, O[0][blk]);
            O[1][blk] = mfma32(vf, pf1, O[1][blk]);
          }
        }
      }
    }
    if (more) lwrite((kt + 1) & 1);
    __syncthreads();
  }
  if (active && !dry) {
#pragma unroll
    for (int qs = 0; qs < 2; ++qs) {
      const float lt = l[qs] + __shfl_xor(l[qs], 32);
      const float inv = 1.f / lt;
      const int qtok = tok0 + wid * 64 + qs * 32 + l31;
      bf16_t* o = (bf16_t*)(ws + W_B) + (size_t)qtok * LDH + h * 64;
#pragma unroll
      for (int blk = 0; blk < 2; ++blk)
#pragma unroll
        for (int g = 0; g < 4; ++g) {
          const int dv = blk * 32 + 8 * g + 4 * hh;
          u32x2 w; w.x = pk2(O[qs][blk][4 * g] * inv, O[qs][blk][4 * g + 1] * inv); w.y = pk2(O[qs][blk][4 * g + 2] * inv, O[qs][blk][4 * g + 3] * inv);
          *(u32x2*)(o + dv) = w;
        }
    }
  }
}

__device__ void phase_attn_diff(const Params& p, char* lds, int* s_item, int dry) {
  const int x = blockIdx.x & 7;
  const int total = 512 + 8;
  unsigned* q = (unsigned*)(p.ws + W_BAR) + QW + dry * 8 + x;
  for (;;) {
    if (threadIdx.x == 0) *s_item = (int)__hip_atomic_fetch_add(q, 1u, __ATOMIC_RELAXED, __HIP_MEMORY_SCOPE_AGENT);
    __syncthreads();
    const int u = *s_item;
    __syncthreads();
    if (u >= total) break;
    int grp = 0, bh, qblk = 0;
    if (u < 256) { qblk = 63 - (u >> 3); bh = (u & 7) * 8 + x; }
    else if (u < 264) { grp = 1; bh = (u - 256) * 8 + x; }
    else { const int v = u - 8; qblk = 63 - (v >> 3); bh = (v & 7) * 8 + x; }
    attn_item<0>(p, lds, grp, bh >> 3, bh & 7, qblk, dry);
  }
}
__device__ void phase_attn_mla(const Params& p, char* lds, int* s_item, int dry) {
  const int x = blockIdx.x & 7;
  const int total = 256 + 16;
  unsigned* q = (unsigned*)(p.ws + W_BAR) + QW + 16 + dry * 8 + x;
  for (;;) {
    if (threadIdx.x == 0) *s_item = (int)__hip_atomic_fetch_add(q, 1u, __ATOMIC_RELAXED, __HIP_MEMORY_SCOPE_AGENT);
    __syncthreads();
    const int u = *s_item;
    __syncthreads();
    if (u >= total) break;
    int grp = 0, bh, qblk = 0;
    if (u < 128) { qblk = 15 - (u >> 4); bh = (u & 15) * 8 + x; }
    else if (u < 144) { grp = 1; bh = (u - 128) * 8 + x; }
    else { const int v = u - 16; qblk = 15 - (v >> 4); bh = (v & 15) * 8 + x; }
    attn_item_mla(p, lds, grp, bh >> 4, bh & 15, qblk, dry);
  }
}

__device__ void phase_mla_expand(const Params& p, char* lds) {
  char* ws = p.ws;
  const int lane = threadIdx.x & 63, wid = threadIdx.x >> 6, wr = wid >> 1, wc = wid & 1, hh = lane >> 5, l31 = lane & 31;
  for (int it = 0, setB = 0;; ++it) {
    int mt, nt;
    if (!setB) { if (!tile_at(260, 12, it, mt, nt)) { setB = 1; it = -1; continue; } }
    else if (!tile_at(388, 16, it, mt, nt)) break;
    f32x16 acc[2][2]; zero_acc(acc);
    const int m0 = mt * 128, n0 = nt * 128;
    if (!setB) {
      gemm_mainloop<true>((const bf16_t*)(ws + F_CQ) + (size_t)m0 * LDQ, LDQ, (const bf16_t*)(ws + W_WUQ) + (size_t)n0 * LDQ, LDQ, 256, acc, lds, 2 * ((mt + nt) & 7));
      const float sc = 0.10206207261596577f * LOG2E;
#pragma unroll
      for (int i = 0; i < 2; ++i)
#pragma unroll
        for (int j = 0; j < 2; ++j) {
          const int tok = m0 + wr * 64 + i * 32 + l31; const int cb = n0 + wc * 64 + j * 32;
          if (nt < 8) st_bf16_sw((bf16_t*)(ws + W_B) + (size_t)tok * LDH + cb, acc[i][j], hh, sc);
          else st_bf16_sw((bf16_t*)(ws + F_ZCQ) + (size_t)tok * 512 + (cb - 1024), acc[i][j], hh, sc);
        }
    } else if (nt < 8) {
      gemm_mainloop<true>((const bf16_t*)(ws + W_G) + (size_t)m0 * LDK, LDK, (const bf16_t*)(ws + W_WUKV) + (size_t)n0 * LDK, LDK, 128, acc, lds, 2 * ((mt + nt) & 7));
#pragma unroll
      for (int i = 0; i < 2; ++i)
#pragma unroll
        for (int j = 0; j < 2; ++j) {
          const int row = m0 + wr * 64 + i * 32 + l31; const int cb = n0 + wc * 64 + j * 32;
          st_bf16_sw((bf16_t*)(ws + W_D) + (size_t)row * LDH + cb, acc[i][j], hh, 1.f);
        }
    } else {
      gemm_mainloop<false>((const bf16_t*)(ws + W_G) + (size_t)m0 * LDK, LDK, (const bf16_t*)(ws + W_WUKV) + (size_t)n0 * LDK, LDK, 128, acc, lds, 2 * ((mt + nt) & 7));
#pragma unroll
      for (int i = 0; i < 2; ++i)
#pragma unroll
        for (int j = 0; j < 2; ++j) {
          const int mb = m0 + wr * 64 + i * 32; const int nn = n0 - 1024 + wc * 64 + j * 32 + l31;
          bf16_t* vt; int key32;
          if (mb < TP) { const int b = mb >> 12; vt = (bf16_t*)(ws + W_D2) + ((size_t)(b * 1024 + nn)) * SEQP; key32 = mb & 4095; }
          else { const int x = mb - TP; const int b = x / LKS; vt = (bf16_t*)(ws + W_D2 + SZ_VTP) + ((size_t)(b * 1024 + nn)) * LKS; key32 = x - b * LKS; }
          vt_store(vt, key32, acc[i][j], hh);
        }
    }
  }
}

__device__ void phase_merge(const Params& p, char* lds) {
  char* ws = p.ws;
  const int lane = threadIdx.x & 63, wid = threadIdx.x >> 6, wr = wid >> 1, wc = wid & 1, hh = lane >> 5, l31 = lane & 31;
  const bf16_t* gates = (const bf16_t*)(p.out + O_Y);
  bf16_t* mg = (bf16_t*)(ws + W_F);
  for (int it = 0;; ++it) {
    int mt, nt; if (!tile_at(260, 8, it, mt, nt)) break;
    const int m0 = mt * 128, n0 = nt * 128;
    {
      f32x16 acc[2][2]; zero_acc(acc);
      gemm_mainloop<true>((const bf16_t*)(ws + W_C) + (size_t)m0 * LDH, LDH, (const bf16_t*)(ws + W_WA) + (size_t)n0 * LDH, LDH, 1024, acc, lds, 2 * ((mt + nt) & 7));
#pragma unroll
      for (int i = 0; i < 2; ++i)
#pragma unroll
        for (int j = 0; j < 2; ++j) {
          const int tok = m0 + wr * 64 + i * 32 + l31; const int cb = n0 + wc * 64 + j * 32;
          const bf16_t* gp = gates + (size_t)tok * 2048 + cb + 4 * hh;
          bf16_t* op = mg + (size_t)tok * LDH + cb + 4 * hh;
#pragma unroll
          for (int g = 0; g < 4; ++g) {
            const u32x2 gv = *(const u32x2*)(gp + 8 * g);
            u32x2 w;
            w.x = pk2(acc[i][j][4 * g] * bflo(gv.x), acc[i][j][4 * g + 1] * bfhi(gv.x));
            w.y = pk2(acc[i][j][4 * g + 2] * bflo(gv.y), acc[i][j][4 * g + 3] * bfhi(gv.y));
            *(u32x2*)(op + 8 * g) = w;
          }
        }
    }
    {
      f32x16 acc[2][2]; zero_acc(acc);
      gemm_mainloop<true>((const bf16_t*)(ws + W_B) + (size_t)m0 * LDH, LDH, (const bf16_t*)(ws + W_WB) + (size_t)n0 * LDH, LDH, 1024, acc, lds, 2 * ((mt + nt) & 7));
      int l31b = l31; asm volatile("" : "+v"(l31b));
#pragma unroll
      for (int i = 0; i < 2; ++i)
#pragma unroll
        for (int j = 0; j < 2; ++j) {
          const int tok = m0 + wr * 64 + i * 32 + l31b; const int cb = n0 + wc * 64 + j * 32;
          const bf16_t* gp = gates + (size_t)tok * 2048 + 1024 + cb + 4 * hh;
          bf16_t* op = mg + (size_t)tok * LDH + cb + 4 * hh;
#pragma unroll
          for (int g = 0; g < 4; ++g) {
            const u32x2 gv = *(const u32x2*)(gp + 8 * g);
            const u32x2 pv = *(const u32x2*)(op + 8 * g);
            u32x2 w;
            w.x = pk2(bflo(pv.x) + acc[i][j][4 * g] * bflo(gv.x), bfhi(pv.x) + acc[i][j][4 * g + 1] * bfhi(gv.x));
            w.y = pk2(bflo(pv.y) + acc[i][j][4 * g + 2] * bflo(gv.y), bfhi(pv.y) + acc[i][j][4 * g + 3] * bfhi(gv.y));
            *(u32x2*)(op + 8 * g) = w;
          }
        }
    }
  }
}

__device__ void phase_outproj(const Params& p, char* lds) {
  char* ws = p.ws;
  const int lane = threadIdx.x & 63, wid = threadIdx.x >> 6, wr = wid >> 1, wc = wid & 1, hh = lane >> 5, l31 = lane & 31;
  float* x1 = (float*)(ws + D_X1);
  for (int it = 0;; ++it) {
    int mt, nt; if (!tile_at(260, 8, it, mt, nt)) break;
    const int m0 = mt * 128, n0 = nt * 128;
    f32x16 acc[2][2]; zero_acc(acc);
    gemm_mainloop<true>((const bf16_t*)(ws + W_F) + (size_t)m0 * LDH, LDH, (const bf16_t*)(ws + W_WO) + (size_t)n0 * LDH, LDH, 1024, acc, lds, 2 * ((mt + nt) & 7));
#pragma unroll
    for (int i = 0; i < 2; ++i)
#pragma unroll
      for (int j = 0; j < 2; ++j) {
        const int tok = m0 + wr * 64 + i * 32 + l31; const int cb = n0 + wc * 64 + j * 32 + 4 * hh;
        const float* xr = ((tok < TP) ? p.in[0] + (size_t)tok * 1024 : p.in[1] + (size_t)(tok - TP) * 1024) + cb;
        float* orow = x1 + (size_t)tok * 1024 + cb;
#pragma unroll
        for (int g = 0; g < 4; ++g) {
          const f32x4 xv = *(const f32x4*)(xr + 8 * g);
          f32x4 w = {xv[0] + acc[i][j][4 * g], xv[1] + acc[i][j][4 * g + 1], xv[2] + acc[i][j][4 * g + 2], xv[3] + acc[i][j][4 * g + 3]};
          *(f32x4*)(orow + 8 * g) = w;
        }
      }
  }
}

__device__ void phase_ffn_norm(const Params& p) {
  char* ws = p.ws;
  const int gtid = blockIdx.x * 256 + threadIdx.x, gthreads = gridDim.x * 256;
  const int gw = gtid >> 6, nw = gthreads >> 6, lane = threadIdx.x & 63;
  const float* x1 = (const float*)(ws + D_X1); bf16_t* hf = (bf16_t*)(ws + W_C); const float* g = p.in[19];
  for (int t = gw; t < T; t += nw) {
    const float* x = x1 + (size_t)t * DM;
    f32x4 v[4]; float ss = 0.f;
#pragma unroll
    for (int i = 0; i < 4; ++i) { v[i] = *(const f32x4*)(x + i * 256 + lane * 4); ss += v[i][0] * v[i][0] + v[i][1] * v[i][1] + v[i][2] * v[i][2] + v[i][3] * v[i][3]; }
    ss = wave_sum(ss);
    const float rs = rsqrtf(ss * (1.f / DM) + EPS);
#pragma unroll
    for (int i = 0; i < 4; ++i) {
      f32x4 gg = *(const f32x4*)(g + i * 256 + lane * 4);
      u32x2 w; w.x = pk2(v[i][0] * rs * gg[0], v[i][1] * rs * gg[1]); w.y = pk2(v[i][2] * rs * gg[2], v[i][3] * rs * gg[3]);
      *(u32x2*)(hf + (size_t)t * LDH + i * 256 + lane * 4) = w;
    }
  }
  unsigned char* q8 = (unsigned char*)(ws + W_F); float* qs = (float*)(ws + W_F + 33554432);
  for (int r = gw; r < 2 * 16384; r += nw) {
    const float* src = (r < 16384) ? p.in[22] + (size_t)r * DM : p.in[23] + (size_t)(r - 16384) * DM;
    f32x4 v[4]; float am = 0.f;
#pragma unroll
    for (int i = 0; i < 4; ++i) { v[i] = *(const f32x4*)(src + lane * 16 + i * 4); am = fmaxf(am, fmaxf(fmaxf(fabsf(v[i][0]), fabsf(v[i][1])), fmaxf(fabsf(v[i][2]), fabsf(v[i][3])))); }
#pragma unroll
    for (int o = 32; o >= 1; o >>= 1) am = fmaxf(am, __shfl_xor(am, o));
    const float sc = am > 0.f ? 224.f / am : 1.f;
    u32x4 w;
#pragma unroll
    for (int i = 0; i < 4; ++i) {
      int d = 0;
      d = __builtin_amdgcn_cvt_pk_fp8_f32(v[i][0] * sc, v[i][1] * sc, d, false);
      d = __builtin_amdgcn_cvt_pk_fp8_f32(v[i][2] * sc, v[i][3] * sc, d, true);
      w[i] = (unsigned)d;
    }
    *(u32x4*)(q8 + (r < 16384 ? (size_t)r * 2048 : (size_t)(r - 16384) * 2048 + 1024) + lane * 16) = w;
    if (lane == 0) qs[r] = am > 0.f ? am / 224.f : 1.f;
  }
}

__device__ void phase_peer_q(const Params& p, char* lds) {
  char* ws = p.ws;
  const int lane = threadIdx.x & 63, wid = threadIdx.x >> 6, wr = wid >> 1, wc = wid & 1, hh = lane >> 5, l31 = lane & 31;
  bf16_t* pq = (bf16_t*)(ws + W_B);
  for (int it = 0;; ++it) {
    int mt, nt; if (!tile_at(260, 8, it, mt, nt)) break;
    const int m0 = mt * 128, n0 = nt * 128;
    f32x16 acc[2][2]; zero_acc(acc);
    gemm_mainloop<true>((const bf16_t*)(ws + W_C) + (size_t)m0 * LDH, LDH, (const bf16_t*)(ws + W_WQ) + (size_t)n0 * LDH, LDH, 1024, acc, lds, 2 * ((mt + nt) & 7));
#pragma unroll
    for (int i = 0; i < 2; ++i)
#pragma unroll
      for (int j = 0; j < 2; ++j) {
        const int tok = m0 + wr * 64 + i * 32 + l31; const int cb = n0 + wc * 64 + j * 32;
        st_bf16_sw(pq + (size_t)tok * LDH + cb, acc[i][j], hh, 1.f);
      }
  }
}

__device__ __forceinline__ unsigned fkey(float f) { unsigned u = __float_as_uint(f); return (u & 0x80000000u) ? ~u : (u | 0x80000000u); }
__device__ __forceinline__ float fkey_inv(unsigned k) { unsigned u = (k & 0x80000000u) ? (k & 0x7fffffffu) : ~k; return __uint_as_float(u); }
__device__ __forceinline__ void insert16(unsigned (&L)[16], unsigned x) {
#pragma unroll
  for (int i = 0; i < 16; ++i) { const unsigned hi = x > L[i] ? x : L[i]; x = x > L[i] ? L[i] : x; L[i] = hi; }
}
__device__ __forceinline__ void cswap_desc(unsigned& a, unsigned& b) { const unsigned hi = a > b ? a : b, lo = a > b ? b : a; a = hi; b = lo; }
__device__ __forceinline__ void sort16_desc(unsigned (&a)[16]) {
#pragma unroll
  for (int k = 2; k <= 16; k <<= 1)
#pragma unroll
    for (int j = k >> 1; j > 0; j >>= 1)
#pragma unroll
      for (int i = 0; i < 16; ++i) {
        const int l = i ^ j;
        if (l > i) { if ((i & k) == 0) cswap_desc(a[i], a[l]); else cswap_desc(a[l], a[i]); }
      }
}
template <bool SORT>
__device__ __forceinline__ void merge16_desc(unsigned (&a)[16], const unsigned (&b)[16]) {
#pragma unroll
  for (int i = 0; i < 16; ++i) a[i] = a[i] > b[15 - i] ? a[i] : b[15 - i];
  if (SORT) {
#pragma unroll
    for (int j = 8; j > 0; j >>= 1)
#pragma unroll
      for (int i = 0; i < 16; ++i) { const int l = i ^ j; if (l > i) cswap_desc(a[i], a[l]); }
  }
}
__device__ void phase_peer_select(const Params& p, char* lds) {
  char* ws = p.ws;
  const int tid = threadIdx.x, lane = tid & 63, wid = tid >> 6, hh = lane >> 5, l31 = lane & 31;
  const bf16_t* pq = (const bf16_t*)(ws + W_B); const bf16_t* keys = (const bf16_t*)(ws + W_KEYS);
  int* seli = (int*)(ws + D_SELI); float* selw = (float*)(ws + D_SELW);
  float* S = (float*)lds;
  unsigned* LH = (unsigned*)lds;
  unsigned* LF = LH + 2 * 64 * 20;
  for (int u = blockIdx.x; u < 520 * 8; u += gridDim.x) {
    const int tt = u >> 3, h = u & 7; const int t0 = tt * 64;
    {
      const int c = wid >> 1;
      f32x16 acc[2][2]; zero_acc(acc);
      const bf16_t* ap = pq + (size_t)(t0 + l31) * LDH + h * 128 + c * 64 + hh * 8;
      const bf16_t* bp = keys + ((size_t)((h * 2 + c) * 128 + (wid & 1) * 64 + l31)) * 64 + hh * 8;
#pragma unroll
      for (int ks = 0; ks < 4; ++ks) {
        bf16x8 a0 = *(const bf16x8*)(ap + ks * 16), a1 = *(const bf16x8*)(ap + 32 * LDH + ks * 16);
        bf16x8 b0 = *(const bf16x8*)(bp + ks * 16), b1 = *(const bf16x8*)(bp + 32 * 64 + ks * 16);
        acc[0][0] = mfma32(a0, b0, acc[0][0]); acc[0][1] = mfma32(a0, b1, acc[0][1]);
        acc[1][0] = mfma32(a1, b0, acc[1][0]); acc[1][1] = mfma32(a1, b1, acc[1][1]);
      }
#pragma unroll
      for (int i = 0; i < 2; ++i)
#pragma unroll
        for (int j = 0; j < 2; ++j)
#pragma unroll
          for (int r = 0; r < 16; ++r) S[(i * 32 + accrow(r, hh)) * 260 + c * 128 + (wid & 1) * 64 + j * 32 + l31] = acc[i][j][r];
    }
    __syncthreads();
    const int tok = lane, c = wid & 1, half = wid >> 1;
    unsigned L[16];
    {
      const float* sp = S + tok * 260 + c * 128 + half * 64;
#pragma unroll
      for (int grp = 0; grp < 4; ++grp) {
        unsigned G[16];
#pragma unroll
        for (int n4 = 0; n4 < 4; ++n4) {
          const f32x4 v = *(const f32x4*)(sp + grp * 16 + n4 * 4);
          const unsigned ib = (unsigned)(127 - (half * 64 + grp * 16 + n4 * 4));
#pragma unroll
          for (int e = 0; e < 4; ++e) G[n4 * 4 + e] = (fkey(v[e]) & ~127u) | (ib - e);
        }
        sort16_desc(G);
        if (grp == 0) {
#pragma unroll
          for (int i = 0; i < 16; ++i) L[i] = G[i];
        } else merge16_desc<true>(L, G);
      }
    }
    __syncthreads();
    if (half == 1) {
#pragma unroll
      for (int i = 0; i < 16; i += 4) { u32x4 w = {L[i], L[i + 1], L[i + 2], L[i + 3]}; *(u32x4*)(LH + (c * 64 + tok) * 20 + i) = w; }
    }
    __syncthreads();
    if (half == 0) {
      unsigned G[16];
#pragma unroll
      for (int i = 0; i < 16; i += 4) {
        const u32x4 w = *(const u32x4*)(LH + (c * 64 + tok) * 20 + i);
        G[i] = w[0]; G[i + 1] = w[1]; G[i + 2] = w[2]; G[i + 3] = w[3];
      }
      merge16_desc<true>(L, G);
#pragma unroll
      for (int i = 0; i < 16; i += 4) { u32x4 w = {L[i], L[i + 1], L[i + 2], L[i + 3]}; *(u32x4*)(LF + (c * 64 + tok) * 20 + i) = w; }
    }
    __syncthreads();
    if (wid == 0) {
      float a[16], b[16];
#pragma unroll
      for (int i = 0; i < 16; ++i) a[i] = fkey_inv(L[i]);
#pragma unroll
      for (int j = 0; j < 16; j += 4) {
        const u32x4 w = *(const u32x4*)(LF + (64 + tok) * 20 + j);
        b[j] = fkey_inv(w[0]); b[j + 1] = fkey_inv(w[1]); b[j + 2] = fkey_inv(w[2]); b[j + 3] = fkey_inv(w[3]);
      }
      unsigned M[16], G[16];
#pragma unroll
      for (int j = 0; j < 16; ++j) M[j] = (fkey(a[0] + b[j]) & ~255u) | (unsigned)(255 - j);
      sort16_desc(M);
#define PK_CAND(i, j) ((fkey(a[i] + b[j]) & ~255u) | (unsigned)(255 - ((i) * 16 + (j))))
      G[0] = PK_CAND(1, 0); G[1] = PK_CAND(1, 1); G[2] = PK_CAND(1, 2); G[3] = PK_CAND(1, 3); G[4] = PK_CAND(1, 4); G[5] = PK_CAND(1, 5); G[6] = PK_CAND(1, 6); G[7] = PK_CAND(1, 7);
      G[8] = PK_CAND(2, 0); G[9] = PK_CAND(2, 1); G[10] = PK_CAND(2, 2); G[11] = PK_CAND(2, 3); G[12] = PK_CAND(2, 4); G[13] = 0u; G[14] = 0u; G[15] = 0u;
      sort16_desc(G); merge16_desc<true>(M, G);
      G[0] = PK_CAND(3, 0); G[1] = PK_CAND(3, 1); G[2] = PK_CAND(3, 2); G[3] = PK_CAND(3, 3); G[4] = PK_CAND(4, 0); G[5] = PK_CAND(4, 1); G[6] = PK_CAND(4, 2);
      G[7] = PK_CAND(5, 0); G[8] = PK_CAND(5, 1); G[9] = PK_CAND(6, 0); G[10] = PK_CAND(6, 1); G[11] = PK_CAND(7, 0); G[12] = PK_CAND(7, 1); G[13] = 0u; G[14] = 0u; G[15] = 0u;
      sort16_desc(G); merge16_desc<true>(M, G);
      G[0] = PK_CAND(8, 0); G[1] = PK_CAND(9, 0); G[2] = PK_CAND(10, 0); G[3] = PK_CAND(11, 0); G[4] = PK_CAND(12, 0); G[5] = PK_CAND(13, 0); G[6] = PK_CAND(14, 0); G[7] = PK_CAND(15, 0);
#pragma unroll
      for (int i = 8; i < 16; ++i) G[i] = 0u;
      sort16_desc(G); merge16_desc<true>(M, G);
#undef PK_CAND
      const float mx = fkey_inv(M[0]);
      float ev[16], den = 0.f;
#pragma unroll
      for (int k = 0; k < 16; ++k) { ev[k] = __expf(fkey_inv(M[k]) - mx); den += ev[k]; }
      const float rden = 1.f / den;
      const size_t o = ((size_t)(t0 + tok) * 8 + h) * 16;
#pragma unroll
      for (int k4 = 0; k4 < 16; k4 += 4) {
        int id[4]; f32x4 wv;
#pragma unroll
        for (int e = 0; e < 4; ++e) {
          const int flat = 255 - (int)(M[k4 + e] & 255u);
          const int i1 = 127 - (int)(LF[tok * 20 + (flat >> 4)] & 127u), i2 = 127 - (int)(LF[(64 + tok) * 20 + (flat & 15)] & 127u);
          id[e] = i1 * 128 + i2; wv[e] = ev[k4 + e] * rden;
        }
        *(int4*)(seli + o + k4) = make_int4(id[0], id[1], id[2], id[3]);
        *(f32x4*)(selw + o + k4) = wv;
      }
    }
    __syncthreads();
  }
}

__device__ __forceinline__ void peer_token_part(const Params& p, int t, int e_lo, int e_hi, float (&ov)[16], int lane) {
  char* ws = p.ws;
  const bf16_t* hf = (const bf16_t*)(ws + W_C);
  const unsigned char* u8 = (const unsigned char*)(ws + W_F); const unsigned char* v8 = u8 + 1024;
  const float* qs = (const float*)(ws + W_F + 33554432);
  const int* seli = (const int*)(ws + D_SELI); const float* selw = (const float*)(ws + D_SELW);
  f32v2_t hv[8], o2[8];
  {
    u32x4 a = *(const u32x4*)(hf + (size_t)t * LDH + lane * 16), b = *(const u32x4*)(hf + (size_t)t * LDH + lane * 16 + 8);
#pragma unroll
    for (int i = 0; i < 4; ++i) { hv[i] = (f32v2_t){bflo(a[i]), bfhi(a[i])}; hv[4 + i] = (f32v2_t){bflo(b[i]), bfhi(b[i])}; }
#pragma unroll
    for (int i = 0; i < 8; ++i) o2[i] = (f32v2_t){ov[2 * i], ov[2 * i + 1]};
  }
  const int myi0 = seli[(size_t)t * 128 + lane], myi1 = seli[(size_t)t * 128 + 64 + lane];
  const float mysu0 = qs[myi0], mysu1 = qs[myi1];
  const float myw0 = selw[(size_t)t * 128 + lane] * qs[16384 + myi0], myw1 = selw[(size_t)t * 128 + 64 + lane] * qs[16384 + myi1];
  const int b0 = lane & 1, b1 = lane & 2, b2 = lane & 4;
  for (int e0 = e_lo; e0 < e_hi; e0 += 8) {
    u32x4 ua[8], va[8];
    const int esel = (e0 & 63) + (lane & 7);
    const float sul = __shfl(e0 < 64 ? mysu0 : mysu1, esel), gwl = __shfl(e0 < 64 ? myw0 : myw1, esel);
#pragma unroll
    for (int k = 0; k < 8; ++k) {
      const int idx = __shfl(e0 < 64 ? myi0 : myi1, (e0 & 63) + k);
      ua[k] = *(const u32x4*)(u8 + (size_t)idx * 2048 + lane * 16);
      va[k] = *(const u32x4*)(v8 + (size_t)idx * 2048 + lane * 16);
    }
    float d[8];
#pragma unroll
    for (int k = 0; k < 8; ++k) {
      f32v2_t acc = {0.f, 0.f};
#pragma unroll
      for (int i = 0; i < 4; ++i) {
        const f32v2_t lo = __builtin_amdgcn_cvt_pk_f32_fp8((int)ua[k][i], false), hi = __builtin_amdgcn_cvt_pk_f32_fp8((int)ua[k][i], true);
        acc = hv[2 * i] * lo + acc; acc = hv[2 * i + 1] * hi + acc;
      }
      d[k] = acc[0] + acc[1];
    }
    float v4[4], v2[2], v1;
#pragma unroll
    for (int j = 0; j < 4; ++j) { const float keep = b0 ? d[2 * j + 1] : d[2 * j], send = b0 ? d[2 * j] : d[2 * j + 1]; v4[j] = keep + __shfl_xor(send, 1); }
#pragma unroll
    for (int j = 0; j < 2; ++j) { const float keep = b1 ? v4[2 * j + 1] : v4[2 * j], send = b1 ? v4[2 * j] : v4[2 * j + 1]; v2[j] = keep + __shfl_xor(send, 2); }
    { const float keep = b2 ? v2[1] : v2[0], send = b2 ? v2[0] : v2[1]; v1 = keep + __shfl_xor(send, 4); }
    v1 += __shfl_xor(v1, 8); v1 += __shfl_xor(v1, 16); v1 += __shfl_xor(v1, 32);
    const float dl = v1 * sul;
    const float wl = gwl * (0.5f * dl * (1.f + erff(dl * 0.70710678118654752f)));
#pragma unroll
    for (int k = 0; k < 8; ++k) {
      const float w = __builtin_bit_cast(float, __builtin_amdgcn_readlane(__builtin_bit_cast(int, wl), k));
      const f32v2_t w2 = {w, w};
#pragma unroll
      for (int i = 0; i < 4; ++i) {
        const f32v2_t lo = __builtin_amdgcn_cvt_pk_f32_fp8((int)va[k][i], false), hi = __builtin_amdgcn_cvt_pk_f32_fp8((int)va[k][i], true);
        o2[2 * i] = w2 * lo + o2[2 * i]; o2[2 * i + 1] = w2 * hi + o2[2 * i + 1];
      }
    }
  }
#pragma unroll
  for (int i = 0; i < 8; ++i) { ov[2 * i] = o2[i][0]; ov[2 * i + 1] = o2[i][1]; }
}
__device__ __forceinline__ void peer_token_finish(const Params& p, int t, float (&ov)[16], int lane) {
  const float* xr = (const float*)(p.ws + D_X1) + (size_t)t * DM + lane * 16; const float* g = p.in[24] + lane * 16;
  float ss = 0.f;
#pragma unroll
  for (int i = 0; i < 4; ++i) { f32x4 a = *(const f32x4*)(xr + i * 4); ov[4 * i] += a[0]; ov[4 * i + 1] += a[1]; ov[4 * i + 2] += a[2]; ov[4 * i + 3] += a[3]; }
#pragma unroll
  for (int i = 0; i < 16; ++i) ss += ov[i] * ov[i];
  ss = wave_sum(ss);
  const float rs = rsqrtf(ss * (1.f / DM) + EPS);
  float* y = p.out + O_Y + (size_t)t * DM + lane * 16;
#pragma unroll
  for (int i = 0; i < 4; ++i) {
    f32x4 ga = *(const f32x4*)(g + i * 4); f32x4 o;
    o[0] = ov[4 * i] * rs * ga[0]; o[1] = ov[4 * i + 1] * rs * ga[1]; o[2] = ov[4 * i + 2] * rs * ga[2]; o[3] = ov[4 * i + 3] * rs * ga[3];
    *(f32x4*)(y + i * 4) = o;
  }
}
__device__ void phase_peer_gather(const Params& p, char* lds) {
  const int wid = threadIdx.x >> 6, lane = threadIdx.x & 63;
  const int gw = blockIdx.x * 4 + wid, nw = gridDim.x * 4;
  const int t_main = (T / nw) * nw;
  for (int t = gw; t < t_main; t += nw) {
    float ov[16];
#pragma unroll
    for (int i = 0; i < 16; ++i) ov[i] = 0.f;
    peer_token_part(p, t, 0, 128, ov, lane);
    peer_token_finish(p, t, ov, lane);
  }
  float* part = (float*)lds;
  for (int t = t_main + blockIdx.x; t < T; t += gridDim.x) {
    float ov[16];
#pragma unroll
    for (int i = 0; i < 16; ++i) ov[i] = 0.f;
    peer_token_part(p, t, wid * 32, wid * 32 + 32, ov, lane);
    if (wid > 0) {
#pragma unroll
      for (int i = 0; i < 4; ++i) { f32x4 w = {ov[4 * i], ov[4 * i + 1], ov[4 * i + 2], ov[4 * i + 3]}; *(f32x4*)(part + wid * 1024 + lane * 16 + i * 4) = w; }
    }
    __syncthreads();
    if (wid == 0) {
#pragma unroll
      for (int w = 1; w < 4; ++w)
#pragma unroll
        for (int i = 0; i < 4; ++i) { const f32x4 v = *(const f32x4*)(part + w * 1024 + lane * 16 + i * 4); ov[4 * i] += v[0]; ov[4 * i + 1] += v[1]; ov[4 * i + 2] += v[2]; ov[4 * i + 3] += v[3]; }
      peer_token_finish(p, t, ov, lane);
    }
    __syncthreads();
  }
}

constexpr int NPHASE = 12;
__global__ void __launch_bounds__(256, 2) mega(Params p, int ph_lo, int ph_hi, int dupmask) {
  __shared__ __attribute__((aligned(16))) char lds[73728];
  __shared__ int s_item;
  __shared__ unsigned s_bar[4];
  unsigned* bar = (unsigned*)(p.ws + W_BAR);
  const unsigned xcc = xb_xcc_id();
  if (threadIdx.x < 4) s_bar[threadIdx.x] = 0u;
  if (threadIdx.x == 0 && ph_hi - ph_lo > 1) (void)xb_add(&bar[XB_XCNT(xcc)], 1u);
  __syncthreads();
  if (ph_hi > 4096) cg::this_grid().sync();
#define RUN_PHASE(PH, CALL)                                                       \
  if ((ONLY < 0 || ONLY == PH) && ph_lo <= PH && PH < ph_hi) {                    \
    const int nrep = 1 + ((dupmask >> PH) & 1);                                   \
    for (int rep = 0; rep < nrep; ++rep) {                                        \
      const int dry = (rep + 1 < nrep); (void)dry;                                \
      CALL;                                                                       \
      if (dry) grid_barrier(bar, xcc, s_bar);                                     \
    }                                                                             \
    if (PH + 1 < ph_hi) {                                                         \
      grid_barrier(bar, xcc, s_bar);                                              \
    }                                                                             \
  }
  RUN_PHASE(0, phase_prep(p))
  RUN_PHASE(1, phase_inproj(p, lds))
  RUN_PHASE(2, phase_small(p))
  RUN_PHASE(3, phase_attn_diff(p, lds, &s_item, dry))
  RUN_PHASE(4, phase_mla_expand(p, lds))
  RUN_PHASE(5, phase_attn_mla(p, lds, &s_item, dry))
  RUN_PHASE(6, phase_merge(p, lds))
  RUN_PHASE(7, phase_outproj(p, lds))
  RUN_PHASE(8, phase_ffn_norm(p))
  RUN_PHASE(9, phase_peer_q(p, lds))
  RUN_PHASE(10, phase_peer_select(p, lds))
  RUN_PHASE(11, phase_peer_gather(p, lds))
}

extern "C" void kernel_launch(void* const* d_in, const int* in_sizes, int n_in, void* d_out, int out_size, void* d_ws, size_t ws_size,
                              hipStream_t stream) {
  if (ws_size < W_END || n_in < 25) { fprintf(stderr, "workspace too small: %zu < %zu\n", ws_size, (size_t)W_END); return; }
  static int grid_blocks = 0;
  if (!grid_blocks) {
    int dev = 0, cus = 0, per_cu = 0;
    hipGetDevice(&dev);
    hipDeviceGetAttribute(&cus, hipDeviceAttributeMultiprocessorCount, dev);
    hipOccupancyMaxActiveBlocksPerMultiprocessor(&per_cu, mega, 256, 0);
    if (per_cu > 2) per_cu = 2;
    grid_blocks = cus * per_cu;
  }
  Params p{};
  for (int i = 0; i < 25; ++i) p.in[i] = (const float*)d_in[i];
  p.out = (float*)d_out; p.ws = (char*)d_ws; p.nblocks = (unsigned)grid_blocks; p.pad = 0;
  hipMemsetAsync((char*)d_ws + W_BAR, 0, 16384, stream);
#if MULTI_LAUNCH
  for (int ph = 0; ph < NPHASE; ++ph) {
    hipLaunchKernelGGL(mega, dim3(grid_blocks), dim3(256), 0, stream, p, ph, ph + 1, 0);
  }
#else
  int lo = 0, hi = NPHASE, dup = DUPMASK;
  void* args[] = {&p, &lo, &hi, &dup};
  hipError_t e = hipLaunchCooperativeKernel((void*)mega, dim3(grid_blocks), dim3(256), args, 0, stream);
  if (e != hipSuccess) fprintf(stderr, "cooperative launch failed: %s (grid %d)\n", hipGetErrorString(e), grid_blocks);
#endif
}
```

```cpp
#include <hip/hip_runtime.h>
#include <hip/hip_cooperative_groups.h>
#include <cstdio>
#include <cstdint>
namespace cg = cooperative_groups;

#ifndef ONLY
#define ONLY (-1)
#endif
#ifndef DUPMASK
#define DUPMASK 0
#endif
#ifndef MULTI_LAUNCH
#define MULTI_LAUNCH 0
#endif

typedef unsigned short bf16_t;
typedef short bf16x8 __attribute__((ext_vector_type(8)));
typedef float f32x4 __attribute__((ext_vector_type(4)));
typedef float f32x16 __attribute__((ext_vector_type(16)));
typedef unsigned u32x4 __attribute__((ext_vector_type(4)));
typedef unsigned u32x2 __attribute__((ext_vector_type(2)));

constexpr int DM = 1024;
constexpr int TP = 32768, TS = 512, T = TP + TS;
constexpr int SEQ = 4096, PAST = 2048, LKS = 2112;
constexpr int R = TP + 8 * LKS;
constexpr int NIN = 5632;
constexpr int LDH = 1088;
constexpr int LDQ = 288;
constexpr int LDK = 160;
constexpr int SEQP = 4160;
constexpr float LOG2E = 1.4426950408889634f;
constexpr float EPS = 1e-6f;

constexpr size_t O_Y = 0;
constexpr size_t O_KP = 34078720, O_VP = 67633152, O_CP = 101187584, O_EP = 105381888;
constexpr size_t O_KS = 106430464, O_VS = 106954752, O_CS = 107479040, O_ES = 107544576;

constexpr size_t W_WIN = 0;
constexpr size_t W_WUQ = W_WIN + (size_t)NIN * LDH * 2;
constexpr size_t W_WUKV = W_WUQ + (size_t)1536 * LDQ * 2;
constexpr size_t W_WA = W_WUKV + (size_t)2048 * LDK * 2;
constexpr size_t W_WB = W_WA + (size_t)1024 * LDH * 2;
constexpr size_t W_WO = W_WB + (size_t)1024 * LDH * 2;
constexpr size_t W_WQ = W_WO + (size_t)1024 * LDH * 2;
constexpr size_t W_KEYS = W_WQ + (size_t)1024 * LDH * 2;
constexpr size_t W_ROPE = W_KEYS + 262144;
constexpr size_t W_MISC = W_ROPE + 524288;
constexpr size_t W_BAR = W_MISC + 8192;
constexpr int QW = 3584;
constexpr size_t SZ_ACT = (size_t)T * LDH * 2;
constexpr size_t W_B = W_BAR + 16384;
constexpr size_t W_C = W_B + SZ_ACT;
constexpr size_t W_D = W_C + SZ_ACT;
constexpr size_t SZ_VTP = (size_t)8 * 1024 * SEQP * 2, SZ_VTS = (size_t)8 * 1024 * LKS * 2;
constexpr size_t W_D2 = W_D + (size_t)R * LDH * 2;
constexpr size_t W_F = W_D2 + SZ_VTP + SZ_VTS;
constexpr size_t F_ZCQ = W_F, F_ZCKV = F_ZCQ + 34078720, F_ZKR = F_ZCKV + 17039360, F_CQ = F_ZKR + 4259840;
constexpr size_t SZ_F = (F_CQ - W_F) + (size_t)T * LDQ * 2;
static_assert(SZ_F >= SZ_ACT, "merged must fit in F");
constexpr size_t W_G = W_F + SZ_F;
constexpr size_t W_KPE = W_G + (size_t)R * LDK * 2;
constexpr size_t W_END = W_KPE + (size_t)R * 32 * 2;
static_assert(W_END <= 536870912ull, "workspace budget");
constexpr size_t D_X1 = W_D, D_SELI = W_D + 136314880, D_SELW = D_SELI + 17039360;
static_assert(D_SELW + 17039360 <= W_F, "x1 + sel must fit in D");

struct Params {
  const float* in[25];
  float* out;
  char* ws;
  unsigned nblocks;
  unsigned pad;
};

typedef __bf16 bf16v2_t __attribute__((ext_vector_type(2)));
typedef float f32v2_t __attribute__((ext_vector_type(2)));
__device__ __forceinline__ unsigned pk2(float lo, float hi) { f32v2_t v = {lo, hi}; bf16v2_t r = __builtin_convertvector(v, bf16v2_t); return __builtin_bit_cast(unsigned, r); }
__device__ __forceinline__ bf16_t f2bf(float x) { return (bf16_t)(pk2(x, 0.f) & 0xffffu); }
__device__ __forceinline__ float bf2f(bf16_t v) { return __uint_as_float(((unsigned)v) << 16); }
__device__ __forceinline__ float bflo(unsigned w) { return __uint_as_float(w << 16); }
__device__ __forceinline__ float bfhi(unsigned w) { return __uint_as_float(w & 0xffff0000u); }
__device__ __forceinline__ float wave_sum(float v) {
#pragma unroll
  for (int o = 32; o >= 1; o >>= 1) v += __shfl_xor(v, o);
  return v;
}
__device__ __forceinline__ f32x16 mfma32(bf16x8 a, bf16x8 b, f32x16 c) { return __builtin_amdgcn_mfma_f32_32x32x16_bf16(a, b, c, 0, 0, 0); }
__device__ __forceinline__ int accrow(int reg, int hh) { return (reg & 3) + 8 * (reg >> 2) + 4 * hh; }
__device__ __forceinline__ int kperm(int k) { return (k & ~12) | ((k & 4) << 1) | ((k & 8) >> 1); }

__device__ __forceinline__ int keyrow_of_token(int t) {
  if (t < TP) return t;
  int ts = t - TP; return TP + (ts >> 6) * LKS + PAST + (ts & 63);
}

#define XB_XCNT(j)  (256  + 64 * (j))
#define XB_XSUB(j)  (1280 + 64 * (j))
#define XB_XGEN(j)  (2304 + 64 * (j))
#define XB_TOP      3328
#define XB_TOPGEN   3392
__device__ __forceinline__ unsigned xb_ld(unsigned* p)              { return __hip_atomic_load(p, __ATOMIC_RELAXED, __HIP_MEMORY_SCOPE_AGENT); }
__device__ __forceinline__ unsigned xb_add(unsigned* p, unsigned v) { return __hip_atomic_fetch_add(p, v, __ATOMIC_RELAXED, __HIP_MEMORY_SCOPE_AGENT); }
__device__ __forceinline__ unsigned xb_xcc_id() { return (unsigned)__builtin_amdgcn_s_getreg((3 << 11) | 20) & 0xFu; }
__device__ __forceinline__ void grid_barrier(unsigned* bar, unsigned xcc, volatile unsigned* st) {
  asm volatile("s_waitcnt vmcnt(0)" ::: "memory");
  __syncthreads();
  if (threadIdx.x == 0) {
    __builtin_amdgcn_s_waitcnt(0);
    unsigned nloc = st[0], nx = st[1];
    if (nloc == 0u) {
      const unsigned G = gridDim.x;
      for (;;) {
        unsigned sum = 0u, cnt = 0u, mine = 0u;
#pragma unroll
        for (unsigned j = 0; j < 16; ++j) { const unsigned c = xb_ld(&bar[XB_XCNT(j)]); sum += c; cnt += (c > 0u) ? 1u : 0u; mine = (j == xcc) ? c : mine; }
        if (sum == G) { nloc = mine; nx = cnt; break; }
        __builtin_amdgcn_s_sleep(1);
      }
      st[0] = nloc; st[1] = nx;
    }
    const unsigned old = xb_add(&bar[XB_XSUB(xcc)], 1u);
    const unsigned gen = old / nloc;
    if (old + 1u == (gen + 1u) * nloc) {
      __builtin_amdgcn_fence(__ATOMIC_RELEASE, "agent");
      asm volatile("s_waitcnt vmcnt(0)" ::: "memory");
      const unsigned og = xb_add(&bar[XB_TOP], 1u);
      const unsigned tg = og / nx;
      if (og + 1u == (tg + 1u) * nx) xb_add(&bar[XB_TOPGEN], 1u);
      else { while (xb_ld(&bar[XB_TOPGEN]) == tg) __builtin_amdgcn_s_sleep(1); }
      __builtin_amdgcn_fence(__ATOMIC_ACQUIRE, "agent");
      xb_add(&bar[XB_XGEN(xcc)], 1u);
      asm volatile("s_waitcnt vmcnt(0)" ::: "memory");
    } else {
      while (xb_ld(&bar[XB_XGEN(xcc)]) == gen) __builtin_amdgcn_s_sleep(1);
      __builtin_amdgcn_fence(__ATOMIC_ACQUIRE, "agent");
      asm volatile("s_waitcnt vmcnt(0)" ::: "memory");
    }
  }
  __syncthreads();
}

constexpr int GEMM_BUF = 32768;
typedef __attribute__((address_space(3))) unsigned lds_u32_t;
typedef __attribute__((address_space(1))) const unsigned glb_u32_t;
__device__ __forceinline__ void glds16(const bf16_t* g, char* l) {
  __builtin_amdgcn_global_load_lds((glb_u32_t*)g, (lds_u32_t*)l, 16, 0, 0);
}
template <bool SW>
__device__ __forceinline__ void gemm_mainloop(const bf16_t* __restrict__ A, int lda, const bf16_t* __restrict__ Bt, int ldb, int K,
                                              f32x16 (&acc)[2][2], char* lds, int kstart) {
  const int tid = threadIdx.x, lane = tid & 63, wid = tid >> 6;
  const int wr = wid >> 1, wc = wid & 1, l31 = lane & 31, hh = lane >> 5;
  const int lrow = wid * 32 + (lane >> 3);
  const int nk = K >> 6;
  kstart &= (nk - 1);
  const bf16_t* ap[4]; const bf16_t* bp[4];
#pragma unroll
  for (int i = 0; i < 4; ++i) {
    const int row = lrow + 8 * i; const int ch = (lane & 7) ^ ((row >> 1) & 7);
    ap[i] = A + (size_t)row * lda + ch * 8; bp[i] = Bt + (size_t)row * ldb + ch * 8;
  }
  char* ldst = lds + (wid * 32) * 128 + lane * 16;
#pragma unroll
  for (int i = 0; i < 4; ++i) { glds16(ap[i] + kstart * 64, ldst + i * 1024); glds16(bp[i] + kstart * 64, ldst + 16384 + i * 1024); }
  asm volatile("s_waitcnt vmcnt(0)" ::: "memory");
  __syncthreads();
  const int swz = (l31 >> 1) & 7;
  const int roffA = (wr * 64 + l31) * 128, roffB = 16384 + (wc * 64 + l31) * 128;
#pragma unroll 1
  for (int kt = 0; kt < nk; ++kt) {
    const bool more = (kt + 1 < nk);
    if (more) {
      char* d = ldst + ((kt + 1) & 1) * GEMM_BUF;
      const int ko = ((kt + 1 + kstart) & (nk - 1)) * 64;
#pragma unroll
      for (int i = 0; i < 4; ++i) { glds16(ap[i] + ko, d + i * 1024); glds16(bp[i] + ko, d + 16384 + i * 1024); }
    }
    const char* base = lds + (kt & 1) * GEMM_BUF;
#pragma unroll
    for (int ks = 0; ks < 4; ++ks) {
      const int co = ((2 * ks + hh) ^ swz) * 16;
      bf16x8 a0 = *(const bf16x8*)(base + roffA + co), a1 = *(const bf16x8*)(base + roffA + 32 * 128 + co);
      bf16x8 b0 = *(const bf16x8*)(base + roffB + co), b1 = *(const bf16x8*)(base + roffB + 32 * 128 + co);
      if (SW) {
        acc[0][0] = mfma32(b0, a0, acc[0][0]); acc[0][1] = mfma32(b1, a0, acc[0][1]);
        acc[1][0] = mfma32(b0, a1, acc[1][0]); acc[1][1] = mfma32(b1, a1, acc[1][1]);
      } else {
        acc[0][0] = mfma32(a0, b0, acc[0][0]); acc[0][1] = mfma32(a0, b1, acc[0][1]);
        acc[1][0] = mfma32(a1, b0, acc[1][0]); acc[1][1] = mfma32(a1, b1, acc[1][1]);
      }
    }
    asm volatile("s_waitcnt vmcnt(0)" ::: "memory");
    __syncthreads();
  }
}
__device__ __forceinline__ bool tile_at(int nMt, int nNt, int it, int& mt, int& nt) {
  const int x = blockIdx.x & 7, lb = blockIdx.x >> 3, nloc = gridDim.x >> 3;
  const int mb = (x * nMt) >> 3, mc = (((x + 1) * nMt) >> 3) - mb;
  const int idx = lb + it * nloc;
  if (idx >= mc * nNt) return false;
  const int g = idx / (8 * nNt); const int rem = idx - g * 8 * nNt;
  const int left = mc - g * 8; const int gsz = left < 8 ? left : 8;
  mt = mb + g * 8 + rem % gsz; nt = rem / gsz;
  return true;
}
__device__ __forceinline__ void zero_acc(f32x16 (&acc)[2][2]) {
#pragma unroll
  for (int i = 0; i < 2; ++i)
#pragma unroll
    for (int j = 0; j < 2; ++j)
#pragma unroll
      for (int r = 0; r < 16; ++r) acc[i][j][r] = 0.f;
}

__device__ __forceinline__ void vt_store(bf16_t* vt_row, int key32, const f32x16& a, int hh) {
#pragma unroll
  for (int g = 0; g < 4; ++g) {
    const int pos = key32 + (g >> 1) * 16 + hh * 8 + (g & 1) * 4;
    u32x2 w; w.x = pk2(a[4 * g], a[4 * g + 1]); w.y = pk2(a[4 * g + 2], a[4 * g + 3]);
    *(u32x2*)(vt_row + pos) = w;
  }
}

__device__ __forceinline__ void st_bf16_sw(bf16_t* row, const f32x16& a, int hh, float sc) {
#pragma unroll
  for (int g = 0; g < 4; ++g) { u32x2 w; w.x = pk2(a[4 * g] * sc, a[4 * g + 1] * sc); w.y = pk2(a[4 * g + 2] * sc, a[4 * g + 3] * sc); *(u32x2*)(row + 8 * g + 4 * hh) = w; }
}
__device__ __forceinline__ void st_f32_sw(float* row, const f32x16& a, int hh) {
#pragma unroll
  for (int g = 0; g < 4; ++g) { f32x4 w = {a[4 * g], a[4 * g + 1], a[4 * g + 2], a[4 * g + 3]}; *(f32x4*)(row + 8 * g + 4 * hh) = w; }
}

__device__ void phase_prep(const Params& p) {
  const int gtid = blockIdx.x * 256 + threadIdx.x, gthreads = gridDim.x * 256;
  const int gw = gtid >> 6, nw = gthreads >> 6, lane = threadIdx.x & 63;
  char* ws = p.ws;
  {
    bf16_t* dst = (bf16_t*)(ws + W_WIN); const float* src = p.in[8];
    for (int u = gtid; u < NIN * 128; u += gthreads) {
      const int n = u % NIN, k0 = (u / NIN) * 8;
      int col = n; bool valid = true;
      if (n >= 3584) col = n - 96; else if (n >= 3488) valid = false;
      float v[8];
#pragma unroll
      for (int j = 0; j < 8; ++j) v[j] = valid ? src[(size_t)(k0 + j) * 5536 + col] : 0.f;
      u32x4 w; w.x = pk2(v[0], v[1]); w.y = pk2(v[2], v[3]); w.z = pk2(v[4], v[5]); w.w = pk2(v[6], v[7]);
      *(u32x4*)(dst + (size_t)n * LDH + k0) = w;
    }
  }
  {
    bf16_t* dst = (bf16_t*)(ws + W_WUQ); const float* src = p.in[12];
    for (int u = gtid; u < 1536 * 32; u += gthreads) {
      const int n = u % 1536, k0 = (u / 1536) * 8;
      int col = (n < 1024) ? ((n >> 6) * 96 + (n & 63)) : (((n - 1024) >> 5) * 96 + 64 + ((n - 1024) & 31));
      float v[8];
#pragma unroll
      for (int j = 0; j < 8; ++j) v[j] = src[(size_t)(k0 + j) * 1536 + col];
      u32x4 w; w.x = pk2(v[0], v[1]); w.y = pk2(v[2], v[3]); w.z = pk2(v[4], v[5]); w.w = pk2(v[6], v[7]);
      *(u32x4*)(dst + (size_t)n * LDQ + k0) = w;
    }
  }
  {
    bf16_t* dst = (bf16_t*)(ws + W_WUKV);
    for (int u = gtid; u < 2048 * 16; u += gthreads) {
      const int n = u % 2048, k0 = (u / 2048) * 8;
      const float* src = (n < 1024) ? p.in[14] : p.in[15]; const int col = n & 1023;
      float v[8];
#pragma unroll
      for (int j = 0; j < 8; ++j) v[j] = src[(size_t)(k0 + j) * 1024 + col];
      u32x4 w; w.x = pk2(v[0], v[1]); w.y = pk2(v[2], v[3]); w.z = pk2(v[4], v[5]); w.w = pk2(v[6], v[7]);
      *(u32x4*)(dst + (size_t)n * LDK + k0) = w;
    }
  }
  {
    for (int u = gtid; u < 4 * 1024 * 128; u += gthreads) {
      const int which = u >> 17, uu = u & 131071;
      const int n = uu & 1023, k0 = (uu >> 10) * 8;
      const float* src = which == 0 ? p.in[16] : which == 1 ? p.in[17] : which == 2 ? p.in[18] : p.in[20];
      bf16_t* dst = (bf16_t*)(ws + (which == 0 ? W_WA : which == 1 ? W_WB : which == 2 ? W_WO : W_WQ));
      float v[8];
#pragma unroll
      for (int j = 0; j < 8; ++j) v[j] = src[(size_t)(k0 + j) * 1024 + n];
      u32x4 w; w.x = pk2(v[0], v[1]); w.y = pk2(v[2], v[3]); w.z = pk2(v[4], v[5]); w.w = pk2(v[6], v[7]);
      *(u32x4*)(dst + (size_t)n * LDH + k0) = w;
    }
  }
  {
    bf16_t* dst = (bf16_t*)(ws + W_KEYS); const float* src = p.in[21];
    for (int u = gtid; u < 16 * 128 * 64 / 4; u += gthreads) {
      f32x4 v = *(const f32x4*)(src + (size_t)u * 4);
      u32x2 w; w.x = pk2(v[0], v[1]); w.y = pk2(v[2], v[3]);
      *(u32x2*)(dst + (size_t)u * 4) = w;
    }
  }
  {
    bf16_t* hb = (bf16_t*)(ws + W_B); const float* g = p.in[7];
    for (int t = gw; t < T; t += nw) {
      const float* x = (t < TP) ? p.in[0] + (size_t)t * DM : p.in[1] + (size_t)(t - TP) * DM;
      f32x4 v[4]; float ss = 0.f;
#pragma unroll
      for (int i = 0; i < 4; ++i) { v[i] = *(const f32x4*)(x + i * 256 + lane * 4); ss += v[i][0] * v[i][0] + v[i][1] * v[i][1] + v[i][2] * v[i][2] + v[i][3] * v[i][3]; }
      ss = wave_sum(ss);
      const float rs = rsqrtf(ss * (1.f / DM) + EPS);
#pragma unroll
      for (int i = 0; i < 4; ++i) {
        f32x4 gg = *(const f32x4*)(g + i * 256 + lane * 4);
        u32x2 w; w.x = pk2(v[i][0] * rs * gg[0], v[i][1] * rs * gg[1]); w.y = pk2(v[i][2] * rs * gg[2], v[i][3] * rs * gg[3]);
        *(u32x2*)(hb + (size_t)t * LDH + i * 256 + lane * 4) = w;
      }
    }
  }
  {
    bf16_t* dk = (bf16_t*)(ws + W_D); const float* src = p.in[2];
    for (int u = gtid; u < 8 * PAST * 256; u += gthreads) {
      const int e = u * 4; const int row = e >> 10, c = e & 1023; const int b = row >> 11, j = row & 2047;
      f32x4 v = *(const f32x4*)(src + (size_t)e);
      u32x2 w; w.x = pk2(v[0], v[1]); w.y = pk2(v[2], v[3]);
      *(u32x2*)(dk + (size_t)(TP + b * LKS + j) * LDH + c) = w;
    }
    bf16_t* ck = (bf16_t*)(ws + W_G); const float* s2 = p.in[4];
    for (int u = gtid; u < 8 * PAST * 32; u += gthreads) {
      const int e = u * 4; const int row = e >> 7, c = e & 127; const int b = row >> 11, j = row & 2047;
      f32x4 v = *(const f32x4*)(s2 + (size_t)e);
      u32x2 w; w.x = pk2(v[0], v[1]); w.y = pk2(v[2], v[3]);
      *(u32x2*)(ck + (size_t)(TP + b * LKS + j) * LDK + c) = w;
    }
    bf16_t* kp = (bf16_t*)(ws + W_KPE); const float* s3 = p.in[5];
    for (int u = gtid; u < 8 * PAST * 8; u += gthreads) {
      const int e = u * 4; const int row = e >> 5, c = e & 31; const int b = row >> 11, j = row & 2047;
      f32x4 v = *(const f32x4*)(s3 + (size_t)e);
      u32x2 w; w.x = pk2(v[0], v[1]); w.y = pk2(v[2], v[3]);
      *(u32x2*)(kp + (size_t)(TP + b * LKS + j) * 32 + c) = w;
    }
  }
  {
    bf16_t* vt = (bf16_t*)(ws + W_D2 + SZ_VTP); const float* src = p.in[3];
    for (int u = gtid; u < 8 * 256 * 1024; u += gthreads) {
      const int c = u & 1023, pg = (u >> 10) & 255, b = u >> 18;
      const int p0 = pg * 8;
      float v[8];
#pragma unroll
      for (int i = 0; i < 8; ++i) { const int key = kperm(p0 + i); v[i] = src[((size_t)(b * PAST + key)) * 1024 + c]; }
      u32x4 w; w.x = pk2(v[0], v[1]); w.y = pk2(v[2], v[3]); w.z = pk2(v[4], v[5]); w.w = pk2(v[6], v[7]);
      *(u32x4*)(vt + ((size_t)(b * 1024 + c)) * LKS + p0) = w;
    }
  }
  {
    float2* rt = (float2*)(ws + W_ROPE);
    for (int u = gtid; u < 4096 * 16; u += gthreads) {
      const int pos = u >> 4, i = u & 15;
      const float inv = powf(10000.0f, -(float)i / 16.0f);
      const float ang = (float)pos * inv;
      rt[u] = make_float2(cosf(ang), sinf(ang));
    }
    float* misc = (float*)(ws + W_MISC);
    if (gw == 0) {
      const float* lp = p.in[9];
      float a = lp[lane] * lp[64 + lane], b = lp[128 + lane] * lp[192 + lane];
      a = wave_sum(a); b = wave_sum(b);
      if (lane == 0) misc[0] = expf(a) - expf(b) + 0.2f;
    }
    for (int u = gtid; u < 8 * 192; u += gthreads) {
      const int h = u / 192, idx = u % 192; const int rel = idx - 128;
      const int n = rel < 0 ? -rel : rel;
      int bucket = rel > 0 ? 16 : 0;
      if (n < 8) bucket += n;
      else { int lg = 8 + (n >= 12) + (n >= 16) + (n >= 23) + (n >= 32) + (n >= 46) + (n >= 64) + (n >= 91); bucket += lg > 15 ? 15 : lg; }
      misc[64 + u] = (p.in[6][bucket * 8 + h] - p.in[6][15 * 8 + h]) * LOG2E;
    }
  }
}

__device__ void phase_inproj(const Params& p, char* lds) {
  char* ws = p.ws;
  const bf16_t* hb = (const bf16_t*)(ws + W_B); const bf16_t* wt = (const bf16_t*)(ws + W_WIN);
  const int lane = threadIdx.x & 63, wid = threadIdx.x >> 6, wr = wid >> 1, wc = wid & 1, hh = lane >> 5, l31 = lane & 31;
  for (int it = 0;; ++it) {
    int mt, nt; if (!tile_at(260, 44, it, mt, nt)) break;
    const int m0 = mt * 128, n0 = nt * 128;
    f32x16 acc[2][2]; zero_acc(acc);
    const bool samp = (m0 >= TP);
    if (nt >= 16 && nt < 24) {
      gemm_mainloop<false>(hb + (size_t)m0 * LDH, LDH, wt + (size_t)n0 * LDH, LDH, DM, acc, lds, 2 * ((mt + nt) & 7));
#pragma unroll
      for (int i = 0; i < 2; ++i)
#pragma unroll
        for (int j = 0; j < 2; ++j) {
          const int mb = m0 + wr * 64 + i * 32; const int nn = n0 - 2048 + wc * 64 + j * 32 + l31;
          float* o = (samp ? p.out + O_VS + (size_t)(mb - TP) * 1024 : p.out + O_VP + (size_t)mb * 1024) + nn;
#pragma unroll
          for (int r = 0; r < 16; ++r) o[(size_t)accrow(r, hh) * 1024] = acc[i][j][r];
          bf16_t* vt; int key32;
          if (!samp) { const int b = mb >> 12; vt = (bf16_t*)(ws + W_D2) + ((size_t)(b * 1024 + nn)) * SEQP; key32 = mb & 4095; }
          else { const int ts = mb - TP; const int b = ts >> 6; vt = (bf16_t*)(ws + W_D2 + SZ_VTP) + ((size_t)(b * 1024 + nn)) * LKS; key32 = PAST + (ts & 63); }
          vt_store(vt, key32, acc[i][j], hh);
        }
      continue;
    }
    gemm_mainloop<true>(hb + (size_t)m0 * LDH, LDH, wt + (size_t)n0 * LDH, LDH, DM, acc, lds, 2 * ((mt + nt) & 7));
#pragma unroll
    for (int i = 0; i < 2; ++i)
#pragma unroll
      for (int j = 0; j < 2; ++j) {
        const int tok = m0 + wr * 64 + i * 32 + l31; const int cb = n0 + wc * 64 + j * 32;
        if (nt < 8) {
          st_bf16_sw((bf16_t*)(ws + W_C) + (size_t)tok * LDH + cb, acc[i][j], hh, 0.125f * LOG2E);
        } else if (nt < 16) {
          st_f32_sw((samp ? p.out + O_KS + (size_t)(tok - TP) * 1024 : p.out + O_KP + (size_t)tok * 1024) + (cb - 1024), acc[i][j], hh);
          st_bf16_sw((bf16_t*)(ws + W_D) + (size_t)keyrow_of_token(tok) * LDH + (cb - 1024), acc[i][j], hh, 1.f);
        } else if (nt < 26) {
          st_f32_sw((float*)(ws + F_ZCQ) + (size_t)tok * 256 + (cb - 3072), acc[i][j], hh);
        } else if (nt == 26) {
          st_f32_sw((float*)(ws + F_ZCKV) + (size_t)tok * 128 + (cb - 3328), acc[i][j], hh);
        } else if (nt == 27) {
          if (cb == 3456) st_f32_sw((float*)(ws + F_ZKR) + (size_t)tok * 32, acc[i][j], hh);
        } else {
          f32x16 sg;
#pragma unroll
          for (int r = 0; r < 16; ++r) sg[r] = __builtin_amdgcn_rcpf(1.f + __expf(-acc[i][j][r]));
          st_bf16_sw((bf16_t*)(p.out + O_Y) + (size_t)tok * 2048 + (cb - 3584), sg, hh, 1.f);
        }
      }
  }
}

__device__ void phase_small(const Params& p) {
  char* ws = p.ws;
  const int gw = (blockIdx.x * 256 + threadIdx.x) >> 6, nw = (gridDim.x * 256) >> 6, lane = threadIdx.x & 63;
  const float* zcq = (const float*)(ws + F_ZCQ); const float* zckv = (const float*)(ws + F_ZCKV); const float* zkr = (const float*)(ws + F_ZKR);
  bf16_t* cq = (bf16_t*)(ws + F_CQ); bf16_t* ckva = (bf16_t*)(ws + W_G); bf16_t* kpea = (bf16_t*)(ws + W_KPE);
  const float2* rt = (const float2*)(ws + W_ROPE);
  for (int t = gw; t < T; t += nw) {
    {
      f32x4 v = *(const f32x4*)(zcq + (size_t)t * 256 + lane * 4);
      float ss = wave_sum(v[0] * v[0] + v[1] * v[1] + v[2] * v[2] + v[3] * v[3]);
      const float rs = rsqrtf(ss * (1.f / 256.f) + EPS);
      f32x4 g = *(const f32x4*)(p.in[11] + lane * 4);
      u32x2 w; w.x = pk2(v[0] * rs * g[0], v[1] * rs * g[1]); w.y = pk2(v[2] * rs * g[2], v[3] * rs * g[3]);
      *(u32x2*)(cq + (size_t)t * LDQ + lane * 4) = w;
    }
    const int kr = keyrow_of_token(t);
    {
      float2 v = *(const float2*)(zckv + (size_t)t * 128 + lane * 2);
      float ss = wave_sum(v.x * v.x + v.y * v.y);
      const float rs = rsqrtf(ss * (1.f / 128.f) + EPS);
      float2 g = *(const float2*)(p.in[13] + lane * 2);
      const float a = v.x * rs * g.x, b = v.y * rs * g.y;
      float* o = (t < TP) ? p.out + O_CP + (size_t)t * 128 : p.out + O_CS + (size_t)(t - TP) * 128;
      *(float2*)(o + lane * 2) = make_float2(a, b);
      *(unsigned*)(ckva + (size_t)kr * LDK + lane * 2) = pk2(a, b);
    }
    {
      const int pos = (t < TP) ? (t & 4095) : (PAST + ((t - TP) & 63));
      const int i = lane & 15;
      const float x1 = zkr[(size_t)t * 32 + i], x2 = zkr[(size_t)t * 32 + 16 + i];
      const float2 cs = rt[pos * 16 + i];
      const float r = (lane < 16) ? (x1 * cs.x - x2 * cs.y) : (x1 * cs.y + x2 * cs.x);
      if (lane < 32) {
        float* o = (t < TP) ? p.out + O_EP + (size_t)t * 32 : p.out + O_ES + (size_t)(t - TP) * 32;
        o[lane] = r; kpea[(size_t)kr * 32 + lane] = f2bf(r);
      }
    }
  }
}

template <int MODE>
__device__ void attn_item(const Params& p, char* lds, int grp  , int b, int h, int qblk, int dry) {
  constexpr int DQ = MODE == 0 ? 64 : 96;
  constexpr int KROW = MODE == 0 ? 128 : 96;
  constexpr int KSTR = MODE == 0 ? 272 : 208;
  constexpr int DV = MODE == 0 ? 128 : 64;
  constexpr int NH = MODE == 0 ? 8 : 16;
  constexpr int KBYTES = 64 * KSTR;
  constexpr int BUF = KBYTES + DV * 144;
  constexpr int KCH = KROW / 8;
  constexpr int NKC = 64 * KCH / 256;
  constexpr int NVC = DV * 8 / 256;
  char* ws = p.ws;
  const int tid = threadIdx.x, lane = tid & 63, wid = tid >> 6, hh = lane >> 5, l31 = lane & 31;
  const int qsub = MODE == 0 ? (wid >> 1) : wid;
  const int comp = MODE == 0 ? (wid & 1) : 0;
  const int QB = MODE == 0 ? 64 : 128;
  const int Lk = grp == 0 ? SEQP : LKS;
  const int tok0 = grp == 0 ? (b * SEQ + qblk * QB) : (TP + b * 64);
  const int qpos0 = grp == 0 ? qblk * QB : PAST;
  const int krow0 = grp == 0 ? b * SEQ : TP + b * LKS;
  int nkt;
  if (grp == 0) nkt = MODE == 0 ? (qblk + 1) : (2 * qblk + 2); else nkt = 33;
  int my_last = nkt - 1; bool active = true;
  if (MODE == 1) { if (grp == 0) my_last = 2 * qblk + (wid >> 1); else active = (wid < 2); }
  const int qtok = tok0 + qsub * 32 + l31;
  const int qpos = qpos0 + qsub * 32 + l31;

  bf16x8 qf[DQ / 16];
  if (MODE == 0) {
    const bf16_t* q = (const bf16_t*)(ws + W_C) + (size_t)qtok * LDH + h * 128 + comp * 64 + hh * 8;
#pragma unroll
    for (int ks = 0; ks < 4; ++ks) qf[ks] = *(const bf16x8*)(q + ks * 16);
  } else {
    const int qt = active ? qtok : tok0;
    const bf16_t* q = (const bf16_t*)(ws + W_B) + (size_t)qt * LDH + h * 64 + hh * 8;
#pragma unroll
    for (int ks = 0; ks < 4; ++ks) qf[ks] = *(const bf16x8*)(q + ks * 16);
    const bf16_t* qp = (const bf16_t*)(ws + F_ZCQ) + (size_t)qt * 512 + h * 32 + hh * 8;
    bf16x8 a = *(const bf16x8*)(qp), c = *(const bf16x8*)(qp + 16);
    const float2* rt = (const float2*)(ws + W_ROPE) + (size_t)(active ? qpos : qpos0) * 16 + hh * 8;
    float o1[8], o2[8];
#pragma unroll
    for (int j = 0; j < 8; ++j) {
      const float x1 = bf2f((bf16_t)a[j]), x2 = bf2f((bf16_t)c[j]); const float2 cs = rt[j];
      o1[j] = x1 * cs.x - x2 * cs.y; o2[j] = x1 * cs.y + x2 * cs.x;
    }
    u32x4 w1, w2;
    w1.x = pk2(o1[0], o1[1]); w1.y = pk2(o1[2], o1[3]); w1.z = pk2(o1[4], o1[5]); w1.w = pk2(o1[6], o1[7]);
    w2.x = pk2(o2[0], o2[1]); w2.y = pk2(o2[2], o2[3]); w2.z = pk2(o2[4], o2[5]); w2.w = pk2(o2[6], o2[7]);
    qf[4] = __builtin_bit_cast(bf16x8, w1); qf[5] = __builtin_bit_cast(bf16x8, w2);
  }

  const bf16_t* kg; const bf16_t* kpe; const bf16_t* vg;
  if (MODE == 0) {
    kg = (const bf16_t*)(ws + W_D) + (size_t)krow0 * LDH + h * 128;
    kpe = nullptr;
    vg = grp == 0 ? (const bf16_t*)(ws + W_D2) + (size_t)(b * 1024 + h * 128) * SEQP : (const bf16_t*)(ws + W_D2 + SZ_VTP) + (size_t)(b * 1024 + h * 128) * LKS;
  } else {
    kg = (const bf16_t*)(ws + W_D) + (size_t)krow0 * LDH + h * 64;
    kpe = (const bf16_t*)(ws + W_KPE) + (size_t)krow0 * 32;
    vg = grp == 0 ? (const bf16_t*)(ws + W_D2) + (size_t)(b * 1024 + h * 64) * SEQP : (const bf16_t*)(ws + W_D2 + SZ_VTP) + (size_t)(b * 1024 + h * 64) * LKS;
  }
  u32x4 rk[NKC], rv[NVC];
  int koff[NKC], voff[NVC];
#pragma unroll
  for (int i = 0; i < NKC; ++i) { const int q = tid + 256 * i; koff[i] = (q / KCH) * LDH + (q % KCH) * 8; }
#pragma unroll
  for (int i = 0; i < NVC; ++i) { const int q = tid + 256 * i; voff[i] = (q >> 3) * Lk + (q & 7) * 8; }
  auto gloadK = [&](int kt) {
    const bf16_t* ktile = kg + (size_t)kt * 64 * LDH;
#pragma unroll
    for (int i = 0; i < NKC; ++i) {
      if (MODE == 0) rk[i] = *(const u32x4*)(ktile + koff[i]);
      else {
        const int q = tid + 256 * i; const int row = q / KCH, ch = q % KCH;
        const bf16_t* src = (ch < 8) ? kg + (size_t)(kt * 64 + row) * LDH + ch * 8 : kpe + (size_t)(kt * 64 + row) * 32 + (ch - 8) * 8;
        rk[i] = *(const u32x4*)src;
      }
    }
  };
  auto gloadV = [&](int kt) {
    const bf16_t* vtile = vg + kt * 64;
#pragma unroll
    for (int i = 0; i < NVC; ++i) rv[i] = *(const u32x4*)(vtile + voff[i]);
  };
  auto lwriteK = [&](int buf) {
    char* base = lds + buf * BUF;
#pragma unroll
    for (int i = 0; i < NKC; ++i) { const int q = tid + 256 * i; const int row = q / KCH, ch = q % KCH; *(u32x4*)(base + row * KSTR + ch * 16) = rk[i]; }
  };
  auto lwriteV = [&](int buf) {
    char* base = lds + buf * BUF;
#pragma unroll
    for (int i = 0; i < NVC; ++i) { const int q = tid + 256 * i; const int row = q >> 3, ch = q & 7; *(u32x4*)(base + KBYTES + row * 144 + ch * 16) = rv[i]; }
  };

  f32x16 O[DV / 32];
#pragma unroll
  for (int i = 0; i < DV / 32; ++i)
#pragma unroll
    for (int r = 0; r < 16; ++r) O[i][r] = 0.f;
  float m = -1e30f, l = 0.f;
  const float* btab = (const float*)(ws + W_MISC) + 64 + h * 192;
  __shared__ float s_bt[192];
  if (MODE == 0 && tid < 192) s_bt[tid] = btab[tid];

  gloadK(0); gloadV(0); lwriteK(0); lwriteV(0);
  __syncthreads();
  for (int kt = 0; kt < nkt; ++kt) {
    const bool more = (kt + 1 < nkt);
    if (more) { gloadK(kt + 1); if (MODE == 1) gloadV(kt + 1); }
    if (active && kt <= my_last) {
      const char* base = lds + (kt & 1) * BUF;
      f32x16 S[2];
      const char* kp0 = base + l31 * KSTR + comp * 128 + hh * 16;
#pragma unroll
      for (int sub = 0; sub < 2; ++sub) {
#pragma unroll
        for (int r = 0; r < 16; ++r) S[sub][r] = 0.f;
#pragma unroll
        for (int ks = 0; ks < DQ / 16; ++ks) {
          bf16x8 kf = *(const bf16x8*)(kp0 + sub * 32 * KSTR + ks * 32);
          S[sub] = mfma32(kf, qf[ks], S[sub]);
        }
      }
      if (MODE == 0) {
        const int kpos0 = kt * 64;
        if (kpos0 + 63 > qpos0 - 91) {
#pragma unroll
          for (int sub = 0; sub < 2; ++sub)
#pragma unroll
            for (int r = 0; r < 16; ++r) {
              int rel = kpos0 + sub * 32 + accrow(r, hh) - qpos; rel = rel < -128 ? -128 : rel;
              S[sub][r] += s_bt[rel + 128];
            }
        }
      }
      __builtin_amdgcn_sched_barrier(0);
      float mx = S[0][0];
#pragma unroll
      for (int sub = 0; sub < 2; ++sub)
#pragma unroll
        for (int r = 0; r < 16; ++r) mx = fmaxf(mx, S[sub][r]);
      if (__any(mx > m + 8.0f)) {
        mx = fmaxf(mx, __shfl_xor(mx, 32));
        const float mn = fmaxf(m, mx);
        const float alpha = __builtin_amdgcn_exp2f(m - mn);
        m = mn; l *= alpha;
#pragma unroll
        for (int i = 0; i < DV / 32; ++i)
#pragma unroll
          for (int r = 0; r < 16; ++r) O[i][r] *= alpha;
      }
      if (MODE == 0 && more) { lwriteK((kt + 1) & 1); gloadV(kt + 1); }
      f32v2_t ps2 = {0.f, 0.f}; const f32v2_t m2 = {m, m};
      const char* vp0 = base + KBYTES + l31 * 144 + hh * 16;
#pragma unroll
      for (int sub = 0; sub < 2; ++sub) {
#pragma unroll
        for (int r = 0; r < 16; r += 2) {
          f32v2_t v = (f32v2_t){S[sub][r], S[sub][r + 1]} - m2;
          v[0] = __builtin_amdgcn_exp2f(v[0]); v[1] = __builtin_amdgcn_exp2f(v[1]);
          S[sub][r] = v[0]; S[sub][r + 1] = v[1]; ps2 += v;
        }
#pragma unroll
        for (int s = 0; s < 2; ++s) {
          u32x4 w;
          w.x = pk2(S[sub][8 * s + 0], S[sub][8 * s + 1]); w.y = pk2(S[sub][8 * s + 2], S[sub][8 * s + 3]);
          w.z = pk2(S[sub][8 * s + 4], S[sub][8 * s + 5]); w.w = pk2(S[sub][8 * s + 6], S[sub][8 * s + 7]);
          const bf16x8 pf = __builtin_bit_cast(bf16x8, w);
#pragma unroll
          for (int blk = 0; blk < DV / 32; ++blk) {
            bf16x8 vf = *(const bf16x8*)(vp0 + blk * 32 * 144 + sub * 64 + s * 32);
            O[blk] = mfma32(vf, pf, O[blk]);
          }
        }
      }
      l += ps2[0] + ps2[1];
    }
    if (more) { if (MODE == 1) lwriteK((kt + 1) & 1); lwriteV((kt + 1) & 1); }
    __syncthreads();
  }
  const float lt = l + __shfl_xor(l, 32);
  const float inv = 1.f / lt;
  if (MODE == 0) {
    float* xch = (float*)lds;
    const float lam = ((const float*)(ws + W_MISC))[0];
    if (comp == 1) {
#pragma unroll
      for (int blk = 0; blk < 4; ++blk)
#pragma unroll
        for (int r = 0; r < 16; ++r) xch[(qsub * 32 + l31) * 132 + blk * 32 + accrow(r, hh)] = O[blk][r] * inv * lam;
    }
    __syncthreads();
    if (comp == 0 && !dry) {
      float ss = 0.f;
#pragma unroll
      for (int blk = 0; blk < 4; ++blk)
#pragma unroll
        for (int r = 0; r < 16; ++r) { const float v = O[blk][r] * inv - xch[(qsub * 32 + l31) * 132 + blk * 32 + accrow(r, hh)]; O[blk][r] = v; ss += v * v; }
      ss += __shfl_xor(ss, 32);
      const float rs = rsqrtf(ss * (1.f / 128.f) + EPS) * 0.8f;
      bf16_t* o = (bf16_t*)(ws + W_C) + (size_t)qtok * LDH + h * 128;
      const float* sg = p.in[10];
#pragma unroll
      for (int blk = 0; blk < 4; ++blk)
#pragma unroll
        for (int g = 0; g < 4; ++g) {
          const int dv = blk * 32 + 8 * g + 4 * hh;
          f32x4 gg = *(const f32x4*)(sg + dv);
          u32x2 w; w.x = pk2(O[blk][4 * g] * rs * gg[0], O[blk][4 * g + 1] * rs * gg[1]); w.y = pk2(O[blk][4 * g + 2] * rs * gg[2], O[blk][4 * g + 3] * rs * gg[3]);
          *(u32x2*)(o + dv) = w;
        }
    }
    __syncthreads();
  } else {
    if (active && !dry) {
      bf16_t* o = (bf16_t*)(ws + W_B) + (size_t)qtok * LDH + h * 64;
#pragma unroll
      for (int blk = 0; blk < 2; ++blk)
#pragma unroll
        for (int g = 0; g < 4; ++g) {
          const int dv = blk * 32 + 8 * g + 4 * hh;
          u32x2 w; w.x = pk2(O[blk][4 * g] * inv, O[blk][4 * g + 1] * inv); w.y = pk2(O[blk][4 * g + 2] * inv, O[blk][4 * g + 3] * inv);
          *(u32x2*)(o + dv) = w;
        }
    }
  }
}

__device__ void attn_item_mla(const Params& p, char* lds, int grp, int b, int h, int qblk, int dry) {
  constexpr int KSTR = 208, KBYTES = 64 * KSTR, BUF = KBYTES + 64 * 144;
  char* ws = p.ws;
  int tid = threadIdx.x; asm volatile("" : "+v"(tid));
  const int lane = tid & 63, wid = tid >> 6, hh = lane >> 5, l31 = lane & 31;
  const int Lk = grp == 0 ? SEQP : LKS;
  const int tok0 = grp == 0 ? (b * SEQ + qblk * 256) : (TP + b * 64);
  const int qpos0 = grp == 0 ? qblk * 256 : PAST;
  const int krow0 = grp == 0 ? b * SEQ : TP + b * LKS;
  const int nkt = grp == 0 ? (4 * qblk + 4) : 33;
  const int my_last = grp == 0 ? (4 * qblk + wid) : 32;
  const bool active = grp == 0 ? true : (wid == 0);
  bf16x8 qf[2][6];
#pragma unroll
  for (int qs = 0; qs < 2; ++qs) {
    const int qt = active ? tok0 + wid * 64 + qs * 32 + l31 : tok0;
    const int qp = active ? qpos0 + wid * 64 + qs * 32 + l31 : qpos0;
    const bf16_t* q = (const bf16_t*)(ws + W_B) + (size_t)qt * LDH + h * 64 + hh * 8;
#pragma unroll
    for (int ks = 0; ks < 4; ++ks) qf[qs][ks] = *(const bf16x8*)(q + ks * 16);
    const bf16_t* qpe = (const bf16_t*)(ws + F_ZCQ) + (size_t)qt * 512 + h * 32 + hh * 8;
    const bf16x8 a = *(const bf16x8*)(qpe), c = *(const bf16x8*)(qpe + 16);
    const float2* rt = (const float2*)(ws + W_ROPE) + (size_t)qp * 16 + hh * 8;
    float o1[8], o2[8];
#pragma unroll
    for (int j = 0; j < 8; ++j) {
      const float x1 = bf2f((bf16_t)a[j]), x2 = bf2f((bf16_t)c[j]); const float2 cs = rt[j];
      o1[j] = x1 * cs.x - x2 * cs.y; o2[j] = x1 * cs.y + x2 * cs.x;
    }
    u32x4 w1, w2;
    w1.x = pk2(o1[0], o1[1]); w1.y = pk2(o1[2], o1[3]); w1.z = pk2(o1[4], o1[5]); w1.w = pk2(o1[6], o1[7]);
    w2.x = pk2(o2[0], o2[1]); w2.y = pk2(o2[2], o2[3]); w2.z = pk2(o2[4], o2[5]); w2.w = pk2(o2[6], o2[7]);
    qf[qs][4] = __builtin_bit_cast(bf16x8, w1); qf[qs][5] = __builtin_bit_cast(bf16x8, w2);
  }
  const bf16_t* kg = (const bf16_t*)(ws + W_D) + (size_t)krow0 * LDH + h * 64;
  const bf16_t* kpe = (const bf16_t*)(ws + W_KPE) + (size_t)krow0 * 32;
  const bf16_t* vg = grp == 0 ? (const bf16_t*)(ws + W_D2) + (size_t)(b * 1024 + h * 64) * SEQP : (const bf16_t*)(ws + W_D2 + SZ_VTP) + (size_t)(b * 1024 + h * 64) * LKS;
  u32x4 rk[3], rv[2];
  auto gload = [&](int kt) {
#pragma unroll
    for (int i = 0; i < 3; ++i) {
      const int q = tid + 256 * i; const int row = q / 12, ch = q % 12;
      const bf16_t* src = (ch < 8) ? kg + (size_t)(kt * 64 + row) * LDH + ch * 8 : kpe + (size_t)(kt * 64 + row) * 32 + (ch - 8) * 8;
      rk[i] = *(const u32x4*)src;
    }
#pragma unroll
    for (int i = 0; i < 2; ++i) { const int q = tid + 256 * i; const int row = q >> 3, ch = q & 7; rv[i] = *(const u32x4*)(vg + (size_t)row * Lk + kt * 64 + ch * 8); }
  };
  auto lwrite = [&](int buf) {
    char* base = lds + buf * BUF;
#pragma unroll
    for (int i = 0; i < 3; ++i) { const int q = tid + 256 * i; const int row = q / 12, ch = q % 12; *(u32x4*)(base + row * KSTR + ch * 16) = rk[i]; }
#pragma unroll
    for (int i = 0; i < 2; ++i) { const int q = tid + 256 * i; const int row = q >> 3, ch = q & 7; *(u32x4*)(base + KBYTES + row * 144 + ch * 16) = rv[i]; }
  };
  f32x16 O[2][2];
#pragma unroll
  for (int qs = 0; qs < 2; ++qs)
#pragma unroll
    for (int i = 0; i < 2; ++i)
#pragma unroll
      for (int r = 0; r < 16; ++r) O[qs][i][r] = 0.f;
  float m[2] = {-1e30f, -1e30f}, l[2] = {0.f, 0.f};
  gload(0); lwrite(0);
  __syncthreads();
  for (int kt = 0; kt < nkt; ++kt) {
    const bool more = (kt + 1 < nkt);
    if (more) gload(kt + 1);
    if (active && kt <= my_last) {
      const char* base = lds + (kt & 1) * BUF;
      const char* kp0 = base + l31 * KSTR + hh * 16;
      const char* vp0 = base + KBYTES + l31 * 144 + hh * 16;
#pragma unroll 1
      for (int sub = 0; sub < 2; ++sub) {
        f32x16 S[2];
#pragma unroll
        for (int r = 0; r < 16; ++r) { S[0][r] = 0.f; S[1][r] = 0.f; }
#pragma unroll
        for (int ks = 0; ks < 6; ++ks) {
          const bf16x8 kf = *(const bf16x8*)(kp0 + sub * 32 * KSTR + ks * 32);
          S[0] = mfma32(kf, qf[0][ks], S[0]);
          S[1] = mfma32(kf, qf[1][ks], S[1]);
        }
#pragma unroll
        for (int qs = 0; qs < 2; ++qs) {
          float mx = S[qs][0];
#pragma unroll
          for (int r = 1; r < 16; ++r) mx = fmaxf(mx, S[qs][r]);
          if (__any(mx > m[qs] + 8.0f)) {
            mx = fmaxf(mx, __shfl_xor(mx, 32));
            const float mn = fmaxf(m[qs], mx);
            const float alpha = __builtin_amdgcn_exp2f(m[qs] - mn);
            m[qs] = mn; l[qs] *= alpha;
#pragma unroll
            for (int i = 0; i < 2; ++i)
#pragma unroll
              for (int r = 0; r < 16; ++r) O[qs][i][r] *= alpha;
          }
          f32v2_t ps2 = {0.f, 0.f}; const f32v2_t m2 = {m[qs], m[qs]};
#pragma unroll
          for (int r = 0; r < 16; r += 2) {
            f32v2_t v = (f32v2_t){S[qs][r], S[qs][r + 1]} - m2;
            v[0] = __builtin_amdgcn_exp2f(v[0]); v[1] = __builtin_amdgcn_exp2f(v[1]);
            S[qs][r] = v[0]; S[qs][r + 1] = v[1]; ps2 += v;
          }
          l[qs] += ps2[0] + ps2[1];
        }
#pragma unroll
        for (int s2 = 0; s2 < 2; ++s2) {
          u32x4 w0, w1;
          w0.x = pk2(S[0][8 * s2 + 0], S[0][8 * s2 + 1]); w0.y = pk2(S[0][8 * s2 + 2], S[0][8 * s2 + 3]);
          w0.z = pk2(S[0][8 * s2 + 4], S[0][8 * s2 + 5]); w0.w = pk2(S[0][8 * s2 + 6], S[0][8 * s2 + 7]);
          w1.x = pk2(S[1][8 * s2 + 0], S[1][8 * s2 + 1]); w1.y = pk2(S[1][8 * s2 + 2], S[1][8 * s2 + 3]);
          w1.z = pk2(S[1][8 * s2 + 4], S[1][8 * s2 + 5]); w1.w = pk2(S[1][8 * s2 + 6], S[1][8 * s2 + 7]);
          const bf16x8 pf0 = __builtin_bit_cast(bf16x8, w0), pf1 = __builtin_bit_cast(bf16x8, w1);
#pragma unroll
          for (int blk = 0; blk < 2; ++blk) {
            const bf16x8 vf = *(const bf16x8*)(vp0 + blk * 32 * 144 + sub * 64 + s2 * 32);
            O[0][blk] = mfma32(vf, pf0, O[0][blk]);
            O[1][blk] = mfma32(vf, pf1, O[1][blk]);
          }
        }
      }
    }
    if (more) lwrite((kt + 1) & 1);
    __syncthreads();
  }
  if (active && !dry) {
#pragma unroll
    for (int qs = 0; qs < 2; ++qs) {
      const float lt = l[qs] + __shfl_xor(l[qs], 32);
      const float inv = 1.f / lt;
      const int qtok = tok0 + wid * 64 + qs * 32 + l31;
      bf16_t* o = (bf16_t*)(ws + W_B) + (size_t)qtok * LDH + h * 64;
#pragma unroll
      for (int blk = 0; blk < 2; ++blk)
#pragma unroll
        for (int g = 0; g < 4; ++g) {
          const int dv = blk * 32 + 8 * g + 4 * hh;
          u32x2 w; w.x = pk2(O[qs][blk][4 * g] * inv, O[qs][blk][4 * g + 1] * inv); w.y = pk2(O[qs][blk][4 * g + 2] * inv, O[qs][blk][4 * g + 3] * inv);
          *(u32x2*)(o + dv) = w;
        }
    }
  }
}

__device__ void phase_attn_diff(const Params& p, char* lds, int* s_item, int dry) {
  const int x = blockIdx.x & 7;
  const int total = 512 + 8;
  unsigned* q = (unsigned*)(p.ws + W_BAR) + QW + dry * 8 + x;
  for (;;) {
    if (threadIdx.x == 0) *s_item = (int)__hip_atomic_fetch_add(q, 1u, __ATOMIC_RELAXED, __HIP_MEMORY_SCOPE_AGENT);
    __syncthreads();
    const int u = *s_item;
    __syncthreads();
    if (u >= total) break;
    int grp = 0, bh, qblk = 0;
    if (u < 256) { qblk = 63 - (u >> 3); bh = (u & 7) * 8 + x; }
    else if (u < 264) { grp = 1; bh = (u - 256) * 8 + x; }
    else { const int v = u - 8; qblk = 63 - (v >> 3); bh = (v & 7) * 8 + x; }
    attn_item<0>(p, lds, grp, bh >> 3, bh & 7, qblk, dry);
  }
}
__device__ void phase_attn_mla(const Params& p, char* lds, int* s_item, int dry) {
  const int x = blockIdx.x & 7;
  const int total = 256 + 16;
  unsigned* q = (unsigned*)(p.ws + W_BAR) + QW + 16 + dry * 8 + x;
  for (;;) {
    if (threadIdx.x == 0) *s_item = (int)__hip_atomic_fetch_add(q, 1u, __ATOMIC_RELAXED, __HIP_MEMORY_SCOPE_AGENT);
    __syncthreads();
    const int u = *s_item;
    __syncthreads();
    if (u >= total) break;
    int grp = 0, bh, qblk = 0;
    if (u < 128) { qblk = 15 - (u >> 4); bh = (u & 15) * 8 + x; }
    else if (u < 144) { grp = 1; bh = (u - 128) * 8 + x; }
    else { const int v = u - 16; qblk = 15 - (v >> 4); bh = (v & 15) * 8 + x; }
    attn_item_mla(p, lds, grp, bh >> 4, bh & 15, qblk, dry);
  }
}

__device__ void phase_mla_expand(const Params& p, char* lds) {
  char* ws = p.ws;
  const int lane = threadIdx.x & 63, wid = threadIdx.x >> 6, wr = wid >> 1, wc = wid & 1, hh = lane >> 5, l31 = lane & 31;
  for (int it = 0, setB = 0;; ++it) {
    int mt, nt;
    if (!setB) { if (!tile_at(260, 12, it, mt, nt)) { setB = 1; it = -1; continue; } }
    else if (!tile_at(388, 16, it, mt, nt)) break;
    f32x16 acc[2][2]; zero_acc(acc);
    const int m0 = mt * 128, n0 = nt * 128;
    if (!setB) {
      gemm_mainloop<true>((const bf16_t*)(ws + F_CQ) + (size_t)m0 * LDQ, LDQ, (const bf16_t*)(ws + W_WUQ) + (size_t)n0 * LDQ, LDQ, 256, acc, lds, 2 * ((mt + nt) & 7));
      const float sc = 0.10206207261596577f * LOG2E;
#pragma unroll
      for (int i = 0; i < 2; ++i)
#pragma unroll
        for (int j = 0; j < 2; ++j) {
          const int tok = m0 + wr * 64 + i * 32 + l31; const int cb = n0 + wc * 64 + j * 32;
          if (nt < 8) st_bf16_sw((bf16_t*)(ws + W_B) + (size_t)tok * LDH + cb, acc[i][j], hh, sc);
          else st_bf16_sw((bf16_t*)(ws + F_ZCQ) + (size_t)tok * 512 + (cb - 1024), acc[i][j], hh, sc);
        }
    } else if (nt < 8) {
      gemm_mainloop<true>((const bf16_t*)(ws + W_G) + (size_t)m0 * LDK, LDK, (const bf16_t*)(ws + W_WUKV) + (size_t)n0 * LDK, LDK, 128, acc, lds, 2 * ((mt + nt) & 7));
#pragma unroll
      for (int i = 0; i < 2; ++i)
#pragma unroll
        for (int j = 0; j < 2; ++j) {
          const int row = m0 + wr * 64 + i * 32 + l31; const int cb = n0 + wc * 64 + j * 32;
          st_bf16_sw((bf16_t*)(ws + W_D) + (size_t)row * LDH + cb, acc[i][j], hh, 1.f);
        }
    } else {
      gemm_mainloop<false>((const bf16_t*)(ws + W_G) + (size_t)m0 * LDK, LDK, (const bf16_t*)(ws + W_WUKV) + (size_t)n0 * LDK, LDK, 128, acc, lds, 2 * ((mt + nt) & 7));
#pragma unroll
      for (int i = 0; i < 2; ++i)
#pragma unroll
        for (int j = 0; j < 2; ++j) {
          const int mb = m0 + wr * 64 + i * 32; const int nn = n0 - 1024 + wc * 64 + j * 32 + l31;
          bf16_t* vt; int key32;
          if (mb < TP) { const int b = mb >> 12; vt = (bf16_t*)(ws + W_D2) + ((size_t)(b * 1024 + nn)) * SEQP; key32 = mb & 4095; }
          else { const int x = mb - TP; const int b = x / LKS; vt = (bf16_t*)(ws + W_D2 + SZ_VTP) + ((size_t)(b * 1024 + nn)) * LKS; key32 = x - b * LKS; }
          vt_store(vt, key32, acc[i][j], hh);
        }
    }
  }
}

__device__ void phase_merge(const Params& p, char* lds) {
  char* ws = p.ws;
  const int lane = threadIdx.x & 63, wid = threadIdx.x >> 6, wr = wid >> 1, wc = wid & 1, hh = lane >> 5, l31 = lane & 31;
  const bf16_t* gates = (const bf16_t*)(p.out + O_Y);
  bf16_t* mg = (bf16_t*)(ws + W_F);
  for (int it = 0;; ++it) {
    int mt, nt; if (!tile_at(260, 8, it, mt, nt)) break;
    const int m0 = mt * 128, n0 = nt * 128;
    {
      f32x16 acc[2][2]; zero_acc(acc);
      gemm_mainloop<true>((const bf16_t*)(ws + W_C) + (size_t)m0 * LDH, LDH, (const bf16_t*)(ws + W_WA) + (size_t)n0 * LDH, LDH, 1024, acc, lds, 2 * ((mt + nt) & 7));
#pragma unroll
      for (int i = 0; i < 2; ++i)
#pragma unroll
        for (int j = 0; j < 2; ++j) {
          const int tok = m0 + wr * 64 + i * 32 + l31; const int cb = n0 + wc * 64 + j * 32;
          const bf16_t* gp = gates + (size_t)tok * 2048 + cb + 4 * hh;
          bf16_t* op = mg + (size_t)tok * LDH + cb + 4 * hh;
#pragma unroll
          for (int g = 0; g < 4; ++g) {
            const u32x2 gv = *(const u32x2*)(gp + 8 * g);
            u32x2 w;
            w.x = pk2(acc[i][j][4 * g] * bflo(gv.x), acc[i][j][4 * g + 1] * bfhi(gv.x));
            w.y = pk2(acc[i][j][4 * g + 2] * bflo(gv.y), acc[i][j][4 * g + 3] * bfhi(gv.y));
            *(u32x2*)(op + 8 * g) = w;
          }
        }
    }
    {
      f32x16 acc[2][2]; zero_acc(acc);
      gemm_mainloop<true>((const bf16_t*)(ws + W_B) + (size_t)m0 * LDH, LDH, (const bf16_t*)(ws + W_WB) + (size_t)n0 * LDH, LDH, 1024, acc, lds, 2 * ((mt + nt) & 7));
      int l31b = l31; asm volatile("" : "+v"(l31b));
#pragma unroll
      for (int i = 0; i < 2; ++i)
#pragma unroll
        for (int j = 0; j < 2; ++j) {
          const int tok = m0 + wr * 64 + i * 32 + l31b; const int cb = n0 + wc * 64 + j * 32;
          const bf16_t* gp = gates + (size_t)tok * 2048 + 1024 + cb + 4 * hh;
          bf16_t* op = mg + (size_t)tok * LDH + cb + 4 * hh;
#pragma unroll
          for (int g = 0; g < 4; ++g) {
            const u32x2 gv = *(const u32x2*)(gp + 8 * g);
            const u32x2 pv = *(const u32x2*)(op + 8 * g);
            u32x2 w;
            w.x = pk2(bflo(pv.x) + acc[i][j][4 * g] * bflo(gv.x), bfhi(pv.x) + acc[i][j][4 * g + 1] * bfhi(gv.x));
            w.y = pk2(bflo(pv.y) + acc[i][j][4 * g + 2] * bflo(gv.y), bfhi(pv.y) + acc[i][j][4 * g + 3] * bfhi(gv.y));
            *(u32x2*)(op + 8 * g) = w;
          }
        }
    }
  }
}

__device__ void phase_outproj(const Params& p, char* lds) {
  char* ws = p.ws;
  const int lane = threadIdx.x & 63, wid = threadIdx.x >> 6, wr = wid >> 1, wc = wid & 1, hh = lane >> 5, l31 = lane & 31;
  float* x1 = (float*)(ws + D_X1);
  for (int it = 0;; ++it) {
    int mt, nt; if (!tile_at(260, 8, it, mt, nt)) break;
    const int m0 = mt * 128, n0 = nt * 128;
    f32x16 acc[2][2]; zero_acc(acc);
    gemm_mainloop<true>((const bf16_t*)(ws + W_F) + (size_t)m0 * LDH, LDH, (const bf16_t*)(ws + W_WO) + (size_t)n0 * LDH, LDH, 1024, acc, lds, 2 * ((mt + nt) & 7));
#pragma unroll
    for (int i = 0; i < 2; ++i)
#pragma unroll
      for (int j = 0; j < 2; ++j) {
        const int tok = m0 + wr * 64 + i * 32 + l31; const int cb = n0 + wc * 64 + j * 32 + 4 * hh;
        const float* xr = ((tok < TP) ? p.in[0] + (size_t)tok * 1024 : p.in[1] + (size_t)(tok - TP) * 1024) + cb;
        float* orow = x1 + (size_t)tok * 1024 + cb;
#pragma unroll
        for (int g = 0; g < 4; ++g) {
          const f32x4 xv = *(const f32x4*)(xr + 8 * g);
          f32x4 w = {xv[0] + acc[i][j][4 * g], xv[1] + acc[i][j][4 * g + 1], xv[2] + acc[i][j][4 * g + 2], xv[3] + acc[i][j][4 * g + 3]};
          *(f32x4*)(orow + 8 * g) = w;
        }
      }
  }
}

__device__ void phase_ffn_norm(const Params& p) {
  char* ws = p.ws;
  const int gtid = blockIdx.x * 256 + threadIdx.x, gthreads = gridDim.x * 256;
  const int gw = gtid >> 6, nw = gthreads >> 6, lane = threadIdx.x & 63;
  const float* x1 = (const float*)(ws + D_X1); bf16_t* hf = (bf16_t*)(ws + W_C); const float* g = p.in[19];
  for (int t = gw; t < T; t += nw) {
    const float* x = x1 + (size_t)t * DM;
    f32x4 v[4]; float ss = 0.f;
#pragma unroll
    for (int i = 0; i < 4; ++i) { v[i] = *(const f32x4*)(x + i * 256 + lane * 4); ss += v[i][0] * v[i][0] + v[i][1] * v[i][1] + v[i][2] * v[i][2] + v[i][3] * v[i][3]; }
    ss = wave_sum(ss);
    const float rs = rsqrtf(ss * (1.f / DM) + EPS);
#pragma unroll
    for (int i = 0; i < 4; ++i) {
      f32x4 gg = *(const f32x4*)(g + i * 256 + lane * 4);
      u32x2 w; w.x = pk2(v[i][0] * rs * gg[0], v[i][1] * rs * gg[1]); w.y = pk2(v[i][2] * rs * gg[2], v[i][3] * rs * gg[3]);
      *(u32x2*)(hf + (size_t)t * LDH + i * 256 + lane * 4) = w;
    }
  }
  unsigned char* q8 = (unsigned char*)(ws + W_F); float* qs = (float*)(ws + W_F + 33554432);
  for (int r = gw; r < 2 * 16384; r += nw) {
    const float* src = (r < 16384) ? p.in[22] + (size_t)r * DM : p.in[23] + (size_t)(r - 16384) * DM;
    f32x4 v[4]; float am = 0.f;
#pragma unroll
    for (int i = 0; i < 4; ++i) { v[i] = *(const f32x4*)(src + lane * 16 + i * 4); am = fmaxf(am, fmaxf(fmaxf(fabsf(v[i][0]), fabsf(v[i][1])), fmaxf(fabsf(v[i][2]), fabsf(v[i][3])))); }
#pragma unroll
    for (int o = 32; o >= 1; o >>= 1) am = fmaxf(am, __shfl_xor(am, o));
    const float sc = am > 0.f ? 224.f / am : 1.f;
    u32x4 w;
#pragma unroll
    for (int i = 0; i < 4; ++i) {
      int d = 0;
      d = __builtin_amdgcn_cvt_pk_fp8_f32(v[i][0] * sc, v[i][1] * sc, d, false);
      d = __builtin_amdgcn_cvt_pk_fp8_f32(v[i][2] * sc, v[i][3] * sc, d, true);
      w[i] = (unsigned)d;
    }
    *(u32x4*)(q8 + (r < 16384 ? (size_t)r * 2048 : (size_t)(r - 16384) * 2048 + 1024) + lane * 16) = w;
    if (lane == 0) qs[r] = am > 0.f ? am / 224.f : 1.f;
  }
}

__device__ void phase_peer_q(const Params& p, char* lds) {
  char* ws = p.ws;
  const int lane = threadIdx.x & 63, wid = threadIdx.x >> 6, wr = wid >> 1, wc = wid & 1, hh = lane >> 5, l31 = lane & 31;
  bf16_t* pq = (bf16_t*)(ws + W_B);
  for (int it = 0;; ++it) {
    int mt, nt; if (!tile_at(260, 8, it, mt, nt)) break;
    const int m0 = mt * 128, n0 = nt * 128;
    f32x16 acc[2][2]; zero_acc(acc);
    gemm_mainloop<true>((const bf16_t*)(ws + W_C) + (size_t)m0 * LDH, LDH, (const bf16_t*)(ws + W_WQ) + (size_t)n0 * LDH, LDH, 1024, acc, lds, 2 * ((mt + nt) & 7));
#pragma unroll
    for (int i = 0; i < 2; ++i)
#pragma unroll
      for (int j = 0; j < 2; ++j) {
        const int tok = m0 + wr * 64 + i * 32 + l31; const int cb = n0 + wc * 64 + j * 32;
        st_bf16_sw(pq + (size_t)tok * LDH + cb, acc[i][j], hh, 1.f);
      }
  }
}

__device__ __forceinline__ unsigned fkey(float f) { unsigned u = __float_as_uint(f); return (u & 0x80000000u) ? ~u : (u | 0x80000000u); }
__device__ __forceinline__ float fkey_inv(unsigned k) { unsigned u = (k & 0x80000000u) ? (k & 0x7fffffffu) : ~k; return __uint_as_float(u); }
__device__ __forceinline__ void insert16(unsigned (&L)[16], unsigned x) {
#pragma unroll
  for (int i = 0; i < 16; ++i) { const unsigned hi = x > L[i] ? x : L[i]; x = x > L[i] ? L[i] : x; L[i] = hi; }
}
__device__ __forceinline__ void cswap_desc(unsigned& a, unsigned& b) { const unsigned hi = a > b ? a : b, lo = a > b ? b : a; a = hi; b = lo; }
__device__ __forceinline__ void sort16_desc(unsigned (&a)[16]) {
#pragma unroll
  for (int k = 2; k <= 16; k <<= 1)
#pragma unroll
    for (int j = k >> 1; j > 0; j >>= 1)
#pragma unroll
      for (int i = 0; i < 16; ++i) {
        const int l = i ^ j;
        if (l > i) { if ((i & k) == 0) cswap_desc(a[i], a[l]); else cswap_desc(a[l], a[i]); }
      }
}
template <bool SORT>
__device__ __forceinline__ void merge16_desc(unsigned (&a)[16], const unsigned (&b)[16]) {
#pragma unroll
  for (int i = 0; i < 16; ++i) a[i] = a[i] > b[15 - i] ? a[i] : b[15 - i];
  if (SORT) {
#pragma unroll
    for (int j = 8; j > 0; j >>= 1)
#pragma unroll
      for (int i = 0; i < 16; ++i) { const int l = i ^ j; if (l > i) cswap_desc(a[i], a[l]); }
  }
}
__device__ void phase_peer_select(const Params& p, char* lds) {
  char* ws = p.ws;
  const int tid = threadIdx.x, lane = tid & 63, wid = tid >> 6, hh = lane >> 5, l31 = lane & 31;
  const bf16_t* pq = (const bf16_t*)(ws + W_B); const bf16_t* keys = (const bf16_t*)(ws + W_KEYS);
  int* seli = (int*)(ws + D_SELI); float* selw = (float*)(ws + D_SELW);
  float* S = (float*)lds;
  unsigned* LH = (unsigned*)lds;
  unsigned* LF = LH + 2 * 64 * 20;
  for (int u = blockIdx.x; u < 520 * 8; u += gridDim.x) {
    const int tt = u >> 3, h = u & 7; const int t0 = tt * 64;
    {
      const int c = wid >> 1;
      f32x16 acc[2][2]; zero_acc(acc);
      const bf16_t* ap = pq + (size_t)(t0 + l31) * LDH + h * 128 + c * 64 + hh * 8;
      const bf16_t* bp = keys + ((size_t)((h * 2 + c) * 128 + (wid & 1) * 64 + l31)) * 64 + hh * 8;
#pragma unroll
      for (int ks = 0; ks < 4; ++ks) {
        bf16x8 a0 = *(const bf16x8*)(ap + ks * 16), a1 = *(const bf16x8*)(ap + 32 * LDH + ks * 16);
        bf16x8 b0 = *(const bf16x8*)(bp + ks * 16), b1 = *(const bf16x8*)(bp + 32 * 64 + ks * 16);
        acc[0][0] = mfma32(a0, b0, acc[0][0]); acc[0][1] = mfma32(a0, b1, acc[0][1]);
        acc[1][0] = mfma32(a1, b0, acc[1][0]); acc[1][1] = mfma32(a1, b1, acc[1][1]);
      }
#pragma unroll
      for (int i = 0; i < 2; ++i)
#pragma unroll
        for (int j = 0; j < 2; ++j)
#pragma unroll
          for (int r = 0; r < 16; ++r) S[(i * 32 + accrow(r, hh)) * 260 + c * 128 + (wid & 1) * 64 + j * 32 + l31] = acc[i][j][r];
    }
    __syncthreads();
    const int tok = lane, c = wid & 1, half = wid >> 1;
    unsigned L[16];
    {
      const float* sp = S + tok * 260 + c * 128 + half * 64;
#pragma unroll
      for (int grp = 0; grp < 4; ++grp) {
        unsigned G[16];
#pragma unroll
        for (int n4 = 0; n4 < 4; ++n4) {
          const f32x4 v = *(const f32x4*)(sp + grp * 16 + n4 * 4);
          const unsigned ib = (unsigned)(127 - (half * 64 + grp * 16 + n4 * 4));
#pragma unroll
          for (int e = 0; e < 4; ++e) G[n4 * 4 + e] = (fkey(v[e]) & ~127u) | (ib - e);
        }
        sort16_desc(G);
        if (grp == 0) {
#pragma unroll
          for (int i = 0; i < 16; ++i) L[i] = G[i];
        } else merge16_desc<true>(L, G);
      }
    }
    __syncthreads();
    if (half == 1) {
#pragma unroll
      for (int i = 0; i < 16; i += 4) { u32x4 w = {L[i], L[i + 1], L[i + 2], L[i + 3]}; *(u32x4*)(LH + (c * 64 + tok) * 20 + i) = w; }
    }
    __syncthreads();
    if (half == 0) {
      unsigned G[16];
#pragma unroll
      for (int i = 0; i < 16; i += 4) {
        const u32x4 w = *(const u32x4*)(LH + (c * 64 + tok) * 20 + i);
        G[i] = w[0]; G[i + 1] = w[1]; G[i + 2] = w[2]; G[i + 3] = w[3];
      }
      merge16_desc<true>(L, G);
#pragma unroll
      for (int i = 0; i < 16; i += 4) { u32x4 w = {L[i], L[i + 1], L[i + 2], L[i + 3]}; *(u32x4*)(LF + (c * 64 + tok) * 20 + i) = w; }
    }
    __syncthreads();
    if (wid == 0) {
      float a[16], b[16];
#pragma unroll
      for (int i = 0; i < 16; ++i) a[i] = fkey_inv(L[i]);
#pragma unroll
      for (int j = 0; j < 16; j += 4) {
        const u32x4 w = *(const u32x4*)(LF + (64 + tok) * 20 + j);
        b[j] = fkey_inv(w[0]); b[j + 1] = fkey_inv(w[1]); b[j + 2] = fkey_inv(w[2]); b[j + 3] = fkey_inv(w[3]);
      }
      unsigned M[16], G[16];
#pragma unroll
      for (int j = 0; j < 16; ++j) M[j] = (fkey(a[0] + b[j]) & ~255u) | (unsigned)(255 - j);
      sort16_desc(M);
#define PK_CAND(i, j) ((fkey(a[i] + b[j]) & ~255u) | (unsigned)(255 - ((i) * 16 + (j))))
      G[0] = PK_CAND(1, 0); G[1] = PK_CAND(1, 1); G[2] = PK_CAND(1, 2); G[3] = PK_CAND(1, 3); G[4] = PK_CAND(1, 4); G[5] = PK_CAND(1, 5); G[6] = PK_CAND(1, 6); G[7] = PK_CAND(1, 7);
      G[8] = PK_CAND(2, 0); G[9] = PK_CAND(2, 1); G[10] = PK_CAND(2, 2); G[11] = PK_CAND(2, 3); G[12] = PK_CAND(2, 4); G[13] = 0u; G[14] = 0u; G[15] = 0u;
      sort16_desc(G); merge16_desc<true>(M, G);
      G[0] = PK_CAND(3, 0); G[1] = PK_CAND(3, 1); G[2] = PK_CAND(3, 2); G[3] = PK_CAND(3, 3); G[4] = PK_CAND(4, 0); G[5] = PK_CAND(4, 1); G[6] = PK_CAND(4, 2);
      G[7] = PK_CAND(5, 0); G[8] = PK_CAND(5, 1); G[9] = PK_CAND(6, 0); G[10] = PK_CAND(6, 1); G[11] = PK_CAND(7, 0); G[12] = PK_CAND(7, 1); G[13] = 0u; G[14] = 0u; G[15] = 0u;
      sort16_desc(G); merge16_desc<true>(M, G);
      G[0] = PK_CAND(8, 0); G[1] = PK_CAND(9, 0); G[2] = PK_CAND(10, 0); G[3] = PK_CAND(11, 0); G[4] = PK_CAND(12, 0); G[5] = PK_CAND(13, 0); G[6] = PK_CAND(14, 0); G[7] = PK_CAND(15, 0);
#pragma unroll
      for (int i = 8; i < 16; ++i) G[i] = 0u;
      sort16_desc(G); merge16_desc<true>(M, G);
#undef PK_CAND
      const float mx = fkey_inv(M[0]);
      float ev[16], den = 0.f;
#pragma unroll
      for (int k = 0; k < 16; ++k) { ev[k] = __expf(fkey_inv(M[k]) - mx); den += ev[k]; }
      const float rden = 1.f / den;
      const size_t o = ((size_t)(t0 + tok) * 8 + h) * 16;
#pragma unroll
      for (int k4 = 0; k4 < 16; k4 += 4) {
        int id[4]; f32x4 wv;
#pragma unroll
        for (int e = 0; e < 4; ++e) {
          const int flat = 255 - (int)(M[k4 + e] & 255u);
          const int i1 = 127 - (int)(LF[tok * 20 + (flat >> 4)] & 127u), i2 = 127 - (int)(LF[(64 + tok) * 20 + (flat & 15)] & 127u);
          id[e] = i1 * 128 + i2; wv[e] = ev[k4 + e] * rden;
        }
        *(int4*)(seli + o + k4) = make_int4(id[0], id[1], id[2], id[3]);
        *(f32x4*)(selw + o + k4) = wv;
      }
    }
    __syncthreads();
  }
}

__device__ __forceinline__ void peer_token_part(const Params& p, int t, int e_lo, int e_hi, float (&ov)[16], int lane) {
  char* ws = p.ws;
  const bf16_t* hf = (const bf16_t*)(ws + W_C);
  const unsigned char* u8 = (const unsigned char*)(ws + W_F); const unsigned char* v8 = u8 + 1024;
  const float* qs = (const float*)(ws + W_F + 33554432);
  const int* seli = (const int*)(ws + D_SELI); const float* selw = (const float*)(ws + D_SELW);
  f32v2_t hv[8], o2[8];
  {
    u32x4 a = *(const u32x4*)(hf + (size_t)t * LDH + lane * 16), b = *(const u32x4*)(hf + (size_t)t * LDH + lane * 16 + 8);
#pragma unroll
    for (int i = 0; i < 4; ++i) { hv[i] = (f32v2_t){bflo(a[i]), bfhi(a[i])}; hv[4 + i] = (f32v2_t){bflo(b[i]), bfhi(b[i])}; }
#pragma unroll
    for (int i = 0; i < 8; ++i) o2[i] = (f32v2_t){ov[2 * i], ov[2 * i + 1]};
  }
  const int myi0 = seli[(size_t)t * 128 + lane], myi1 = seli[(size_t)t * 128 + 64 + lane];
  const float mysu0 = qs[myi0], mysu1 = qs[myi1];
  const float myw0 = selw[(size_t)t * 128 + lane] * qs[16384 + myi0], myw1 = selw[(size_t)t * 128 + 64 + lane] * qs[16384 + myi1];
  const int b0 = lane & 1, b1 = lane & 2, b2 = lane & 4;
  for (int e0 = e_lo; e0 < e_hi; e0 += 8) {
    u32x4 ua[8], va[8];
    const int esel = (e0 & 63) + (lane & 7);
    const float sul = __shfl(e0 < 64 ? mysu0 : mysu1, esel), gwl = __shfl(e0 < 64 ? myw0 : myw1, esel);
#pragma unroll
    for (int k = 0; k < 8; ++k) {
      const int idx = __shfl(e0 < 64 ? myi0 : myi1, (e0 & 63) + k);
      ua[k] = *(const u32x4*)(u8 + (size_t)idx * 2048 + lane * 16);
      va[k] = *(const u32x4*)(v8 + (size_t)idx * 2048 + lane * 16);
    }
    float d[8];
#pragma unroll
    for (int k = 0; k < 8; ++k) {
      f32v2_t acc = {0.f, 0.f};
#pragma unroll
      for (int i = 0; i < 4; ++i) {
        const f32v2_t lo = __builtin_amdgcn_cvt_pk_f32_fp8((int)ua[k][i], false), hi = __builtin_amdgcn_cvt_pk_f32_fp8((int)ua[k][i], true);
        acc = hv[2 * i] * lo + acc; acc = hv[2 * i + 1] * hi + acc;
      }
      d[k] = acc[0] + acc[1];
    }
    float v4[4], v2[2], v1;
#pragma unroll
    for (int j = 0; j < 4; ++j) { const float keep = b0 ? d[2 * j + 1] : d[2 * j], send = b0 ? d[2 * j] : d[2 * j + 1]; v4[j] = keep + __shfl_xor(send, 1); }
#pragma unroll
    for (int j = 0; j < 2; ++j) { const float keep = b1 ? v4[2 * j + 1] : v4[2 * j], send = b1 ? v4[2 * j] : v4[2 * j + 1]; v2[j] = keep + __shfl_xor(send, 2); }
    { const float keep = b2 ? v2[1] : v2[0], send = b2 ? v2[0] : v2[1]; v1 = keep + __shfl_xor(send, 4); }
    v1 += __shfl_xor(v1, 8); v1 += __shfl_xor(v1, 16); v1 += __shfl_xor(v1, 32);
    const float dl = v1 * sul;
    const float wl = gwl * (0.5f * dl * (1.f + erff(dl * 0.70710678118654752f)));
#pragma unroll
    for (int k = 0; k < 8; ++k) {
      const float w = __builtin_bit_cast(float, __builtin_amdgcn_readlane(__builtin_bit_cast(int, wl), k));
      const f32v2_t w2 = {w, w};
#pragma unroll
      for (int i = 0; i < 4; ++i) {
        const f32v2_t lo = __builtin_amdgcn_cvt_pk_f32_fp8((int)va[k][i], false), hi = __builtin_amdgcn_cvt_pk_f32_fp8((int)va[k][i], true);
        o2[2 * i] = w2 * lo + o2[2 * i]; o2[2 * i + 1] = w2 * hi + o2[2 * i + 1];
      }
    }
  }
#pragma unroll
  for (int i = 0; i < 8; ++i) { ov[2 * i] = o2[i][0]; ov[2 * i + 1] = o2[i][1]; }
}
__device__ __forceinline__ void peer_token_finish(const Params& p, int t, float (&ov)[16], int lane) {
  const float* xr = (const float*)(p.ws + D_X1) + (size_t)t * DM + lane * 16; const float* g = p.in[24] + lane * 16;
  float ss = 0.f;
#pragma unroll
  for (int i = 0; i < 4; ++i) { f32x4 a = *(const f32x4*)(xr + i * 4); ov[4 * i] += a[0]; ov[4 * i + 1] += a[1]; ov[4 * i + 2] += a[2]; ov[4 * i + 3] += a[3]; }
#pragma unroll
  for (int i = 0; i < 16; ++i) ss += ov[i] * ov[i];
  ss = wave_sum(ss);
  const float rs = rsqrtf(ss * (1.f / DM) + EPS);
  float* y = p.out + O_Y + (size_t)t * DM + lane * 16;
#pragma unroll
  for (int i = 0; i < 4; ++i) {
    f32x4 ga = *(const f32x4*)(g + i * 4); f32x4 o;
    o[0] = ov[4 * i] * rs * ga[0]; o[1] = ov[4 * i + 1] * rs * ga[1]; o[2] = ov[4 * i + 2] * rs * ga[2]; o[3] = ov[4 * i + 3] * rs * ga[3];
    *(f32x4*)(y + i * 4) = o;
  }
}
__device__ void phase_peer_gather(const Params& p, char* lds) {
  const int wid = threadIdx.x >> 6, lane = threadIdx.x & 63;
  const int gw = blockIdx.x * 4 + wid, nw = gridDim.x * 4;
  const int t_main = (T / nw) * nw;
  for (int t = gw; t < t_main; t += nw) {
    float ov[16];
#pragma unroll
    for (int i = 0; i < 16; ++i) ov[i] = 0.f;
    peer_token_part(p, t, 0, 128, ov, lane);
    peer_token_finish(p, t, ov, lane);
  }
  float* part = (float*)lds;
  for (int t = t_main + blockIdx.x; t < T; t += gridDim.x) {
    float ov[16];
#pragma unroll
    for (int i = 0; i < 16; ++i) ov[i] = 0.f;
    peer_token_part(p, t, wid * 32, wid * 32 + 32, ov, lane);
    if (wid > 0) {
#pragma unroll
      for (int i = 0; i < 4; ++i) { f32x4 w = {ov[4 * i], ov[4 * i + 1], ov[4 * i + 2], ov[4 * i + 3]}; *(f32x4*)(part + wid * 1024 + lane * 16 + i * 4) = w; }
    }
    __syncthreads();
    if (wid == 0) {
#pragma unroll
      for (int w = 1; w < 4; ++w)
#pragma unroll
        for (int i = 0; i < 4; ++i) { const f32x4 v = *(const f32x4*)(part + w * 1024 + lane * 16 + i * 4); ov[4 * i] += v[0]; ov[4 * i + 1] += v[1]; ov[4 * i + 2] += v[2]; ov[4 * i + 3] += v[3]; }
      peer_token_finish(p, t, ov, lane);
    }
    __syncthreads();
  }
}

constexpr int NPHASE = 12;
__global__ void __launch_bounds__(256, 2) mega(Params p, int ph_lo, int ph_hi, int dupmask) {
  __shared__ __attribute__((aligned(16))) char lds[73728];
  __shared__ int s_item;
  __shared__ unsigned s_bar[4];
  unsigned* bar = (unsigned*)(p.ws + W_BAR);
  const unsigned xcc = xb_xcc_id();
  if (threadIdx.x < 4) s_bar[threadIdx.x] = 0u;
  if (threadIdx.x == 0 && ph_hi - ph_lo > 1) (void)xb_add(&bar[XB_XCNT(xcc)], 1u);
  __syncthreads();
  if (ph_hi > 4096) cg::this_grid().sync();
#define RUN_PHASE(PH, CALL)                                                       \
  if ((ONLY < 0 || ONLY == PH) && ph_lo <= PH && PH < ph_hi) {                    \
    const int nrep = 1 + ((dupmask >> PH) & 1);                                   \
    for (int rep = 0; rep < nrep; ++rep) {                                        \
      const int dry = (rep + 1 < nrep); (void)dry;                                \
      CALL;                                                                       \
      if (dry) grid_barrier(bar, xcc, s_bar);                                     \
    }                                                                             \
    if (PH + 1 < ph_hi) {                                                         \
      grid_barrier(bar, xcc, s_bar);                                              \
    }                                                                             \
  }
  RUN_PHASE(0, phase_prep(p))
  RUN_PHASE(1, phase_inproj(p, lds))
  RUN_PHASE(2, phase_small(p))
  RUN_PHASE(3, phase_attn_diff(p, lds, &s_item, dry))
  RUN_PHASE(4, phase_mla_expand(p, lds))
  RUN_PHASE(5, phase_attn_mla(p, lds, &s_item, dry))
  RUN_PHASE(6, phase_merge(p, lds))
  RUN_PHASE(7, phase_outproj(p, lds))
  RUN_PHASE(8, phase_ffn_norm(p))
  RUN_PHASE(9, phase_peer_q(p, lds))
  RUN_PHASE(10, phase_peer_select(p, lds))
  RUN_PHASE(11, phase_peer_gather(p, lds))
}

extern "C" void kernel_launch(void* const* d_in, const int* in_sizes, int n_in, void* d_out, int out_size, void* d_ws, size_t ws_size,
                              hipStream_t stream) {
  if (ws_size < W_END || n_in < 25) { fprintf(stderr, "workspace too small: %zu < %zu\n", ws_size, (size_t)W_END); return; }
  static int grid_blocks = 0;
  if (!grid_blocks) {
    int dev = 0, cus = 0, per_cu = 0;
    hipGetDevice(&dev);
    hipDeviceGetAttribute(&cus, hipDeviceAttributeMultiprocessorCount, dev);
    hipOccupancyMaxActiveBlocksPerMultiprocessor(&per_cu, mega, 256, 0);
    if (per_cu > 2) per_cu = 2;
    grid_blocks = cus * per_cu;
  }
  Params p{};
  for (int i = 0; i < 25; ++i) p.in[i] = (const float*)d_in[i];
  p.out = (float*)d_out; p.ws = (char*)d_ws; p.nblocks = (unsigned)grid_blocks; p.pad = 0;
  hipMemsetAsync((char*)d_ws + W_BAR, 0, 16384, stream);
#if MULTI_LAUNCH
  for (int ph = 0; ph < NPHASE; ++ph) {
    hipLaunchKernelGGL(mega, dim3(grid_blocks), dim3(256), 0, stream, p, ph, ph + 1, 0);
  }
#else
  int lo = 0, hi = NPHASE, dup = DUPMASK;
  void* args[] = {&p, &lo, &hi, &dup};
  hipError_t e = hipLaunchCooperativeKernel((void*)mega, dim3(grid_blocks), dim3(256), args, 0, stream);
  if (e != hipSuccess) fprintf(stderr, "cooperative launch failed: %s (grid %d)\n", hipGetErrorString(e), grid_blocks);
#endif
}
```
